# Optimizing an MI355X kernel written in HIP

```python
import math, functools
import jax, jax.numpy as jnp
from jax import lax
import numpy as np

D_MODEL = 2048
BATCH = 2
SEQ = 4096
DEPTH = 4

GRID_W = 64
CTX_LEN = 256
HEAD_DIM = 128
NORM_EPS = 1e-6
N_MOD = 9
D_FF = 5632
SGU_GROUPS = 4
SGU_WIDTH = SGU_GROUPS * HEAD_DIM
CHUNK = 128
N_Q_HEADS = 8
N_KV_HEADS = 2
Q_GROUP = N_Q_HEADS // N_KV_HEADS
ATTN_WIDTH = N_Q_HEADS * HEAD_DIM
KV_WIDTH = N_KV_HEADS * HEAD_DIM
WINDOW = 128
BLOCK = 128
ROPE_BASE = 10000.0
NEG_INF = -1e30
HY_GROUPS = 4
HY_WIDTH = HY_GROUPS * HEAD_DIM
HY_ORDER = 2
HY_SHORT = 3
HY_BANDS = 16
HY_EMB = 1 + 2 * HY_BANDS
HY_HIDDEN = 64
HY_TARGET = 1e-2
HY_FAST_DECAY = 0.3
HY_SLOW_DECAY = 1.5
D_MIX = SGU_WIDTH + ATTN_WIDTH + HY_WIDTH
A_END = 2 * SGU_WIDTH
Q_END = A_END + ATTN_WIDTH
K_END = Q_END + KV_WIDTH
V_END = K_END + KV_WIDTH
IN_COLS = V_END + (HY_ORDER + 1) * HY_WIDTH

kernel_name = 'hymba_style_sgu_swa_hyena_dit'


def rms_norm(x, g):
    xf = x.astype(jnp.float32)
    y = xf * lax.rsqrt(jnp.mean(xf * xf, axis=-1, keepdims=True) + NORM_EPS)
    return (y * g.astype(jnp.float32)).astype(x.dtype)


def layer_norm(x, g):
    xf = x.astype(jnp.float32)
    mu = jnp.mean(xf, axis=-1, keepdims=True)
    var = jnp.mean(jnp.square(xf - mu), axis=-1, keepdims=True)
    return ((xf - mu) * lax.rsqrt(var + NORM_EPS) * g.astype(jnp.float32)).astype(x.dtype)


def swiglu(h, w_gate, w_up, w_down):
    return (jax.nn.silu(h @ w_gate) * (h @ w_up)) @ w_down


def sub_pre(x, mod, k, g_pre):
    return rms_norm(x, g_pre) * (1.0 + mod[:, 3 * k][:, None]) + mod[:, 3 * k + 1][:, None]


def sub_post(x, y, mod, k, g_post, coef):
    return x + coef * mod[:, 3 * k + 2][:, None] * rms_norm(y, g_post)


def axial_rope(L):
    rows = L // GRID_W
    row = jnp.broadcast_to(jnp.arange(rows)[:, None], (rows, GRID_W)).reshape(L).astype(jnp.float32)
    col = jnp.broadcast_to(jnp.arange(GRID_W)[None, :], (rows, GRID_W)).reshape(L).astype(jnp.float32)
    half = HEAD_DIM // 2
    inv = ROPE_BASE ** (-jnp.arange(0, half, 2, dtype=jnp.float32) / half)
    ang_r = row[:, None] * inv
    ang_c = col[:, None] * inv
    ang = jnp.concatenate([ang_r, ang_r, ang_c, ang_c], axis=-1)
    return jnp.cos(ang), jnp.sin(ang)


def apply_rope(t, cos, sin):
    t1, t2, t3, t4 = jnp.split(t, 4, axis=-1)
    rot = jnp.concatenate([-t2, t1, -t4, t3], axis=-1)
    return (t * cos[:, None] + rot * sin[:, None]).astype(t.dtype)


def spatial_gating(a, g, w_s, b_s):
    B, L, _ = a.shape
    a = jax.nn.gelu(a, approximate=False)
    u, v = jnp.split(a, 2, axis=-1)
    v = layer_norm(v, g)
    vc = v.reshape(B, L // CHUNK, CHUNK, SGU_GROUPS, HEAD_DIM)
    mixed = jnp.einsum('bnpgc,gqp->bnqgc', vc, w_s) + b_s.T[None, None, :, :, None]
    return u * mixed.reshape(B, L, SGU_WIDTH)


def latent_attention(q, k, v, k_c, v_c, sink):
    B, L = q.shape[:2]
    Lc = k_c.shape[1]
    nb = L // BLOCK
    scale = HEAD_DIM ** -0.5
    qb = q.reshape(B, nb, BLOCK, N_KV_HEADS, Q_GROUP, HEAD_DIM)

    def band(t):
        tp = jnp.pad(t, ((0, 0), (BLOCK, BLOCK), (0, 0), (0, 0)))
        tp = tp.reshape(B, nb + 2, BLOCK, N_KV_HEADS, HEAD_DIM)
        return jnp.concatenate([tp[:, :-2], tp[:, 1:-1], tp[:, 2:]], axis=2)

    kb, vb = band(k), band(v)
    s_band = jnp.einsum('bnqkgd,bnrkd->bnkgqr', qb, kb).astype(jnp.float32) * scale
    qpos = jnp.arange(nb)[:, None, None] * BLOCK + jnp.arange(BLOCK)[None, :, None]
    kpos = (jnp.arange(nb)[:, None, None] - 1) * BLOCK + jnp.arange(3 * BLOCK)[None, None, :]
    valid = (jnp.abs(kpos - qpos) <= WINDOW) & (kpos >= 0) & (kpos < L)
    s_band = jnp.where(valid[None, :, None, None], s_band, NEG_INF)
    s_ctx = jnp.einsum('bnqkgd,bckd->bnkgqc', qb, k_c).astype(jnp.float32) * scale
    s_sink = jnp.broadcast_to(
        sink.astype(jnp.float32).reshape(N_KV_HEADS, Q_GROUP)[None, None, :, :, None, None],
        s_ctx.shape[:-1] + (1,))
    probs = jax.nn.softmax(jnp.concatenate([s_ctx, s_band, s_sink], axis=-1), axis=-1)
    p_ctx = probs[..., :Lc].astype(v.dtype)
    p_band = probs[..., Lc:Lc + 3 * BLOCK].astype(v.dtype)
    out = (jnp.einsum('bnkgqc,bckd->bnqkgd', p_ctx, v_c)
           + jnp.einsum('bnkgqr,bnrkd->bnqkgd', p_band, vb))
    return out.reshape(B, L, ATTN_WIDTH)


def context_attention(q_c, k_c, v_c, sink):
    B, Lc = q_c.shape[:2]
    qg = q_c.reshape(B, Lc, N_KV_HEADS, Q_GROUP, HEAD_DIM)
    s = jnp.einsum('bqkgd,bckd->bkgqc', qg, k_c).astype(jnp.float32) * HEAD_DIM ** -0.5
    s_sink = jnp.broadcast_to(
        sink.astype(jnp.float32).reshape(N_KV_HEADS, Q_GROUP)[None, :, :, None, None], s.shape[:-1] + (1,))
    probs = jax.nn.softmax(jnp.concatenate([s, s_sink], axis=-1), axis=-1)[..., :Lc].astype(v_c.dtype)
    return jnp.einsum('bkgqc,bckd->bqkgd', probs, v_c).reshape(B, Lc, ATTN_WIDTH)


def hyena_filter_spectrum(L, w1, b1, w2, b2, w3, freq):
    f32 = jnp.float32
    t = jnp.linspace(0.0, 1.0, L, dtype=f32)[:, None]
    w = (2.0 * math.pi / L) * jnp.arange(L, dtype=f32)[:, None]
    bands = jnp.linspace(1e-4, HY_BANDS - 1, HY_BANDS, dtype=f32)[None, :]
    feat = jnp.concatenate([t, jnp.cos(bands * w), -jnp.sin(bands * w)], axis=-1)
    fr = freq.astype(f32)
    hd = jnp.sin(fr * (feat @ w1.astype(f32) + b1.astype(f32)))
    hd = jnp.sin(fr * (hd @ w2.astype(f32) + b2.astype(f32)))
    h = (hd @ w3.astype(f32)).reshape(L, HY_ORDER, 2, HY_WIDTH)
    deltas = jnp.abs(jnp.linspace(math.log(HY_TARGET) / HY_FAST_DECAY,
                                  math.log(HY_TARGET) / HY_SLOW_DECAY, HY_WIDTH, dtype=f32))
    h = h * jnp.exp(-t * deltas)[:, None, None, :]
    h = h / (jnp.sum(jnp.abs(h), axis=(0, 2), keepdims=True) + 1e-6)
    kf, kb = h[:, :, 0], h[:, :, 1]
    k_circ = jnp.concatenate([kf[:1] + kb[:1], kf[1:], jnp.zeros_like(kf[:1]), kb[:0:-1]], axis=0)
    return jnp.fft.rfft(k_circ, axis=0)


def hyena(z, conv_w, conv_b, w1, b1, w2, b2, w3, freq, skip):
    B, L, _ = z.shape
    pad = HY_SHORT // 2
    zp = jnp.pad(z, ((0, 0), (pad, pad), (0, 0)))
    z = sum(zp[:, j:j + L] * conv_w[j] for j in range(HY_SHORT)) + conv_b
    v, x1, x2 = jnp.split(z, 3, axis=-1)
    spec = hyena_filter_spectrum(L, w1, b1, w2, b2, w3, freq)

    def long_conv(u, o):
        uf = u.astype(jnp.float32)
        U = jnp.fft.rfft(uf, n=2 * L, axis=1)
        y = jnp.fft.irfft(U * spec[None, :, o, :], n=2 * L, axis=1)[:, :L]
        return (y + uf * skip[o].astype(jnp.float32)).astype(u.dtype)

    s = x1 * long_conv(v, 0)
    return x2 * long_conv(s, 1)


def head_groups(z, k_c, v_c, rope, sgu_g, sgu_w, sgu_b, sink,
                hy_conv_w, hy_conv_b, hy_f_w1, hy_f_b1, hy_f_w2, hy_f_b2, hy_f_w3, hy_freq, hy_skip):
    B, L, _ = z.shape
    a_out = spatial_gating(z[..., :A_END], sgu_g, sgu_w, sgu_b)
    q = z[..., A_END:Q_END].reshape(B, L, N_Q_HEADS, HEAD_DIM)
    if rope is None:
        b_out = context_attention(q, k_c, v_c, sink)
    else:
        cos, sin = rope
        k = z[..., Q_END:K_END].reshape(B, L, N_KV_HEADS, HEAD_DIM)
        v = z[..., K_END:V_END].reshape(B, L, N_KV_HEADS, HEAD_DIM)
        b_out = latent_attention(apply_rope(q, cos, sin), apply_rope(k, cos, sin), v, k_c, v_c, sink)
    c_out = hyena(z[..., V_END:], hy_conv_w, hy_conv_b, hy_f_w1, hy_f_b1, hy_f_w2, hy_f_b2,
                  hy_f_w3, hy_freq, hy_skip)
    return jnp.concatenate([a_out, b_out, c_out], axis=-1)


def setup_inputs(seed: int = 0) -> dict:
    key = jax.random.key(seed)
    ks = iter(jax.random.split(key, 40))
    D = D_MODEL

    def nrm(shape, scale):
        return jax.random.normal(next(ks), shape, jnp.float32) * scale

    return {
        'x': nrm((BATCH, SEQ, D), 1.0),
        'c': nrm((BATCH, D), 1.0),
        'ctx': nrm((BATCH, CTX_LEN, D), 1.0),
        'c_ctx': nrm((D,), 1.0),
        'w_ada': nrm((DEPTH, D, N_MOD * D), D ** -0.5),
        'b_ada': nrm((DEPTH, N_MOD * D), 0.02),
        'norm_g': 1.0 + nrm((DEPTH, 6, D), 0.05),
        'ffn1_gate': nrm((DEPTH, D, D_FF), D ** -0.5),
        'ffn1_up': nrm((DEPTH, D, D_FF), D ** -0.5),
        'ffn1_down': nrm((DEPTH, D_FF, D), D_FF ** -0.5),
        'w_in': nrm((DEPTH, D, IN_COLS), D ** -0.5),
        'sgu_g': 1.0 + nrm((DEPTH, SGU_WIDTH), 0.05),
        'sgu_w': nrm((DEPTH, SGU_GROUPS, CHUNK, CHUNK), CHUNK ** -0.5),
        'sgu_b': 1.0 + nrm((DEPTH, SGU_GROUPS, CHUNK), 0.05),
        'attn_sink': nrm((DEPTH, N_Q_HEADS), 0.5),
        'hy_conv_w': nrm((DEPTH, HY_SHORT, (HY_ORDER + 1) * HY_WIDTH), HY_SHORT ** -0.5),
        'hy_conv_b': nrm((DEPTH, (HY_ORDER + 1) * HY_WIDTH), 0.02),
        'hy_f_w1': nrm((DEPTH, HY_EMB, HY_HIDDEN), HY_EMB ** -0.5),
        'hy_f_b1': nrm((DEPTH, HY_HIDDEN), 0.1),
        'hy_f_w2': nrm((DEPTH, HY_HIDDEN, HY_HIDDEN), HY_HIDDEN ** -0.5),
        'hy_f_b2': nrm((DEPTH, HY_HIDDEN), 0.1),
        'hy_f_w3': nrm((DEPTH, HY_HIDDEN, HY_ORDER * 2 * HY_WIDTH), HY_HIDDEN ** -0.5),
        'hy_freq': 1.0 + nrm((DEPTH, HY_HIDDEN), 0.05),
        'hy_skip': nrm((DEPTH, HY_ORDER, HY_WIDTH), 0.5),
        'w_out': nrm((DEPTH, D_MIX, D), D_MIX ** -0.5),
        'ffn2_gate': nrm((DEPTH, D, D_FF), D ** -0.5),
        'ffn2_up': nrm((DEPTH, D, D_FF), D ** -0.5),
        'ffn2_down': nrm((DEPTH, D_FF, D), D_FF ** -0.5),
    }


def reference(x, c, ctx, c_ctx, w_ada, b_ada, norm_g, ffn1_gate, ffn1_up, ffn1_down, w_in,
              sgu_g, sgu_w, sgu_b, attn_sink, hy_conv_w, hy_conv_b, hy_f_w1, hy_f_b1, hy_f_w2,
              hy_f_b2, hy_f_w3, hy_freq, hy_skip, w_out, ffn2_gate, ffn2_up, ffn2_down):
    B, L, D = x.shape
    rope = axial_rope(L)
    cx = ctx
    for i in range(DEPTH):
        last = i == DEPTH - 1
        g = norm_g[i]
        m_lat = (jax.nn.silu(c) @ w_ada[i] + b_ada[i]).reshape(B, N_MOD, D)
        m_ctx = (jax.nn.silu(c_ctx)[None] @ w_ada[i] + b_ada[i]).reshape(1, N_MOD, D)
        ffn1 = functools.partial(swiglu, w_gate=ffn1_gate[i], w_up=ffn1_up[i], w_down=ffn1_down[i])
        ffn2 = functools.partial(swiglu, w_gate=ffn2_gate[i], w_up=ffn2_up[i], w_down=ffn2_down[i])
        mixer_params = (sgu_g[i], sgu_w[i], sgu_b[i], attn_sink[i], hy_conv_w[i], hy_conv_b[i],
                        hy_f_w1[i], hy_f_b1[i], hy_f_w2[i], hy_f_b2[i], hy_f_w3[i], hy_freq[i], hy_skip[i])

        x = sub_post(x, ffn1(sub_pre(x, m_lat, 0, g[0])), m_lat, 0, g[1], 0.5)
        cx = sub_post(cx, ffn1(sub_pre(cx, m_ctx, 0, g[0])), m_ctx, 0, g[1], 0.5)

        h = sub_pre(x, m_lat, 1, g[2])
        hc = sub_pre(cx, m_ctx, 1, g[2])
        if last:
            z_c = None
            kv_c = hc @ w_in[i][:, Q_END:V_END]
        else:
            z_c = hc @ w_in[i]
            kv_c = z_c[..., Q_END:V_END]
        Lc = kv_c.shape[1]
        k_c = kv_c[..., :KV_WIDTH].reshape(B, Lc, N_KV_HEADS, HEAD_DIM)
        v_c = kv_c[..., KV_WIDTH:].reshape(B, Lc, N_KV_HEADS, HEAD_DIM)
        y = head_groups(h @ w_in[i], k_c, v_c, rope, *mixer_params) @ w_out[i]
        x = sub_post(x, y, m_lat, 1, g[3], 1.0)

        x = sub_post(x, ffn2(sub_pre(x, m_lat, 2, g[4])), m_lat, 2, g[5], 0.5)

        if not last:
            yc = head_groups(z_c, k_c, v_c, None, *mixer_params) @ w_out[i]
            cx = sub_post(cx, yc, m_ctx, 1, g[3], 1.0)
            cx = sub_post(cx, ffn2(sub_pre(cx, m_ctx, 2, g[4])), m_ctx, 2, g[5], 0.5)
    return x
```

```cpp
#include <hip/hip_runtime.h>
#include <cstdio>
#include <cstdint>
namespace pg8 {
#define PG8_LAS __attribute__((address_space(3)))
typedef unsigned short bf16_t;
typedef short bf16x8 __attribute__((ext_vector_type(8)));
typedef float f32x4 __attribute__((ext_vector_type(4)));
typedef unsigned u32x4 __attribute__((ext_vector_type(4)));
constexpr int BM = 256, BK = 64, HALF = 128, HTB = HALF * BK * 2  , STAGE_BYTES = 8 * HTB, NXCD = 8, WGM = 8;

__host__ __device__ __forceinline__ int lds_byte(int r, int c) { const int st = (r >> 4) * 2 + (c >> 5), rr = r & 15, cc = c & 31, ob = rr * 64 + cc * 2; return st * 1024 + (ob ^ (((ob >> 9) & 1) << 5)); }
__host__ __device__ __forceinline__ void stage_rc(int b, int& R, int& C) { const int st = b / 1024, sb = b % 1024, swz = sb ^ (((sb >> 9) & 1) << 5); R = (st >> 1) * 16 + swz / 64; C = (st & 1) * 32 + (swz % 64) / 2; }
__host__ __device__ __forceinline__ int perm32(int rho) { const int n = rho >> 4, i = rho & 15; return 8 * (i >> 2) + 4 * n + (i & 3); }

struct Unit { int pm, pn; };
struct Gemm { const bf16_t* A; const bf16_t* Bt; int M, N, K; };

struct StaticOrder {
    int nM, nN, nwg, G, c;
    __host__ __device__ void init(int M, int N, int G_, int c_) { nM = M / BM; nN = N / BM; nwg = nM * nN; G = G_; c = c_; }
    __host__ __device__ bool next(int i, Unit& u) const {
        const long L = (long)i * G + c; if (L >= nwg) return false;
        int wgid = (int)L; { const int q = nwg / NXCD, r = nwg % NXCD, xcd = wgid % NXCD, off = wgid / NXCD; wgid = (xcd < r ? xcd * (q + 1) : r * (q + 1) + (xcd - r) * q) + off; }
        const int nig = WGM * nN, gid = wgid / nig, fm = gid * WGM, gsz = (nM - fm) < WGM ? (nM - fm) : WGM;
        u.pm = fm + ((wgid % nig) % gsz); u.pn = (wgid % nig) / gsz; return true;
    }
    __device__ __forceinline__ void a_ready(const Unit&) const {}
    __device__ __forceinline__ void done(const Unit&) const {}
};

__device__ __forceinline__ unsigned cvt_pk_bf16(float lo, float hi) { unsigned r; asm volatile("v_cvt_pk_bf16_f32 %0, %1, %2" : "=v"(r) : "v"(lo), "v"(hi)); return r; }
typedef float f32x2 __attribute__((ext_vector_type(2)));
__device__ __forceinline__ f32x2 gelu_pk(f32x2 v) {
    const f32x2 av = __builtin_elementwise_abs(v), d = av * 0.2316418882f + 1.0f;
    f32x2 t; t.x = __builtin_amdgcn_rcpf(d.x); t.y = __builtin_amdgcn_rcpf(d.y);
    f32x2 q = t * 0.5307027145f + (-0.7265760135f); q = q * t + 0.7107068705f; q = q * t + (-0.142248368f); q = q * t + 0.127414796f; q = q * t;
    const f32x2 s = (v * v) * (-0.72134752044f);
    f32x2 e; e.x = __builtin_amdgcn_exp2f(s.x); e.y = __builtin_amdgcn_exp2f(s.y);
    const f32x2 m = v * (q * e), r = v - m;
    f32x2 o; o.x = v.x < 0.f ? m.x : r.x; o.y = v.y < 0.f ? m.y : r.y; return o;
}

__device__ __forceinline__ float fast_silu(float g) { return g * __builtin_amdgcn_rcpf(1.0f + __builtin_amdgcn_exp2f(-1.4426950408889634f * g)); }
struct EpiSwiGLU {
    static constexpr bool PERM = true, AFTER_DRAIN = false;
    bf16_t* O; int ldh;
    __device__ __forceinline__ void operator()(const f32x4 (&acc)[2][2][4][2], const Unit& u, int wr, int wc, int fr, int fq) const {
        const int row0 = u.pm * BM + wr * 64 + fr, col0 = u.pn * HALF + wc * 32 + 8 * fq;
#pragma unroll
        for (int ai = 0; ai < 2; ++ai)
#pragma unroll
            for (int m = 0; m < 4; ++m) {
                bf16_t* rowp = O + (size_t)(row0 + ai * HALF + m * 16) * ldh + col0;
                const f32x4 g0 = acc[ai][0][m][0], g1 = acc[ai][0][m][1], u0 = acc[ai][1][m][0], u1 = acc[ai][1][m][1];
                u32x4 w;
                w.x = cvt_pk_bf16(fast_silu(g0[0]) * u0[0], fast_silu(g0[1]) * u0[1]); w.y = cvt_pk_bf16(fast_silu(g0[2]) * u0[2], fast_silu(g0[3]) * u0[3]);
                w.z = cvt_pk_bf16(fast_silu(g1[0]) * u1[0], fast_silu(g1[1]) * u1[1]); w.w = cvt_pk_bf16(fast_silu(g1[2]) * u1[2], fast_silu(g1[3]) * u1[3]);
                *(u32x4*)rowp = w;
            }
    }
};
struct EpiF32 {
    static constexpr bool PERM = false, AFTER_DRAIN = false;
    float* O; int ldc;
    __device__ __forceinline__ void operator()(const f32x4 (&acc)[2][2][4][2], const Unit& u, int wr, int wc, int fr, int fq) const {
        const int row0 = u.pm * BM + wr * 64 + fr, col0 = u.pn * BM + wc * 32 + 4 * fq;
#pragma unroll
        for (int ai = 0; ai < 2; ++ai)
#pragma unroll
            for (int m = 0; m < 4; ++m) {
                float* rowp = O + (size_t)(row0 + ai * HALF + m * 16) * ldc + col0;
#pragma unroll
                for (int bj = 0; bj < 2; ++bj)
#pragma unroll
                    for (int n = 0; n < 2; ++n) *(f32x4*)(rowp + bj * HALF + n * 16) = acc[ai][bj][m][n];
            }
    }
};
constexpr size_t WSO_MiB = 1u << 20, WSO_ROPE = 2 * WSO_MiB, WSO_AU = 408 * WSO_MiB, WSO_QB = 425 * WSO_MiB, WSO_KB = 442 * WSO_MiB, WSO_VTL = 447 * WSO_MiB, WSO_VTC = 451 * WSO_MiB, WSO_HZL = 452 * WSO_MiB, WSO_HZC = 500 * WSO_MiB;
struct EpiWin {
    static constexpr bool PERM = true, AFTER_DRAIN = false;
    unsigned char* ws; float qscale;
    __device__ __forceinline__ void operator()(const f32x4 (&acc)[2][2][4][2], const Unit& u, int wr, int wc, int fr, int fq) const {
        int pm_ = u.pm, pn_ = u.pn; asm volatile("" : "+s"(pm_), "+s"(pn_));
        const int row0 = pm_ * BM + wr * 64 + fr; const int pn = pn_; const bool lat = pm_ < 32;
        bf16_t* AU = (bf16_t*)(ws + WSO_AU); bf16_t* QB = (bf16_t*)(ws + WSO_QB); bf16_t* KB = (bf16_t*)(ws + WSO_KB); bf16_t* VTl = (bf16_t*)(ws + WSO_VTL); bf16_t* VTc = (bf16_t*)(ws + WSO_VTC);
        float* HZl = (float*)(ws + WSO_HZL); float* HZc = (float*)(ws + WSO_HZC); const float* ropeC = (const float*)(ws + WSO_ROPE); const float* ropeS = ropeC + 2048;
#ifndef EWM
#define EWM 15
#endif
        if (pn < 4) { if (EWM & 1) {
            const int col0 = pn * BM + wc * 32 + 8 * fq;
#pragma unroll
            for (int ai = 0; ai < 2; ++ai)
#pragma unroll
                for (int m = 0; m < 4; ++m) { bf16_t* rowp = AU + (size_t)(row0 + ai * HALF + m * 16) * 1024 + col0;
#pragma unroll
                    for (int bj = 0; bj < 2; ++bj) { const f32x4 v0 = acc[ai][bj][m][0], v1 = acc[ai][bj][m][1];
                        const f32x2 a = gelu_pk((f32x2){v0[0], v0[1]}), b = gelu_pk((f32x2){v0[2], v0[3]}), c = gelu_pk((f32x2){v1[0], v1[1]}), d = gelu_pk((f32x2){v1[2], v1[3]});
                        u32x4 w; w.x = cvt_pk_bf16(a.x, a.y); w.y = cvt_pk_bf16(b.x, b.y); w.z = cvt_pk_bf16(c.x, c.y); w.w = cvt_pk_bf16(d.x, d.y);
                        *(u32x4*)(rowp + bj * HALF) = w; } } }
        } else if (pn < 9) { if (EWM & 2) {
            const bool isq = pn < 8; const int head = isq ? 2 * (pn - 4) + (wc >> 1) : (wc >> 1); const int e0 = 32 * (wc & 1) + 8 * fq; const int fi = 8 * fq;
            bf16_t* base = isq ? QB : KB; const int ld = isq ? 1024 : 256; const float sc = isq ? qscale : 1.0f;
#pragma unroll
            for (int ai = 0; ai < 2; ++ai)
#pragma unroll
                for (int m = 0; m < 4; ++m) { const int r = row0 + ai * HALF + m * 16; bf16_t* rowp = base + (size_t)r * ld + head * 128 + e0;
                    f32x4 x1a = acc[ai][0][m][0], x1b = acc[ai][0][m][1], x2a = acc[ai][1][m][0], x2b = acc[ai][1][m][1];
                    if (lat) { const int pos = r & 4095; const int a = (wc & 1) ? (pos & 63) : (pos >> 6);
                        const f32x4 c0 = *(const f32x4*)(ropeC + a * 32 + fi), c1 = *(const f32x4*)(ropeC + a * 32 + fi + 4), s0 = *(const f32x4*)(ropeS + a * 32 + fi), s1 = *(const f32x4*)(ropeS + a * 32 + fi + 4);
                        const f32x4 o1a = x1a * c0 - x2a * s0, o2a = x2a * c0 + x1a * s0, o1b = x1b * c1 - x2b * s1, o2b = x2b * c1 + x1b * s1;
                        x1a = o1a; x2a = o2a; x1b = o1b; x2b = o2b; }
                    x1a = x1a * sc; x1b = x1b * sc; x2a = x2a * sc; x2b = x2b * sc;
                    u32x4 w1, w2; w1.x = cvt_pk_bf16(x1a[0], x1a[1]); w1.y = cvt_pk_bf16(x1a[2], x1a[3]); w1.z = cvt_pk_bf16(x1b[0], x1b[1]); w1.w = cvt_pk_bf16(x1b[2], x1b[3]);
                    w2.x = cvt_pk_bf16(x2a[0], x2a[1]); w2.y = cvt_pk_bf16(x2a[2], x2a[3]); w2.z = cvt_pk_bf16(x2b[0], x2b[1]); w2.w = cvt_pk_bf16(x2b[2], x2b[3]);
                    *(u32x4*)rowp = w1; *(u32x4*)(rowp + 64) = w2; asm volatile("" ::: "memory"); } }
        } else if (pn == 9) { if (EWM & 4) {
            typedef __attribute__((address_space(1))) bf16_t gbf;
            gbf* vb = (gbf*)(lat ? VTl : VTc); const unsigned ldp = lat ? 4096u : 256u;
#pragma unroll
            for (int ai = 0; ai < 2; ++ai)
#pragma unroll
                for (int m = 0; m < 4; ++m) { const int r = row0 + ai * HALF + m * 16;
                    const unsigned rb = lat ? (unsigned)(r >> 12) * (256u * 4096u) + (unsigned)(r & 4095) : (unsigned)((r - 8192) >> 8) * (256u * 256u) + (unsigned)((r - 8192) & 255);
#pragma unroll
                    for (int bj = 0; bj < 2; ++bj)
#pragma unroll
                        for (int n = 0; n < 2; ++n) { const f32x4 v = acc[ai][bj][m][n]; const unsigned d0 = (unsigned)(bj * 128 + wc * 32 + 8 * fq + 4 * n);
                            const unsigned p0 = cvt_pk_bf16(v[0], v[1]), p1 = cvt_pk_bf16(v[2], v[3]); const unsigned o = rb + d0 * ldp;
                            vb[o] = (bf16_t)(p0 & 0xffffu); vb[o + ldp] = (bf16_t)(p0 >> 16); vb[o + 2u * ldp] = (bf16_t)(p1 & 0xffffu); vb[o + 3u * ldp] = (bf16_t)(p1 >> 16);
                            asm volatile("" ::: "memory"); } }
        } }
        else { if (EWM & 8) {
            typedef __attribute__((address_space(1))) float gfl;
            gfl* hb = (gfl*)(lat ? HZl : HZc); const unsigned ldp = lat ? 4096u : 256u;
            const unsigned cc0 = (unsigned)((pn - 10) * BM + wc * 32 + 8 * fq);
#pragma unroll
            for (int ai = 0; ai < 2; ++ai)
#pragma unroll
                for (int m = 0; m < 4; ++m) { const int r = row0 + ai * HALF + m * 16;
                    const unsigned rb = lat ? (unsigned)(r >> 12) * (1536u * 4096u) + (unsigned)(r & 4095) : (unsigned)((r - 8192) >> 8) * (1536u * 256u) + (unsigned)((r - 8192) & 255);
#pragma unroll
                    for (int bj = 0; bj < 2; ++bj)
#pragma unroll
                        for (int n = 0; n < 2; ++n) { const f32x4 v = acc[ai][bj][m][n]; const unsigned o = rb + (cc0 + (unsigned)(bj * 128 + 4 * n)) * ldp;
                            hb[o] = v[0]; hb[o + ldp] = v[1]; hb[o + 2u * ldp] = v[2]; hb[o + 3u * ldp] = v[3];
                            asm volatile("" ::: "memory"); } }
        } }
    }
};
template <class Epi, class Sched, bool ALIGN_EPI = false, bool SP2 = false>
__device__ __forceinline__ void gemm_phase(PG8_LAS unsigned char* lds, const Gemm g, const Sched& S, const Epi& E, const int tid) {
    const int wid = __builtin_amdgcn_readfirstlane(tid >> 6), lane = tid & 63, wr = wid >> 2, wc = wid & 3, fr = lane & 15, fq = lane >> 4;
    const int K = g.K, nt = K / BK;
    unsigned voffA[2], voffB[2];
#pragma unroll
    for (int i = 0; i < 2; ++i) { int R, C; stage_rc(tid * 16 + i * 8192, R, C); const int Rb = Epi::PERM ? ((R & ~31) + perm32(R & 31)) : R;
        voffA[i] = (unsigned)(R * K + C) * 2u; voffB[i] = (unsigned)(Rb * K + C) * 2u; }
    const size_t kstep = (size_t)(BK * 2);
    const size_t hstep = (size_t)HALF * K * 2;
    const size_t tstep = 2 * hstep;
    const unsigned ldsw = (unsigned)wid * 1024u;
    const int aoff = lds_byte(wr * 64 + fr, fq * 8), boff = lds_byte(wc * 32 + fr, fq * 8);
#define PG8_SA(b, h) (((b) * 2 + (h)) * HTB)
#define PG8_SB(b, h) ((4 + (b) * 2 + (h)) * HTB)
#define PG8_STAGE(bufoff, gbase, voff) do { _Pragma("unroll") for (int _i = 0; _i < 2; ++_i) \
        __builtin_amdgcn_global_load_lds((const unsigned*)((const char*)(gbase) + (voff)[_i]), (PG8_LAS unsigned*)(lds + (bufoff) + ldsw + _i * 8192), 16, 0, 0); } while (0)
#define PG8_LDA(dst, b, h) do { _Pragma("unroll") for (int m = 0; m < 4; ++m) _Pragma("unroll") for (int k = 0; k < 2; ++k) dst[m][k] = *(const PG8_LAS bf16x8*)(lds + PG8_SA(b, h) + aoff + m * 2048 + k * 1024); } while (0)
#define PG8_LDB(dst, b, h) do { _Pragma("unroll") for (int n = 0; n < 2; ++n) _Pragma("unroll") for (int k = 0; k < 2; ++k) dst[n][k] = *(const PG8_LAS bf16x8*)(lds + PG8_SB(b, h) + boff + n * 2048 + k * 1024); } while (0)
#define PG8_MMA(ai, bj, At, Bt) do { __builtin_amdgcn_s_setprio(1); _Pragma("unroll") for (int m = 0; m < 4; ++m) _Pragma("unroll") for (int n = 0; n < 2; ++n) _Pragma("unroll") for (int k = 0; k < 2; ++k) \
        acc[ai][bj][m][n] = __builtin_amdgcn_mfma_f32_16x16x32_bf16(Bt[n][k], At[m][k], acc[ai][bj][m][n], 0, 0, 0); __builtin_amdgcn_s_setprio(0); } while (0)
#define PG8_WAIT_V(n) asm volatile("s_waitcnt vmcnt(" #n ")" ::: "memory")
#define PG8_WAIT_L(n) asm volatile("s_waitcnt lgkmcnt(" #n ")" ::: "memory")
#define PG8_BAR __builtin_amdgcn_s_barrier()
#define PG8_SCHED __builtin_amdgcn_sched_barrier(0)
    Unit cur, nxt; int ui = 0;
    if (!S.next(0, cur)) return;
    f32x4 acc[2][2][4][2];
#pragma unroll
    for (int a = 0; a < 2; ++a)
#pragma unroll
        for (int b = 0; b < 2; ++b)
#pragma unroll
            for (int m = 0; m < 4; ++m)
#pragma unroll
                for (int n = 0; n < 2; ++n) acc[a][b][m][n] = (f32x4){0.f, 0.f, 0.f, 0.f};
    bf16x8 At[4][2], B0[2][2], B1[2][2];
    const char* cA = (const char*)g.A + (size_t)cur.pm * tstep; const char* cB = (const char*)g.Bt + (size_t)cur.pn * tstep;
    S.a_ready(cur);
    if constexpr (SP2) {
        PG8_STAGE(PG8_SB(0, 0), cB, voffB); PG8_STAGE(PG8_SB(0, 1), cB + hstep, voffB); PG8_STAGE(PG8_SA(0, 0), cA, voffA); PG8_STAGE(PG8_SA(0, 1), cA + hstep, voffA);
        if (wr == 1) PG8_BAR;
        PG8_WAIT_V(2); PG8_BAR;
        PG8_STAGE(PG8_SB(1, 0), cB + kstep, voffB); PG8_STAGE(PG8_SA(1, 0), cA + kstep, voffA); PG8_STAGE(PG8_SB(1, 1), cB + hstep + kstep, voffB);
        PG8_WAIT_V(6); PG8_BAR;
    } else {
        PG8_STAGE(PG8_SB(0, 0), cB, voffB); PG8_STAGE(PG8_SA(0, 0), cA, voffA); PG8_STAGE(PG8_SB(0, 1), cB + hstep, voffB); PG8_STAGE(PG8_SA(0, 1), cA + hstep, voffA);
        if (wr == 1) PG8_BAR;
        PG8_WAIT_V(4); PG8_BAR;
        PG8_STAGE(PG8_SB(1, 0), cB + kstep, voffB); PG8_STAGE(PG8_SA(1, 0), cA + kstep, voffA); PG8_STAGE(PG8_SB(1, 1), cB + hstep + kstep, voffB);
        PG8_WAIT_V(6); PG8_BAR;
    }
    for (;;) {
        const bool has_next = S.next(ui + 1, nxt);
        const char* nA = has_next ? (const char*)g.A + (size_t)nxt.pm * tstep : cA; const char* nB = has_next ? (const char*)g.Bt + (size_t)nxt.pn * tstep : cB;
        for (int t = 0; t < nt; t += 2) {
            const bool last = (t == nt - 2);
            const char* a1 = cA + (size_t)(t + 1) * kstep;
            const char* a2 = last ? nA : cA + (size_t)(t + 2) * kstep; const char* b2 = last ? nB : cB + (size_t)(t + 2) * kstep;
            const char* a3 = a2 + kstep; const char* b3 = b2 + kstep;
            if (last && has_next) S.a_ready(nxt);
            if constexpr (SP2) {
            PG8_LDB(B0, 0, 0); PG8_LDB(B1, 0, 1); PG8_SCHED; PG8_LDA(At, 0, 0); PG8_STAGE(PG8_SA(1, 1), a1 + hstep, voffA);
            PG8_WAIT_V(8); PG8_WAIT_L(0); PG8_BAR; PG8_MMA(0, 0, At, B0); PG8_MMA(0, 1, At, B1); PG8_BAR; PG8_SCHED;
            PG8_LDA(At, 0, 1); PG8_STAGE(PG8_SB(0, 0), b2, voffB); PG8_STAGE(PG8_SB(0, 1), b2 + hstep, voffB); PG8_STAGE(PG8_SA(0, 0), a2, voffA);
            PG8_WAIT_V(8); PG8_WAIT_L(0); PG8_BAR; PG8_MMA(1, 0, At, B0); PG8_MMA(1, 1, At, B1); PG8_BAR; PG8_SCHED;
            PG8_LDB(B0, 1, 0); PG8_LDB(B1, 1, 1); PG8_SCHED; PG8_LDA(At, 1, 0); PG8_STAGE(PG8_SA(0, 1), a2 + hstep, voffA);
            PG8_WAIT_V(8); PG8_WAIT_L(0); PG8_BAR; PG8_MMA(0, 0, At, B0); PG8_MMA(0, 1, At, B1); PG8_BAR; PG8_SCHED;
            PG8_LDA(At, 1, 1); PG8_STAGE(PG8_SB(1, 0), b3, voffB); PG8_STAGE(PG8_SB(1, 1), b3 + hstep, voffB); PG8_STAGE(PG8_SA(1, 0), a3, voffA);
            PG8_WAIT_V(8); PG8_WAIT_L(0); PG8_BAR; PG8_MMA(1, 0, At, B0); PG8_MMA(1, 1, At, B1); PG8_BAR; PG8_SCHED;
            } else {
            PG8_LDB(B0, 0, 0); PG8_SCHED; PG8_LDA(At, 0, 0); PG8_STAGE(PG8_SA(1, 1), a1 + hstep, voffA);
            PG8_WAIT_L(8); PG8_BAR; PG8_WAIT_L(0); PG8_MMA(0, 0, At, B0); PG8_BAR; PG8_SCHED;
            PG8_LDB(B1, 0, 1); PG8_STAGE(PG8_SB(0, 0), b2, voffB);
            PG8_BAR; PG8_WAIT_L(0); PG8_MMA(0, 1, At, B1); PG8_BAR;
            PG8_LDA(At, 0, 1); PG8_STAGE(PG8_SA(0, 0), a2, voffA);
            PG8_BAR; PG8_WAIT_L(0); PG8_MMA(1, 0, At, B0); PG8_BAR; PG8_SCHED;
            PG8_STAGE(PG8_SB(0, 1), b2 + hstep, voffB);
            PG8_WAIT_V(6); PG8_BAR; PG8_MMA(1, 1, At, B1); PG8_BAR;
            PG8_LDB(B0, 1, 0); PG8_SCHED; PG8_LDA(At, 1, 0); PG8_STAGE(PG8_SA(0, 1), a2 + hstep, voffA);
            PG8_WAIT_L(8); PG8_BAR; PG8_WAIT_L(0); PG8_MMA(0, 0, At, B0); PG8_BAR; PG8_SCHED;
            PG8_LDB(B1, 1, 1); PG8_STAGE(PG8_SB(1, 0), b3, voffB);
            PG8_BAR; PG8_WAIT_L(0); PG8_MMA(0, 1, At, B1); PG8_BAR;
            PG8_LDA(At, 1, 1); PG8_STAGE(PG8_SA(1, 0), a3, voffA);
            PG8_BAR; PG8_WAIT_L(0); PG8_MMA(1, 0, At, B0); PG8_BAR; PG8_SCHED;
            PG8_STAGE(PG8_SB(1, 1), b3 + hstep, voffB);
            PG8_WAIT_V(6); PG8_BAR; PG8_MMA(1, 1, At, B1); PG8_BAR;
            }
        }
        if constexpr (ALIGN_EPI) { if (wr == 0) PG8_BAR; }
        if constexpr (!Epi::AFTER_DRAIN) { E(acc, cur, wr, wc, fr, fq); S.done(cur); }
        if (!has_next) break;
#pragma unroll
        for (int a = 0; a < 2; ++a)
#pragma unroll
            for (int b = 0; b < 2; ++b)
#pragma unroll
                for (int m = 0; m < 4; ++m)
#pragma unroll
                    for (int n = 0; n < 2; ++n) acc[a][b][m][n] = (f32x4){0.f, 0.f, 0.f, 0.f};
        cur = nxt; cA = nA; cB = nB; ++ui;
        if constexpr (ALIGN_EPI) { if (wr == 1) PG8_BAR; }
    }
    PG8_WAIT_V(0);
    if constexpr (!ALIGN_EPI) { if (wr == 0) PG8_BAR; }
    PG8_BAR;
    if constexpr (Epi::AFTER_DRAIN) { E.fused(acc, cur, wr, wc, fr, fq, lds, wid, lane); S.done(cur); }
#undef PG8_SA
#undef PG8_SB
#undef PG8_STAGE
#undef PG8_LDA
#undef PG8_LDB
#undef PG8_MMA
#undef PG8_WAIT_V
#undef PG8_WAIT_L
#undef PG8_BAR
#undef PG8_SCHED
}
}
constexpr int NWAVES = 8;
constexpr int DM = 2048, BATCH = 2, SEQ = 4096, DEPTH = 4, CTXL = 256, FF = 5632, HD = 128, NMOD = 9;
constexpr int ML = BATCH * SEQ, MC = BATCH * CTXL, MA = ML + MC;
constexpr int INC = 4096, DMIX = 2048, SGW = 512, HYW = 512;
constexpr int A_END = 1024, Q_END = 2048, K_END = 2304, V_END = 2560;
constexpr float NORM_EPS = 1e-6f;
constexpr float QSCALE = 0.08838834764831845f * 1.4426950408889634f;
constexpr float LOG2E = 1.4426950408889634f;
#ifndef MK_MULTI
#define MK_MULTI 1
#endif

constexpr size_t MiB = 1u << 20;
constexpr size_t WS_CTL = 0, CTL_ZERO_BYTES = 1 * MiB;
constexpr size_t WS_MOD = 1 * MiB;
constexpr size_t WS_ROPE = 2 * MiB;
constexpr size_t WS_KFS = 2 * MiB + 65536;
constexpr size_t WS_HD2 = 3 * MiB;
constexpr size_t WS_KFL = 8 * MiB;
constexpr size_t WS_KFC = 136 * MiB;
constexpr size_t WS_X = 144 * MiB;
constexpr size_t WS_XN = 212 * MiB;
constexpr size_t WS_H = 246 * MiB;
constexpr size_t WS_Y = 340 * MiB;
constexpr size_t WS_AU = 408 * MiB;
constexpr size_t WS_QB = 425 * MiB;
constexpr size_t WS_KB = 442 * MiB;
constexpr size_t WS_VTL = 447 * MiB;
constexpr size_t WS_VTC = 451 * MiB;
constexpr size_t WS_HZL = 452 * MiB;
constexpr size_t WS_HZC = 500 * MiB;
constexpr size_t WS_MIX = 503 * MiB;
constexpr size_t WS_W = 537 * MiB;
constexpr size_t WL_GU1 = 0, WL_D1 = 44 * MiB, WL_IN = 66 * MiB, WL_OUT = 82 * MiB, WL_GU2 = 90 * MiB, WL_D2 = 134 * MiB, WL_STRIDE = 156 * MiB;
constexpr size_t WS_END = WS_W + DEPTH * WL_STRIDE;
constexpr int CW_TMO = 0, CW_CODE = 1;
constexpr int CW_BAR = 4096;
constexpr int CW_Q = 16384;
static_assert((CW_Q + 16 * 64) * 4 <= (int)CTL_ZERO_BYTES, "CTL words inside the memset region");

constexpr int RING_OFF = 0, RING_BYTES = 139264;
constexpr int LDSCTL_OFF = RING_BYTES, MISC_OFF = LDSCTL_OFF + 320;
constexpr int LDS_BYTES = 147456;
static_assert(MISC_OFF + 128 <= LDS_BYTES, "LDS map");
static_assert(WS_ROPE == pg8::WSO_ROPE && WS_AU == pg8::WSO_AU && WS_QB == pg8::WSO_QB && WS_KB == pg8::WSO_KB && WS_VTL == pg8::WSO_VTL && WS_VTC == pg8::WSO_VTC && WS_HZL == pg8::WSO_HZL && WS_HZC == pg8::WSO_HZC, "EpiWin offsets");
#define GAS __attribute__((address_space(1)))
#define LAS __attribute__((address_space(3)))
typedef unsigned short bf16;
typedef unsigned v4u __attribute__((ext_vector_type(4)));
typedef float f32x4 __attribute__((ext_vector_type(4)));
typedef short bf16x8 __attribute__((ext_vector_type(8)));
typedef GAS unsigned gu32;
typedef GAS unsigned long long gu64;
#define RLX_AGENT __ATOMIC_RELAXED, __HIP_MEMORY_SCOPE_AGENT
#define LDS_WAIT() asm volatile("s_waitcnt lgkmcnt(0)" ::: "memory")
#define VM_WAIT() asm volatile("s_waitcnt vmcnt(0)" ::: "memory")
__device__ __forceinline__ unsigned long long rt() { return __builtin_amdgcn_s_memrealtime(); }
__device__ __forceinline__ unsigned f2bf(float f) { unsigned u = __builtin_bit_cast(unsigned, f); return (u + 0x7fffu + ((u >> 16) & 1u)) >> 16; }
__device__ __forceinline__ unsigned pk2(float lo, float hi) { return f2bf(lo) | (f2bf(hi) << 16); }

#define XB_TMO      128
#define XB_XCNT(j)  (256  + 64 * (j))
#define XB_XSUB(j)  (1280 + 64 * (j))
#define XB_XGEN(j)  (2304 + 64 * (j))
#define XB_TOP      3328
#define XB_TOPGEN   3392
#define XCD_BAR_WORDS 3456
#define XB_SPIN_CAP (1u << 18)

__device__ __forceinline__ unsigned xb_ld(unsigned* p)              { return __hip_atomic_load(p, __ATOMIC_RELAXED, __HIP_MEMORY_SCOPE_AGENT); }
__device__ __forceinline__ unsigned xb_add(unsigned* p, unsigned v) { return __hip_atomic_fetch_add(p, v, __ATOMIC_RELAXED, __HIP_MEMORY_SCOPE_AGENT); }
__device__ __forceinline__ unsigned xb_xcc_id() { return (unsigned)__builtin_amdgcn_s_getreg((3 << 11) | 20) & 0xFu; }
#define XB_SPIN(cond, bar) do { unsigned _sp = 0; while (cond) { __builtin_amdgcn_s_sleep(1); \
    if ((++_sp & 255u) == 0u) { if (xb_ld(&(bar)[XB_TMO])) break; if (_sp > XB_SPIN_CAP) { atomicAdd(&(bar)[XB_TMO], 1u); break; } } } } while (0)

struct XcdBarrier {
    unsigned* bar; unsigned x;
    volatile LAS unsigned* st;
};

__device__ __forceinline__ XcdBarrier xcd_barrier_post(unsigned* bar, volatile LAS unsigned* st) {
    XcdBarrier b; b.bar = bar; b.x = xb_xcc_id(); b.st = st;
    if (threadIdx.x == 0) (void)xb_add(&bar[XB_XCNT(b.x)], 1u);
    return b;
}
__device__ __forceinline__ void xcd_barrier_complete(unsigned* bar, unsigned x, unsigned& nloc, unsigned& nx) {
    const unsigned G = gridDim.x * gridDim.y * gridDim.z;
    unsigned sum, cnt, mine, sp = 0u;
    for (;;) {
        sum = 0u; cnt = 0u; mine = 0u;
#pragma unroll
        for (unsigned j = 0; j < 16; ++j) { const unsigned c = xb_ld(&bar[XB_XCNT(j)]); sum += c; cnt += (c > 0u) ? 1u : 0u; mine = (j == x) ? c : mine; }
        if (sum == G) break;
        __builtin_amdgcn_s_sleep(1);
        if ((++sp & 255u) == 0u) { if (xb_ld(&bar[XB_TMO])) break; if (sp > XB_SPIN_CAP) { atomicAdd(&bar[XB_TMO], 1u); break; } }
    }
    nloc = mine > 0u ? mine : 1u; nx = cnt > 0u ? cnt : 1u;
}

__device__ __forceinline__ void xcd_barrier(const XcdBarrier& b) {
    asm volatile("s_waitcnt vmcnt(0)" ::: "memory");
    __syncthreads();
    if (threadIdx.x == 0) {
        unsigned* bar = b.bar;
        __builtin_amdgcn_s_waitcnt(0);
        unsigned nloc = b.st[0], nx = b.st[1];
        if (nloc == 0u) { xcd_barrier_complete(bar, b.x, nloc, nx); b.st[0] = nloc; b.st[1] = nx; }
        const unsigned old = xb_add(&bar[XB_XSUB(b.x)], 1u);
        const unsigned gen = old / nloc;
        if (old + 1u == (gen + 1u) * nloc) {
            __builtin_amdgcn_fence(__ATOMIC_RELEASE, "agent");
            asm volatile("s_waitcnt vmcnt(0)" ::: "memory");
            const unsigned og = xb_add(&bar[XB_TOP], 1u);
            const unsigned tg = og / nx;
            if (og + 1u == (tg + 1u) * nx) xb_add(&bar[XB_TOPGEN], 1u);
            else XB_SPIN(xb_ld(&bar[XB_TOPGEN]) == tg, bar);
            __builtin_amdgcn_fence(__ATOMIC_ACQUIRE, "agent");
            xb_add(&bar[XB_XGEN(b.x)], 1u);
            asm volatile("s_waitcnt vmcnt(0)" ::: "memory");
        } else {
            XB_SPIN(xb_ld(&bar[XB_XGEN(b.x)]) == gen, bar);
            __builtin_amdgcn_fence(__ATOMIC_ACQUIRE, "agent");
            asm volatile("s_waitcnt vmcnt(0)" ::: "memory");
        }
    }
    __syncthreads();
}

typedef float f32x2 __attribute__((ext_vector_type(2)));
typedef float f32x16 __attribute__((ext_vector_type(16)));
typedef unsigned u32x2 __attribute__((ext_vector_type(2)));
struct Frame {
    LAS unsigned char* lds;
    volatile LAS unsigned* MISC;
    gu32* ctl;
    int tid, lane, wave, G, bx;
    const float* const* in;
    float* out;
    unsigned char* ws;
};
enum InIdx { I_X = 0, I_C, I_CTX, I_CCTX, I_WADA, I_BADA, I_NORMG, I_F1G, I_F1U, I_F1D, I_WIN, I_SGUG, I_SGUW, I_SGUB, I_SINK, I_HCW, I_HCB, I_HW1, I_HB1, I_HW2, I_HB2, I_HW3, I_HFREQ, I_HSKIP, I_WOUT, I_F2G, I_F2U, I_F2D };

__device__ __forceinline__ float wave_sum(float v) {
#pragma unroll
    for (int o = 1; o < 64; o <<= 1) v += __shfl_xor(v, o);
    return v;
}
__device__ __forceinline__ unsigned cvtpk(float lo, float hi) { return pg8::cvt_pk_bf16(lo, hi); }
__device__ __forceinline__ float bf_lo(unsigned w) { return __uint_as_float(w << 16); }
__device__ __forceinline__ float bf_hi(unsigned w) { return __uint_as_float(w & 0xffff0000u); }
__device__ __forceinline__ float sin_rev(float r) { r -= rintf(r); return __builtin_amdgcn_sinf(r); }
__device__ __forceinline__ float cos_rev(float r) { r -= rintf(r); return __builtin_amdgcn_cosf(r); }
__device__ __forceinline__ float sin_rad(float x) { return sin_rev(x * 0.15915494309189535f); }

__device__ __forceinline__ void p0_transpose_tile(const float* W, int K, int N, bf16* WT, int k0, int n0, int drow0, LAS float* scr, int lane) {
#pragma unroll 8
    for (int i = 0; i < 32; ++i) { const int kk = 2 * i + (lane >> 5); scr[kk * 33 + (lane & 31)] = W[(size_t)(k0 + kk) * N + n0 + (lane & 31)]; }
    LDS_WAIT(); asm volatile("" ::: "memory");
    const int c = lane & 7;
#pragma unroll
    for (int j = 0; j < 4; ++j) { const int n = (lane >> 3) + 8 * j; const LAS float* s = scr + (8 * c) * 33 + n;
        v4u o; o.x = pk2(s[0 * 33], s[1 * 33]); o.y = pk2(s[2 * 33], s[3 * 33]); o.z = pk2(s[4 * 33], s[5 * 33]); o.w = pk2(s[6 * 33], s[7 * 33]);
        *(GAS v4u*)(WT + (size_t)(drow0 + n) * K + k0 + 8 * c) = o; }
    LDS_WAIT(); asm volatile("" ::: "memory");
}
__device__ __forceinline__ int win_drow(int n0) {
    if (n0 < A_END || n0 >= K_END) return n0;
    const bool isq = n0 < Q_END; const int qc = n0 - (isq ? A_END : Q_END);
    const int head = qc >> 7, qd = (qc >> 5) & 3;
    const int pn = isq ? 4 + (head >> 1) : 8;
    return pn * 256 + 128 * (qd & 1) + 64 * (head & 1) + 32 * (qd >> 1);
}
constexpr int CV_FF = (DM / 64) * (FF / 32);
constexpr int CV_IN = (DM / 64) * (INC / 32);
constexpr int CV_OUT = (DM / 64) * (DMIX / 32);
constexpr int CV_LAYER = 6 * CV_FF + CV_IN + CV_OUT;
__device__ __forceinline__ void p0_convert_item(Frame& F, int it, LAS float* scr) {
    const int l = it / CV_LAYER; int r = it % CV_LAYER;
    unsigned char* wl = F.ws + WS_W + (size_t)l * WL_STRIDE;
    const size_t ffo = (size_t)l * DM * FF;
    if (r < 4 * CV_FF) {
        const int which = r / CV_FF; r -= which * CV_FF;
        const float* W = (which == 0 ? F.in[I_F1G] : which == 1 ? F.in[I_F1U] : which == 2 ? F.in[I_F2G] : F.in[I_F2U]) + ffo;
        bf16* WT = (bf16*)(wl + (which < 2 ? WL_GU1 : WL_GU2));
        const int nblk = FF / 32, kb = r / nblk, nb = r % nblk, n0 = 32 * nb;
        const int drow0 = 256 * (n0 >> 7) + 128 * (which & 1) + (n0 & 127);
        p0_transpose_tile(W, DM, FF, WT, 64 * kb, n0, drow0, scr, F.lane); return; }
    r -= 4 * CV_FF;
    if (r < 2 * CV_FF) {
        const int which = r / CV_FF; r -= which * CV_FF;
        const float* W = (which == 0 ? F.in[I_F1D] : F.in[I_F2D]) + ffo;
        bf16* WT = (bf16*)(wl + (which == 0 ? WL_D1 : WL_D2));
        const int nblk = DM / 32, kb = r / nblk, nb = r % nblk;
        p0_transpose_tile(W, FF, DM, WT, 64 * kb, 32 * nb, 32 * nb, scr, F.lane); return; }
    r -= 2 * CV_FF;
    if (r < CV_IN) { const float* W = F.in[I_WIN] + (size_t)l * DM * INC; const int nblk = INC / 32, kb = r / nblk, nb = r % nblk;
        p0_transpose_tile(W, DM, INC, (bf16*)(wl + WL_IN), 64 * kb, 32 * nb, win_drow(32 * nb), scr, F.lane); return; }
    r -= CV_IN;
    { const float* W = F.in[I_WOUT] + (size_t)l * DMIX * DM; const int nblk = DM / 32, kb = r / nblk, nb = r % nblk;
        p0_transpose_tile(W, DMIX, DM, (bf16*)(wl + WL_OUT), 64 * kb, 32 * nb, 32 * nb, scr, F.lane); }
}
__device__ __forceinline__ void p0_ada_item(Frame& F, int it) {
    LAS float* sv = (LAS float*)(F.lds + RING_OFF);
    LAS float* red = sv + 3 * DM;
    const int l = it / 72, nb = it % 72;
    for (int i = F.tid; i < 3 * DM; i += NWAVES * 64) { const int r = i / DM, k = i % DM; const float c = r < 2 ? F.in[I_C][r * DM + k] : F.in[I_CCTX][k]; sv[i] = c / (1.0f + __expf(-c)); }
    __syncthreads();
    const float* W = F.in[I_WADA] + (size_t)l * DM * (NMOD * DM) + nb * 256 + 4 * F.lane;
    f32x4 a0 = {0.f, 0.f, 0.f, 0.f}, a1 = a0, a2 = a0;
    const int kb = F.wave * 256;
#pragma unroll 4
    for (int k = 0; k < 256; ++k) { const f32x4 w = *(const f32x4*)(W + (size_t)(kb + k) * (NMOD * DM));
        a0 += w * sv[kb + k]; a1 += w * sv[DM + kb + k]; a2 += w * sv[2 * DM + kb + k]; }
    *(LAS f32x4*)(red + (F.wave * 3 + 0) * 256 + 4 * F.lane) = a0; *(LAS f32x4*)(red + (F.wave * 3 + 1) * 256 + 4 * F.lane) = a1; *(LAS f32x4*)(red + (F.wave * 3 + 2) * 256 + 4 * F.lane) = a2;
    __syncthreads();
    for (int i = F.tid; i < 3 * 256; i += NWAVES * 64) { const int r = i / 256, n = i % 256; float s = 0.f;
#pragma unroll
        for (int w = 0; w < 8; ++w) s += red[(w * 3 + r) * 256 + n];
        const int col = nb * 256 + n;
        ((float*)(F.ws + WS_MOD))[((size_t)l * 3 + r) * (NMOD * DM) + col] = s + F.in[I_BADA][(size_t)l * (NMOD * DM) + col]; }
    __syncthreads();
}
__device__ __forceinline__ void p0_hd2_row(Frame& F, int l, int tp) {
    const bool ctx = tp >= SEQ; const int L = ctx ? CTXL : SEQ; const int t = ctx ? tp - SEQ : tp; const int lane = F.lane;
    float feat = 0.f;
    if (lane == 0) feat = (float)t / (float)(L - 1);
    else if (lane < 33) { const int j = (lane - 1) & 15; const double band = 1e-4 + (double)j * ((15.0 - 1e-4) / 15.0); const double rev = band * (double)t / (double)L; const float fr = (float)(rev - floor(rev));
        feat = lane < 17 ? __builtin_amdgcn_cosf(fr) : -__builtin_amdgcn_sinf(fr); }
    const float* w1 = F.in[I_HW1] + (size_t)l * 33 * 64; const float* w2 = F.in[I_HW2] + (size_t)l * 64 * 64;
    const float fq = F.in[I_HFREQ][l * 64 + lane];
    float a = F.in[I_HB1][l * 64 + lane];
#pragma unroll
    for (int i = 0; i < 33; ++i) a += __shfl(feat, i) * w1[i * 64 + lane];
    const float h1 = sin_rad(fq * a);
    float b = F.in[I_HB2][l * 64 + lane];
#pragma unroll 16
    for (int i = 0; i < 64; ++i) b += __shfl(h1, i) * w2[i * 64 + lane];
    ((float*)(F.ws + WS_HD2))[((size_t)l * (SEQ + CTXL) + tp) * 64 + lane] = sin_rad(fq * b);
}
__device__ __forceinline__ void p0_rope_entry(Frame& F, int idx) {
    const int a = idx >> 5, i = idx & 31;
    const double inv = exp2(-(double)i * (13.287712379549449 / 32.0));
    double x = (double)a * inv; const double k = rint(x * 0.6366197723675814);
    x = x - k * 1.5707963267948966 - k * 6.123233995736766e-17;
    const double x2 = x * x;
    double s = x * (1.0 + x2 * (-1.0 / 6 + x2 * (1.0 / 120 + x2 * (-1.0 / 5040 + x2 * (1.0 / 362880 + x2 * (-1.0 / 39916800 + x2 * (1.0 / 6227020800.0)))))));
    double c = 1.0 + x2 * (-0.5 + x2 * (1.0 / 24 + x2 * (-1.0 / 720 + x2 * (1.0 / 40320 + x2 * (-1.0 / 3628800 + x2 * (1.0 / 479001600.0 + x2 * (-1.0 / 87178291200.0)))))));
    const int q = ((int)k) & 3; double cs, sn;
    if (q == 0) { cs = c; sn = s; } else if (q == 1) { cs = -s; sn = c; } else if (q == 2) { cs = -c; sn = -s; } else { cs = s; sn = -c; }
    float* rp = (float*)(F.ws + WS_ROPE); rp[idx] = (float)cs; rp[2048 + idx] = (float)sn;
}
__device__ __forceinline__ void p0_prologue(Frame& F) {
#ifndef P0M
#define P0M 15
#endif
    if (P0M & 1) for (int it = F.bx; it < DEPTH * 72; it += F.G) p0_ada_item(F, it);
    const int gw = F.bx * NWAVES + F.wave, NGW = F.G * NWAVES;
    if (P0M & 2) for (int it = gw; it < DEPTH * (SEQ + CTXL); it += NGW) p0_hd2_row(F, it / (SEQ + CTXL), it % (SEQ + CTXL));
    if (P0M & 4) if (F.bx == F.G - 1) for (int i = F.tid; i < 2048; i += NWAVES * 64) p0_rope_entry(F, i);
    LAS float* scr = (LAS float*)(F.lds + RING_OFF + F.wave * 16384);
    if (P0M & 8) for (int it = gw; it < DEPTH * CV_LAYER; it += NGW) p0_convert_item(F, it, scr);
}

__device__ __forceinline__ void p1_filter_item(Frame& F, int it) {
    const int cb = it & 63, Lsel = (it >> 6) & 1, l = it >> 7;
    const int L = Lsel ? CTXL : SEQ;
    LAS float* W3s = (LAS float*)(F.lds + RING_OFF);
    LAS float* red = W3s + 64 * 32;
    for (int i = F.tid; i < 64 * 32; i += NWAVES * 64) { const int j = i >> 5, lc = i & 31; const int o = lc >> 4, dir = (lc >> 3) & 1, ci = lc & 7;
        W3s[i] = F.in[I_HW3][((size_t)l * 64 + j) * 2048 + o * 1024 + dir * 512 + cb * 8 + ci]; }
    __syncthreads();
    float asum[16];
#pragma unroll
    for (int i = 0; i < 16; ++i) asum[i] = 0.f;
    const float* hd2 = (const float*)(F.ws + WS_HD2) + ((size_t)l * (SEQ + CTXL) + (Lsel ? SEQ : 0)) * 64;
    float* kf = Lsel ? (float*)(F.ws + WS_KFC) + ((size_t)l * 512 + cb * 8) * 2 * 512 : (float*)(F.ws + WS_KFL) + ((size_t)l * 512 + cb * 8) * 2 * 8192;
    const int N2 = 2 * L;
    const int nrep = Lsel ? 1 : 8;
    for (int rep = 0; rep < nrep; ++rep) {
        const int t = F.tid + 512 * rep;
        if (t < L) {
            float acc[32];
#pragma unroll
            for (int i = 0; i < 32; ++i) acc[i] = 0.f;
            const f32x4* hrow = (const f32x4*)(hd2 + (size_t)t * 64);
#pragma unroll 2
            for (int j4 = 0; j4 < 16; ++j4) { const f32x4 hv = hrow[j4];
#pragma unroll
                for (int jj = 0; jj < 4; ++jj) { const float h = hv[jj]; const LAS f32x4* wr = (const LAS f32x4*)(W3s + (j4 * 4 + jj) * 32);
#pragma unroll
                    for (int q = 0; q < 8; ++q) { const f32x4 w = wr[q]; acc[4 * q + 0] += h * w[0]; acc[4 * q + 1] += h * w[1]; acc[4 * q + 2] += h * w[2]; acc[4 * q + 3] += h * w[3]; } } }
            const float tn = (float)t / (float)(L - 1);
#pragma unroll
            for (int ci = 0; ci < 8; ++ci) { const int c = cb * 8 + ci;
                const float delta = 15.350567286626973f - (float)c * ((15.350567286626973f - 3.0701134573253945f) / 511.0f);
                const float dec = __expf(-tn * delta);
#pragma unroll
                for (int o = 0; o < 2; ++o) { const float vf = acc[o * 16 + ci] * dec, vb = acc[o * 16 + 8 + ci] * dec;
                    asum[o * 8 + ci] += fabsf(vf) + fabsf(vb);
                    float* kp = kf + ((size_t)ci * 2 + o) * N2;
                    if (t == 0) { kp[0] = vf + vb; kp[L] = 0.f; } else { kp[t] = vf; kp[N2 - t] = vb; } } }
        }
    }
#pragma unroll
    for (int i = 0; i < 16; ++i) { const float s = wave_sum(asum[i]); if (F.lane == 0) red[F.wave * 16 + i] = s; }
    __syncthreads();
    if (F.tid < 16) { float s = 0.f;
#pragma unroll
        for (int w = 0; w < 8; ++w) s += red[w * 16 + F.tid];
        const int o = F.tid >> 3, ci = F.tid & 7;
        ((float*)(F.ws + WS_KFS))[(((size_t)l * 2 + Lsel) * 2 + o) * 512 + cb * 8 + ci] = 1.0f / (s + 1e-6f); }
    __syncthreads();
}

template <bool HAS_Y, bool HAS_NEXT, bool FINAL>
__device__ __forceinline__ void thin_row(Frame& F, int row, int l, int k, float coef, int ln, int kn) {
    const int r = row < ML ? (row >> 12) : 2;
    const int lane = F.lane;
    f32x4 xv[8];
    const float* xsrc;
    if (HAS_Y) xsrc = (const float*)(F.ws + WS_X) + (size_t)row * DM;
    else xsrc = row < ML ? F.in[I_X] + (size_t)row * DM : F.in[I_CTX] + (size_t)(row - ML) * DM;
#pragma unroll
    for (int j = 0; j < 8; ++j) xv[j] = *(const GAS f32x4*)(xsrc + 4 * lane + 256 * j);
    if (HAS_Y) {
        const float* yrow = (const float*)(F.ws + WS_Y) + (size_t)row * DM;
        const float* gate = (const float*)(F.ws + WS_MOD) + ((size_t)l * 3 + r) * (NMOD * DM) + (3 * k + 2) * DM;
        const float* gp = F.in[I_NORMG] + ((size_t)l * 6 + 2 * k + 1) * DM;
        f32x4 yv[8]; float ss = 0.f;
#pragma unroll
        for (int j = 0; j < 8; ++j) { yv[j] = *(const GAS f32x4*)(yrow + 4 * lane + 256 * j); ss += (yv[j].x * yv[j].x + yv[j].y * yv[j].y) + (yv[j].z * yv[j].z + yv[j].w * yv[j].w); }
        const float rstd = coef * rsqrtf(wave_sum(ss) * (1.0f / DM) + NORM_EPS);
#pragma unroll
        for (int j = 0; j < 8; ++j) { const f32x4 g = *(const f32x4*)(gate + 4 * lane + 256 * j), q = *(const f32x4*)(gp + 4 * lane + 256 * j); xv[j] += (yv[j] * rstd) * (g * q); }
    }
    if (FINAL) { if (row < ML) {
#pragma unroll
        for (int j = 0; j < 8; ++j) *(GAS f32x4*)(F.out + (size_t)row * DM + 4 * lane + 256 * j) = xv[j]; }
    } else {
#pragma unroll
        for (int j = 0; j < 8; ++j) *(GAS f32x4*)((float*)(F.ws + WS_X) + (size_t)row * DM + 4 * lane + 256 * j) = xv[j];
    }
    if (HAS_NEXT) {
        float ss = 0.f;
#pragma unroll
        for (int j = 0; j < 8; ++j) ss += (xv[j].x * xv[j].x + xv[j].y * xv[j].y) + (xv[j].z * xv[j].z + xv[j].w * xv[j].w);
        const float rstd = rsqrtf(wave_sum(ss) * (1.0f / DM) + NORM_EPS);
        const float* mod = (const float*)(F.ws + WS_MOD) + ((size_t)ln * 3 + r) * (NMOD * DM) + (3 * kn) * DM;
        const float* gq = F.in[I_NORMG] + ((size_t)ln * 6 + 2 * kn) * DM;
        bf16* xn = (bf16*)(F.ws + WS_XN) + (size_t)row * DM;
#pragma unroll
        for (int j = 0; j < 8; ++j) { const f32x4 g = *(const f32x4*)(gq + 4 * lane + 256 * j), sc = *(const f32x4*)(mod + 4 * lane + 256 * j), sh = *(const f32x4*)(mod + DM + 4 * lane + 256 * j);
            const f32x4 o = (xv[j] * rstd) * g * (sc + 1.0f) + sh;
            u32x2 w; w.x = cvtpk(o.x, o.y); w.y = cvtpk(o.z, o.w); *(GAS u32x2*)(xn + 4 * lane + 256 * j) = w; }
    }
}
template <bool HAS_Y, bool HAS_NEXT, bool FINAL>
__device__ __forceinline__ void thin_phase(Frame& F, int l, int k, float coef, int ln, int kn) {
    const int gw = F.bx * NWAVES + F.wave, NGW = F.G * NWAVES;
    for (int row = gw; row < MA; row += NGW) thin_row<HAS_Y, HAS_NEXT, FINAL>(F, row, l, k, coef, ln, kn);
}
typedef float cpx __attribute__((ext_vector_type(2)));
__device__ __forceinline__ cpx cmul(cpx a, cpx b) { return cpx{a.x * b.x - a.y * b.y, a.x * b.y + a.y * b.x}; }
__device__ __forceinline__ cpx cadd(cpx a, cpx b) { return cpx{a.x + b.x, a.y + b.y}; }
__device__ __forceinline__ cpx csub(cpx a, cpx b) { return cpx{a.x - b.x, a.y - b.y}; }
template <bool INV> __device__ __forceinline__ cpx mul_mi(cpx a) { return INV ? cpx{-a.y, a.x} : cpx{a.y, -a.x}; }
template <bool INV> __device__ __forceinline__ cpx twid(float frac) { const float c = __builtin_amdgcn_cosf(frac), s = __builtin_amdgcn_sinf(frac); return cpx{c, INV ? s : -s}; }
template <bool INV> __device__ __forceinline__ void dft4(cpx& a0, cpx& a1, cpx& a2, cpx& a3) {
    const cpx s0 = cadd(a0, a2), s1 = csub(a0, a2), s2 = cadd(a1, a3), s3 = mul_mi<INV>(csub(a1, a3));
    a0 = cadd(s0, s2); a2 = csub(s0, s2); a1 = cadd(s1, s3); a3 = csub(s1, s3);
}
template <bool INV> __device__ __forceinline__ void dft16(cpx (&v)[16]) {
    constexpr float C1 = 0.9238795325112867f, S1 = 0.3826834323650898f, R = 0.7071067811865476f;
    cpx t[4][4];
#pragma unroll
    for (int j = 0; j < 4; ++j) { cpx a0 = v[j], a1 = v[j + 4], a2 = v[j + 8], a3 = v[j + 12]; dft4<INV>(a0, a1, a2, a3); t[0][j] = a0; t[1][j] = a1; t[2][j] = a2; t[3][j] = a3; }
    const float sg = INV ? 1.0f : -1.0f;
    t[1][1] = cmul(t[1][1], cpx{C1, sg * S1}); t[1][2] = cmul(t[1][2], cpx{R, sg * R});   t[1][3] = cmul(t[1][3], cpx{S1, sg * C1});
    t[2][1] = cmul(t[2][1], cpx{R, sg * R});   t[2][2] = mul_mi<INV>(t[2][2]);             t[2][3] = cmul(t[2][3], cpx{-R, sg * R});
    t[3][1] = cmul(t[3][1], cpx{S1, sg * C1}); t[3][2] = cmul(t[3][2], cpx{-R, sg * R});  t[3][3] = cmul(t[3][3], cpx{-C1, -sg * S1});
#pragma unroll
    for (int q = 0; q < 4; ++q) { cpx a0 = t[q][0], a1 = t[q][1], a2 = t[q][2], a3 = t[q][3]; dft4<INV>(a0, a1, a2, a3); v[q] = a0; v[4 + q] = a1; v[8 + q] = a2; v[12 + q] = a3; }
}
constexpr int FFT_HALF_STRIDE = 4096 + 256;
__device__ __forceinline__ int fpos(int e) { return e + (e >> 4); }
template <bool INV, int LOGN> __device__ __forceinline__ void fft_pass(LAS cpx* reg, int tid) {
    constexpr int n = 1 << LOGN, st = n >> 4;
    asm volatile("" : "+v"(tid));
    const int u = tid & 255; LAS cpx* base = reg + (tid >> 8) * FFT_HALF_STRIDE;
    const int j = u & (st - 1), b0 = (u >> (LOGN - 4)) << LOGN;
    cpx v[16];
#pragma unroll
    for (int q = 0; q < 16; ++q) v[q] = base[fpos(b0 + j + q * st)];
    if (INV) {
        if (LOGN > 4) {
#pragma unroll
            for (int q = 1; q < 16; ++q) v[q] = cmul(v[q], twid<true>((float)((j * q) & (n - 1)) * (1.0f / n)));
        }
        dft16<true>(v);
    } else {
        dft16<false>(v);
        if (LOGN > 4) {
#pragma unroll
            for (int q = 1; q < 16; ++q) v[q] = cmul(v[q], twid<false>((float)((j * q) & (n - 1)) * (1.0f / n)));
        }
    }
#pragma unroll
    for (int q = 0; q < 16; ++q) base[fpos(b0 + j + q * st)] = v[q];
}
__device__ __forceinline__ void fft_fwd(LAS cpx* reg, int tid) {
    fft_pass<false, 12>(reg, tid); __syncthreads(); fft_pass<false, 8>(reg, tid); __syncthreads(); fft_pass<false, 4>(reg, tid); __syncthreads();
}
__device__ __forceinline__ void fft_inv(LAS cpx* reg, int tid) {
    fft_pass<true, 4>(reg, tid); __syncthreads(); fft_pass<true, 8>(reg, tid); __syncthreads(); fft_pass<true, 12>(reg, tid); __syncthreads();
}
__device__ __forceinline__ float short_conv(const float* z, int t, int L, float w0, float w1, float w2, float b) {
    const float zm = t > 0 ? z[t - 1] : 0.f, z0 = z[t], zp = t < L - 1 ? z[t + 1] : 0.f;
    return zm * w0 + z0 * w1 + zp * w2 + b;
}
__device__ __forceinline__ void load_filter_fft(Frame& F, LAS cpx* RB, const float* kf, float sc) {
    int tq = F.tid; asm volatile("" : "+v"(tq));
#pragma unroll
    for (int i = 0; i < 8; ++i) { const int j = tq + 512 * i; const float k0 = kf[j] * sc, k1 = kf[j + 4096] * sc; const float d = k0 - k1;
        const float fr = (float)j * (1.0f / 8192.0f); const float c = __builtin_amdgcn_cosf(fr), s = __builtin_amdgcn_sinf(fr);
        RB[fpos(j)] = cpx{k0 + k1, 0.f}; RB[FFT_HALF_STRIDE + fpos(j)] = cpx{d * c, -d * s}; }
    __syncthreads();
    fft_fwd(RB, F.tid);
}
__device__ __forceinline__ void fft_conv(Frame& F, LAS cpx* RA, LAS cpx* RB, const float (&u0)[8], const float (&u1)[8], float (&y0)[8], float (&y1)[8]) {
    int tq = F.tid; asm volatile("" : "+v"(tq));
#pragma unroll
    for (int i = 0; i < 8; ++i) { const int j = tq + 512 * i; const float fr = (float)j * (1.0f / 8192.0f); const cpx w = cpx{__builtin_amdgcn_cosf(fr), -__builtin_amdgcn_sinf(fr)};
        const cpx z = cpx{u0[i], u1[i]}; RA[fpos(j)] = z; RA[FFT_HALF_STRIDE + fpos(j)] = cmul(z, w); }
    __syncthreads();
    fft_fwd(RA, F.tid);
#pragma unroll
    for (int i = 0; i < 16; ++i) { const int e = F.tid + 512 * i; const int p = (e >> 12) * FFT_HALF_STRIDE + fpos(e & 4095); RA[p] = cmul(RA[p], RB[p]); }
    __syncthreads();
    fft_inv(RA, F.tid);
    asm volatile("" : "+v"(tq));
#pragma unroll
    for (int i = 0; i < 8; ++i) { const int j = tq + 512 * i; const float fr = (float)j * (1.0f / 8192.0f); const cpx wc = cpx{__builtin_amdgcn_cosf(fr), __builtin_amdgcn_sinf(fr)};
        const cpx lo = RA[fpos(j)], up = cmul(RA[FFT_HALF_STRIDE + fpos(j)], wc);
        y0[i] = (lo.x + up.x) * (1.0f / 8192.0f); y1[i] = (lo.y + up.y) * (1.0f / 8192.0f); }
    __syncthreads();
}
__device__ __forceinline__ void hyena_lat_item(Frame& F, int l, int c) {
    LAS cpx* RA = (LAS cpx*)(F.lds + RING_OFF); LAS cpx* RB = RA + 2 * FFT_HALF_STRIDE;
    const float* hz0 = (const float*)(F.ws + WS_HZL); const float* hz1 = hz0 + (size_t)1536 * 4096;
    const float* cw = F.in[I_HCW] + (size_t)l * 3 * 1536; const float* cbv = F.in[I_HCB] + (size_t)l * 1536;
    const float* kfl = (const float*)(F.ws + WS_KFL) + ((size_t)l * 512 + c) * 2 * 8192;
    const float* kfs = (const float*)(F.ws + WS_KFS) + ((size_t)l * 2 + 0) * 2 * 512;
    const float sk0 = F.in[I_HSKIP][((size_t)l * 2 + 0) * 512 + c], sk1 = F.in[I_HSKIP][((size_t)l * 2 + 1) * 512 + c];
    float a0[8], a1[8], y0[8], y1[8];
    load_filter_fft(F, RB, kfl, kfs[c]);
    { const float w0 = cw[c], w1 = cw[1536 + c], w2 = cw[3072 + c], b = cbv[c]; int tq = F.tid; asm volatile("" : "+v"(tq));
#pragma unroll
      for (int i = 0; i < 8; ++i) { const int t = tq + 512 * i; a0[i] = short_conv(hz0 + (size_t)c * 4096, t, 4096, w0, w1, w2, b); a1[i] = short_conv(hz1 + (size_t)c * 4096, t, 4096, w0, w1, w2, b); } }
    fft_conv(F, RA, RB, a0, a1, y0, y1);
    { const int cc = 512 + c; const float w0 = cw[cc], w1 = cw[1536 + cc], w2 = cw[3072 + cc], b = cbv[cc]; int tq = F.tid; asm volatile("" : "+v"(tq));
#pragma unroll
      for (int i = 0; i < 8; ++i) { const int t = tq + 512 * i; const float x0 = short_conv(hz0 + (size_t)cc * 4096, t, 4096, w0, w1, w2, b), x1 = short_conv(hz1 + (size_t)cc * 4096, t, 4096, w0, w1, w2, b);
          a0[i] = x0 * (y0[i] + a0[i] * sk0); a1[i] = x1 * (y1[i] + a1[i] * sk0); } }
    load_filter_fft(F, RB, kfl + 8192, kfs[512 + c]);
    fft_conv(F, RA, RB, a0, a1, y0, y1);
    { const int cc = 1024 + c; const float w0 = cw[cc], w1 = cw[1536 + cc], w2 = cw[3072 + cc], b = cbv[cc];
      bf16* mix = (bf16*)(F.ws + WS_MIX) + 1536 + c; int tq = F.tid; asm volatile("" : "+v"(tq));
#pragma unroll
      for (int i = 0; i < 8; ++i) { const int t = tq + 512 * i; const float x0 = short_conv(hz0 + (size_t)cc * 4096, t, 4096, w0, w1, w2, b), x1 = short_conv(hz1 + (size_t)cc * 4096, t, 4096, w0, w1, w2, b);
          const float o0 = x0 * (y0[i] + a0[i] * sk1), o1 = x1 * (y1[i] + a1[i] * sk1);
          mix[(size_t)t * DMIX] = (bf16)f2bf(o0); mix[(size_t)(4096 + t) * DMIX] = (bf16)f2bf(o1); } }
}
__device__ __forceinline__ void hyena_ctx_item(Frame& F, int l, int c) {
    LAS float* K0 = (LAS float*)(F.lds + RING_OFF); LAS float* K1 = K0 + 512; LAS float* U = K1 + 512;
    const float* kfc = (const float*)(F.ws + WS_KFC) + ((size_t)l * 512 + c) * 2 * 512;
    const float* kfs = (const float*)(F.ws + WS_KFS) + ((size_t)l * 2 + 1) * 2 * 512;
    const float* cw = F.in[I_HCW] + (size_t)l * 3 * 1536; const float* cbv = F.in[I_HCB] + (size_t)l * 1536;
    const float sk0 = F.in[I_HSKIP][((size_t)l * 2 + 0) * 512 + c], sk1 = F.in[I_HSKIP][((size_t)l * 2 + 1) * 512 + c];
    const int b = F.tid >> 8, t = F.tid & 255;
    const float* hz = (const float*)(F.ws + WS_HZC) + (size_t)b * 1536 * 256;
    K0[F.tid] = kfc[F.tid] * kfs[c]; K1[F.tid] = kfc[512 + F.tid] * kfs[512 + c];
    const float v = short_conv(hz + (size_t)c * 256, t, 256, cw[c], cw[1536 + c], cw[3072 + c], cbv[c]);
    U[F.tid] = v;
    __syncthreads();
    float y = 0.f;
#pragma unroll 8
    for (int s = 0; s < 256; ++s) y += K0[(t - s) & 511] * U[b * 256 + s];
    const int c1 = 512 + c, c2 = 1024 + c;
    const float x1 = short_conv(hz + (size_t)c1 * 256, t, 256, cw[c1], cw[1536 + c1], cw[3072 + c1], cbv[c1]);
    const float s1 = x1 * (y + v * sk0);
    __syncthreads();
    U[F.tid] = s1;
    __syncthreads();
    float y2 = 0.f;
#pragma unroll 8
    for (int s = 0; s < 256; ++s) y2 += K1[(t - s) & 511] * U[b * 256 + s];
    const float x2 = short_conv(hz + (size_t)c2 * 256, t, 256, cw[c2], cw[1536 + c2], cw[3072 + c2], cbv[c2]);
    const float o = x2 * (y2 + s1 * sk1);
    ((bf16*)(F.ws + WS_MIX))[(size_t)(ML + b * 256 + t) * DMIX + 1536 + c] = (bf16)f2bf(o);
    __syncthreads();
}
constexpr int KT_STRIDE = 272, VT_STRIDE = 264;
constexpr int KT_BYTES = 128 * KT_STRIDE;
__device__ __forceinline__ f32x16 mfma32(bf16x8 a, bf16x8 b, f32x16 c) { return __builtin_amdgcn_mfma_f32_32x32x16_bf16(a, b, c, 0, 0, 0); }
__device__ __forceinline__ void attn_item(Frame& F, int l, int it) {
    const bool lat = it < 256; int nblk, pair, kh, b;
    if (lat) { nblk = it & 31; pair = (it >> 5) & 1; kh = (it >> 6) & 1; b = it >> 7; } else { const int x = it - 256; nblk = x & 1; pair = (x >> 1) & 1; kh = (x >> 2) & 1; b = x >> 3; }
    const int w = F.wave, lane = F.lane, h = lane >> 5, ql = lane & 31;
    const int hq = 4 * kh + 2 * pair + (w >> 2);
    const int qi = 32 * (w & 3) + ql;
    const size_t qrow = (size_t)(lat ? b * SEQ : ML + b * CTXL) + 128 * nblk + qi;
    const bf16* QBp = (const bf16*)(F.ws + WS_QB); const bf16* KBp = (const bf16*)(F.ws + WS_KB);
    const bf16* VTl = (const bf16*)(F.ws + WS_VTL); const bf16* VTc = (const bf16*)(F.ws + WS_VTC);
    LAS unsigned char* Kt = F.lds + RING_OFF; LAS unsigned char* Vt = Kt + KT_BYTES;
    bf16x8 qf[8];
    { const bf16* qp = QBp + qrow * 1024 + hq * 128 + 8 * h;
#pragma unroll
      for (int s = 0; s < 8; ++s) qf[s] = *(const GAS bf16x8*)(qp + 16 * s); }
    float m = F.in[I_SINK][l * 8 + hq] * LOG2E; float lsum = h == 0 ? 1.0f : 0.0f;
    f32x16 O[4];
#pragma unroll
    for (int dt = 0; dt < 4; ++dt)
#pragma unroll
        for (int r = 0; r < 16; ++r) O[dt][r] = 0.f;
    const int ntiles = lat ? 5 : 2;
    for (int ti = 0; ti < ntiles; ++ti) {
        int type = 0; const bf16* ksrc; const bf16* vsrc; int vld;
        if (ti < 2) { ksrc = KBp + (size_t)(ML + b * CTXL + 128 * ti) * 256 + kh * 128; vsrc = VTc + (size_t)((b * 2 + kh) * 128) * 256 + 128 * ti; vld = 256; }
        else { const int kb = nblk + ti - 3; if (kb < 0 || kb > 31) continue;
            ksrc = KBp + (size_t)(b * SEQ + 128 * kb) * 256 + kh * 128; vsrc = VTl + (size_t)((b * 2 + kh) * 128) * 4096 + 128 * kb; vld = 4096; type = ti == 2 ? 1 : (ti == 3 ? 0 : 2); }
        __syncthreads();
#pragma unroll
        for (int i = 0; i < 4; ++i) { const int id = F.tid + 512 * i, row = id >> 4, ch = id & 15;
            const v4u kd = *(const GAS v4u*)(ksrc + (size_t)row * 256 + ch * 8); *(LAS v4u*)(Kt + row * KT_STRIDE + ch * 16) = kd;
            const v4u vd = *(const GAS v4u*)(vsrc + (size_t)row * vld + ch * 8);
            *(LAS u32x2*)(Vt + row * VT_STRIDE + ch * 16) = (u32x2){vd.x, vd.y}; *(LAS u32x2*)(Vt + row * VT_STRIDE + ch * 16 + 8) = (u32x2){vd.z, vd.w}; }
        __syncthreads();
        f32x16 S[4];
#pragma unroll
        for (int sub = 0; sub < 4; ++sub) {
#pragma unroll
            for (int r = 0; r < 16; ++r) S[sub][r] = 0.f;
#pragma unroll
            for (int s = 0; s < 8; ++s) { const bf16x8 a = *(const LAS bf16x8*)(Kt + (32 * sub + ql) * KT_STRIDE + (16 * s + 8 * h) * 2); S[sub] = mfma32(a, qf[s], S[sub]); }
        }
        if (type != 0) {
            int qv = type == 1 ? qi - 4 * h : -(qi - 4 * h); asm volatile("" : "+v"(qv));
#pragma unroll
            for (int sub = 0; sub < 4; ++sub)
#pragma unroll
                for (int r = 0; r < 16; ++r) { const int j0 = 32 * sub + (r & 3) + 8 * (r >> 2); const int jv = type == 1 ? j0 : -j0; if (jv < qv) S[sub][r] = -1e30f; }
        }
        float mx = m;
#pragma unroll
        for (int sub = 0; sub < 4; ++sub)
#pragma unroll
            for (int r = 0; r < 16; ++r) mx = fmaxf(mx, S[sub][r]);
        mx = fmaxf(mx, __shfl_xor(mx, 32));
        const float alpha = __builtin_amdgcn_exp2f(m - mx); m = mx; lsum *= alpha;
#pragma unroll
        for (int dt = 0; dt < 4; ++dt)
#pragma unroll
            for (int r = 0; r < 16; ++r) O[dt][r] *= alpha;
        float ps = 0.f;
#pragma unroll
        for (int sub = 0; sub < 4; ++sub)
#pragma unroll
            for (int r = 0; r < 16; ++r) { const float p = __builtin_amdgcn_exp2f(S[sub][r] - mx); S[sub][r] = p; ps += p; }
        lsum += ps;
#pragma unroll
        for (int sub = 0; sub < 4; ++sub)
#pragma unroll
            for (int s2 = 0; s2 < 2; ++s2) {
                v4u pw; pw.x = cvtpk(S[sub][8 * s2 + 0], S[sub][8 * s2 + 1]); pw.y = cvtpk(S[sub][8 * s2 + 2], S[sub][8 * s2 + 3]); pw.z = cvtpk(S[sub][8 * s2 + 4], S[sub][8 * s2 + 5]); pw.w = cvtpk(S[sub][8 * s2 + 6], S[sub][8 * s2 + 7]);
                const bf16x8 pf = __builtin_bit_cast(bf16x8, pw);
#pragma unroll
                for (int dt = 0; dt < 4; ++dt) { LAS unsigned char* vb = Vt + (32 * dt + ql) * VT_STRIDE + (32 * sub + 16 * s2 + 4 * h) * 2;
                    const u32x2 lo = *(const LAS u32x2*)vb, hi = *(const LAS u32x2*)(vb + 16);
                    const bf16x8 a = __builtin_bit_cast(bf16x8, (v4u){lo.x, lo.y, hi.x, hi.y});
                    O[dt] = mfma32(a, pf, O[dt]); }
            }
    }
    const float lt = lsum + __shfl_xor(lsum, 32); const float inv = 1.0f / lt;
    bf16* op = (bf16*)(F.ws + WS_MIX) + qrow * DMIX + 512 + hq * 128 + 4 * h;
#pragma unroll
    for (int dt = 0; dt < 4; ++dt)
#pragma unroll
        for (int g = 0; g < 4; ++g) { u32x2 wv; wv.x = cvtpk(O[dt][4 * g + 0] * inv, O[dt][4 * g + 1] * inv); wv.y = cvtpk(O[dt][4 * g + 2] * inv, O[dt][4 * g + 3] * inv);
            *(GAS u32x2*)(op + 32 * dt + 8 * g) = wv; }
    __syncthreads();
}
__device__ __forceinline__ void sgu_item(Frame& F, int l, int it) {
    const int n = it >> 2, g = it & 3; const int row0 = 128 * n;
    const int w = F.wave, lane = F.lane, h = lane >> 5, ql = lane & 31;
    LAS unsigned char* VnT = F.lds + RING_OFF;
    const bf16* AU = (const bf16*)(F.ws + WS_AU);
    float gam[8];
#pragma unroll
    for (int k = 0; k < 8; ++k) gam[k] = F.in[I_SGUG][l * 512 + 8 * lane + k];
    for (int rr = 0; rr < 16; ++rr) {
        const int p = 16 * w + rr; const v4u d = *(const GAS v4u*)(AU + (size_t)(row0 + p) * 1024 + 512 + 8 * lane);
        float x[8] = {bf_lo(d.x), bf_hi(d.x), bf_lo(d.y), bf_hi(d.y), bf_lo(d.z), bf_hi(d.z), bf_lo(d.w), bf_hi(d.w)};
        float s = 0.f;
#pragma unroll
        for (int k = 0; k < 8; ++k) s += x[k];
        const float mean = wave_sum(s) * (1.0f / 512.0f); float q = 0.f;
#pragma unroll
        for (int k = 0; k < 8; ++k) { x[k] -= mean; q += x[k] * x[k]; }
        const float rstd = rsqrtf(wave_sum(q) * (1.0f / 512.0f) + NORM_EPS);
        if ((lane >> 4) == g) {
#pragma unroll
            for (int k = 0; k < 8; ++k) { const int cl = 8 * (lane & 15) + k; *(LAS bf16*)(VnT + cl * 272 + p * 2) = (bf16)f2bf(x[k] * rstd * gam[k]); }
        }
    }
    __syncthreads();
    const int ct = w & 3, qt0 = 2 * (w >> 2);
    bf16x8 af[8];
#pragma unroll
    for (int s = 0; s < 8; ++s) af[s] = *(const LAS bf16x8*)(VnT + (32 * ct + ql) * 272 + (16 * s + 8 * h) * 2);
    const float* Ws = F.in[I_SGUW] + ((size_t)l * 4 + g) * 128 * 128;
    bf16* MIXp = (bf16*)(F.ws + WS_MIX);
#pragma unroll
    for (int qq = 0; qq < 2; ++qq) {
        const int q = 32 * (qt0 + qq) + ql;
        f32x16 D;
#pragma unroll
        for (int r = 0; r < 16; ++r) D[r] = 0.f;
#pragma unroll
        for (int s = 0; s < 8; ++s) { const f32x4 w0 = *(const f32x4*)(Ws + (size_t)q * 128 + 16 * s + 8 * h), w1 = *(const f32x4*)(Ws + (size_t)q * 128 + 16 * s + 8 * h + 4);
            const v4u pw = {cvtpk(w0[0], w0[1]), cvtpk(w0[2], w0[3]), cvtpk(w1[0], w1[1]), cvtpk(w1[2], w1[3])};
            D = mfma32(af[s], __builtin_bit_cast(bf16x8, pw), D); }
        const float bs = F.in[I_SGUB][((size_t)l * 4 + g) * 128 + q];
        const size_t row = (size_t)row0 + q;
#pragma unroll
        for (int gi = 0; gi < 4; ++gi) { const int c4 = 128 * g + 32 * ct + 8 * gi + 4 * h;
            const u32x2 uv = *(const GAS u32x2*)(AU + row * 1024 + c4);
            u32x2 o; o.x = cvtpk(bf_lo(uv.x) * (D[4 * gi + 0] + bs), bf_hi(uv.x) * (D[4 * gi + 1] + bs)); o.y = cvtpk(bf_lo(uv.y) * (D[4 * gi + 2] + bs), bf_hi(uv.y) * (D[4 * gi + 3] + bs));
            *(GAS u32x2*)(MIXp + row * DMIX + c4) = o; }
    }
    __syncthreads();
}
#ifndef PHM
#define PHM 0xffffffffu
#endif
#define PON(b) ((PHM >> (b)) & 1u)
__device__ __forceinline__ int grab(Frame& F, int qidx) {
    __syncthreads();
    if (F.tid == 0) F.MISC[16] = __hip_atomic_fetch_add(F.ctl + CW_Q + qidx * 64, 1u, __ATOMIC_RELAXED, __HIP_MEMORY_SCOPE_AGENT);
    __syncthreads();
    return (int)F.MISC[16];
}
__device__ __forceinline__ Frame phase_frame(const Frame& F);
__device__ __forceinline__ void mixer_phase(Frame& F, int l) {
    if (PON(12)) { Frame P = phase_frame(F); for (int it; (it = grab(P, l * 4 + 0)) < 272;) attn_item(P, l, it); }
    if (PON(13)) { Frame P = phase_frame(F); for (int it; (it = grab(P, l * 4 + 1)) < 512;) hyena_lat_item(P, l, it); }
    if (PON(14)) { Frame P = phase_frame(F); for (int it; (it = grab(P, l * 4 + 2)) < 272;) sgu_item(P, l, it); }
    if (PON(15)) { Frame P = phase_frame(F); for (int it; (it = grab(P, l * 4 + 3)) < 512;) hyena_ctx_item(P, l, it); }
}

__device__ __forceinline__ Frame phase_frame(const Frame& F) {
    Frame P = F;
    unsigned long long w = (unsigned long long)P.ws; int gg = P.G, bx = P.bx; asm volatile("" : "+s"(w), "+s"(gg), "+s"(bx)); P.ws = (unsigned char*)w; P.G = gg; P.bx = bx;
    P.ctl = (gu32*)(P.ws + WS_CTL);
    int ln; asm volatile("v_mbcnt_lo_u32_b32 %0, -1, 0\n\tv_mbcnt_hi_u32_b32 %0, -1, %0" : "=v"(ln)); P.lane = ln; P.tid = P.wave * 64 + ln;
    return P;
}
struct Args { const float* in[28]; float* out; unsigned char* ws; int ph_lo, ph_hi; };
constexpr int NPH = 2 + 10 * DEPTH;
__global__ void __launch_bounds__(NWAVES * 64, 2) hymba_fwd(Args args) {
    extern __shared__ __attribute__((aligned(16))) unsigned char lds[];
    Frame F;
    F.lds = (LAS unsigned char*)lds;
    F.MISC = (volatile LAS unsigned*)(F.lds + MISC_OFF);
    F.tid = threadIdx.x; F.lane = F.tid & 63; F.wave = __builtin_amdgcn_readfirstlane(F.tid >> 6);
    F.G = gridDim.x; F.bx = blockIdx.x;
    F.in = args.in;
    F.out = args.out; F.ws = args.ws;
    F.ctl = (gu32*)(args.ws + WS_CTL);
    for (int u = F.tid; u < (LDS_BYTES - LDSCTL_OFF) / 4; u += NWAVES * 64) ((LAS unsigned*)(F.lds + LDSCTL_OFF))[u] = 0u;
    __syncthreads();
    XcdBarrier bar; bar.bar = (unsigned*)(F.ctl + CW_BAR); bar.x = 0; bar.st = nullptr;
    if (!MK_MULTI) bar = xcd_barrier_post((unsigned*)(F.ctl + CW_BAR), F.MISC + 8);
    const int lo = args.ph_lo, hi = args.ph_hi;
#ifndef PHM
#define PHM 0xffffffffu
#endif
#define PON(b) ((PHM >> (b)) & 1u)
#define IN(k) (lo <= (k) && (k) < hi)
#define SEAM(k) do { if (!MK_MULTI && (k) + 1 < hi) xcd_barrier(bar); } while (0)

    if (IN(0)) { if (PON(0)) { Frame P = phase_frame(F); p0_prologue(P); } SEAM(0); }
    if (IN(1)) {
        Frame P = phase_frame(F);
        if (PON(1)) for (int it = P.bx; it < DEPTH * 2 * 64; it += P.G) p1_filter_item(P, it);
        if (PON(2)) thin_phase<false, true, false>(P, 0, 0, 0.f, 0, 0);
        SEAM(1);
    }
    for (int l = 0; l < DEPTH; ++l) {
        const int pb = 2 + 10 * l;
        if (IN(pb + 0) && PON(3)) {
            Frame P = phase_frame(F); unsigned char* wl = P.ws + WS_W + (size_t)l * WL_STRIDE;
            pg8::Gemm g{(const pg8::bf16_t*)(P.ws + WS_XN), (const pg8::bf16_t*)(wl + WL_GU1), MA, 2 * FF, DM}; pg8::StaticOrder S; S.init(MA, 2 * FF, P.G, P.bx);
            pg8::EpiSwiGLU E{(pg8::bf16_t*)(P.ws + WS_H), FF};
            pg8::gemm_phase<pg8::EpiSwiGLU, pg8::StaticOrder, true, true>(P.lds + RING_OFF, g, S, E, P.tid);
        }
        if (IN(pb + 0)) SEAM(pb + 0);
        if (IN(pb + 1) && PON(4)) {
            Frame P = phase_frame(F); unsigned char* wl = P.ws + WS_W + (size_t)l * WL_STRIDE;
            pg8::Gemm g{(const pg8::bf16_t*)(P.ws + WS_H), (const pg8::bf16_t*)(wl + WL_D1), MA, DM, FF}; pg8::StaticOrder S; S.init(MA, DM, P.G, P.bx);
            pg8::EpiF32 E{(float*)(P.ws + WS_Y), DM};
            pg8::gemm_phase<pg8::EpiF32, pg8::StaticOrder, true, true>(P.lds + RING_OFF, g, S, E, P.tid);
        }
        if (IN(pb + 1)) SEAM(pb + 1);
        if (IN(pb + 2)) { if (PON(5)) { Frame P = phase_frame(F); thin_phase<true, true, false>(P, l, 0, 0.5f, l, 1); } SEAM(pb + 2); }
        if (IN(pb + 3) && PON(6)) {
            Frame P = phase_frame(F); unsigned char* wl = P.ws + WS_W + (size_t)l * WL_STRIDE;
            pg8::Gemm g{(const pg8::bf16_t*)(P.ws + WS_XN), (const pg8::bf16_t*)(wl + WL_IN), MA, INC, DM}; pg8::StaticOrder S; S.init(MA, INC, P.G, P.bx);
            pg8::EpiWin E{P.ws, QSCALE};
            pg8::gemm_phase<pg8::EpiWin, pg8::StaticOrder, true, true>(P.lds + RING_OFF, g, S, E, P.tid);
        }
        if (IN(pb + 3)) SEAM(pb + 3);
        if (IN(pb + 4)) { { Frame P = phase_frame(F); mixer_phase(P, l); } SEAM(pb + 4); }
        if (IN(pb + 5) && PON(7)) {
            Frame P = phase_frame(F); unsigned char* wl = P.ws + WS_W + (size_t)l * WL_STRIDE;
            pg8::Gemm g{(const pg8::bf16_t*)(P.ws + WS_MIX), (const pg8::bf16_t*)(wl + WL_OUT), MA, DM, DMIX}; pg8::StaticOrder S; S.init(MA, DM, P.G, P.bx);
            pg8::EpiF32 E{(float*)(P.ws + WS_Y), DM};
            pg8::gemm_phase<pg8::EpiF32, pg8::StaticOrder, true, true>(P.lds + RING_OFF, g, S, E, P.tid);
        }
        if (IN(pb + 5)) SEAM(pb + 5);
        if (IN(pb + 6)) { if (PON(8)) { Frame P = phase_frame(F); thin_phase<true, true, false>(P, l, 1, 1.0f, l, 2); } SEAM(pb + 6); }
        if (IN(pb + 7) && PON(9)) {
            Frame P = phase_frame(F); unsigned char* wl = P.ws + WS_W + (size_t)l * WL_STRIDE;
            pg8::Gemm g{(const pg8::bf16_t*)(P.ws + WS_XN), (const pg8::bf16_t*)(wl + WL_GU2), MA, 2 * FF, DM}; pg8::StaticOrder S; S.init(MA, 2 * FF, P.G, P.bx);
            pg8::EpiSwiGLU E{(pg8::bf16_t*)(P.ws + WS_H), FF};
            pg8::gemm_phase<pg8::EpiSwiGLU, pg8::StaticOrder, true, true>(P.lds + RING_OFF, g, S, E, P.tid);
        }
        if (IN(pb + 7)) SEAM(pb + 7);
        if (IN(pb + 8) && PON(10)) {
            Frame P = phase_frame(F); unsigned char* wl = P.ws + WS_W + (size_t)l * WL_STRIDE;
            pg8::Gemm g{(const pg8::bf16_t*)(P.ws + WS_H), (const pg8::bf16_t*)(wl + WL_D2), MA, DM, FF}; pg8::StaticOrder S; S.init(MA, DM, P.G, P.bx);
            pg8::EpiF32 E{(float*)(P.ws + WS_Y), DM};
            pg8::gemm_phase<pg8::EpiF32, pg8::StaticOrder, true, true>(P.lds + RING_OFF, g, S, E, P.tid);
        }
        if (IN(pb + 8)) SEAM(pb + 8);
        if (IN(pb + 9)) {
            if (PON(11)) { Frame P = phase_frame(F);
                if (l == DEPTH - 1) thin_phase<true, false, true>(P, l, 2, 0.5f, 0, 0);
                else thin_phase<true, true, false>(P, l, 2, 0.5f, l + 1, 0); }
            SEAM(pb + 9);
        }
    }
#undef IN
#undef SEAM
}

extern "C" void kernel_launch(void* const* d_in, const int* in_sizes, int n_in, void* d_out, int out_size, void* d_ws, size_t ws_size, hipStream_t stream) {
    static int grid = 0;
    if (grid == 0) {
        if (n_in != 28 || in_sizes[0] != ML * DM || out_size != ML * DM || ws_size < WS_END) { fprintf(stderr, "kernel_launch: unexpected shapes (n_in %d, in0 %d, out %d, ws %zu < %zu); nothing launched\n", n_in, n_in > 0 ? in_sizes[0] : -1, out_size, ws_size, (size_t)WS_END); grid = -1; return; }
        int dev = 0, cus = 0, per_cu = 0;
        if (hipGetDevice(&dev) != hipSuccess || hipDeviceGetAttribute(&cus, hipDeviceAttributeMultiprocessorCount, dev) != hipSuccess) { grid = -1; return; }
        if (hipFuncSetAttribute((const void*)hymba_fwd, hipFuncAttributeMaxDynamicSharedMemorySize, LDS_BYTES) != hipSuccess) { fprintf(stderr, "kernel_launch: hipFuncSetAttribute failed\n"); grid = -1; return; }
        if (hipOccupancyMaxActiveBlocksPerMultiprocessor(&per_cu, (const void*)hymba_fwd, NWAVES * 64, LDS_BYTES) != hipSuccess || per_cu < 1)
            fprintf(stderr, "kernel_launch: note: occupancy query reports %d workgroups per CU\n", per_cu);
        (void)hipGetLastError();
        grid = cus;
    }
    if (grid < 0) return;
    if (hipMemsetAsync((char*)d_ws + WS_CTL, 0, CTL_ZERO_BYTES, stream) != hipSuccess) { fprintf(stderr, "kernel_launch: hipMemsetAsync failed\n"); return; }
    Args a{};
    for (int i = 0; i < 28; ++i) a.in[i] = (const float*)d_in[i];
    a.out = (float*)d_out; a.ws = (unsigned char*)d_ws;
#if MK_MULTI
    for (int p = 0; p < NPH; ++p) { a.ph_lo = p; a.ph_hi = p + 1; hipLaunchKernelGGL(hymba_fwd, dim3(grid), dim3(NWAVES * 64), LDS_BYTES, stream, a); }
#else
    a.ph_lo = 0; a.ph_hi = NPH;
    hipLaunchKernelGGL(hymba_fwd, dim3(grid), dim3(NWAVES * 64), LDS_BYTES, stream, a);
#endif
    const hipError_t le = hipPeekAtLastError();
    if (le != hipSuccess) fprintf(stderr, "kernel_launch: launch failed: %s\n", hipGetErrorName(le));
}
```

```cpp
#include <hip/hip_runtime.h>
#include <cstdio>
#include <cstdint>
namespace pg8 {
#define PG8_LAS __attribute__((address_space(3)))
typedef unsigned short bf16_t;
typedef short bf16x8 __attribute__((ext_vector_type(8)));
typedef float f32x4 __attribute__((ext_vector_type(4)));
typedef unsigned u32x4 __attribute__((ext_vector_type(4)));
constexpr int BM = 256, BK = 64, HALF = 128, HTB = HALF * BK * 2  , STAGE_BYTES = 8 * HTB, NXCD = 8, WGM = 8;

__host__ __device__ __forceinline__ int lds_byte(int r, int c) { const int st = (r >> 4) * 2 + (c >> 5), rr = r & 15, cc = c & 31, ob = rr * 64 + cc * 2; return st * 1024 + (ob ^ (((ob >> 9) & 1) << 5)); }
__host__ __device__ __forceinline__ void stage_rc(int b, int& R, int& C) { const int st = b / 1024, sb = b % 1024, swz = sb ^ (((sb >> 9) & 1) << 5); R = (st >> 1) * 16 + swz / 64; C = (st & 1) * 32 + (swz % 64) / 2; }
__host__ __device__ __forceinline__ int perm32(int rho) { const int n = rho >> 4, i = rho & 15; return 8 * (i >> 2) + 4 * n + (i & 3); }

struct Unit { int pm, pn, kt0, nt, slab; };
struct Gemm { const bf16_t* A; const bf16_t* Bt; int M, N, K; };

struct StaticOrder {
    int nM, nN, nwg, G, c, ntK;
    __host__ __device__ void init(int M, int N, int K, int G_, int c_) { nM = M / BM; nN = N / BM; nwg = nM * nN; G = G_; c = c_; ntK = K / BK; }
    __host__ __device__ bool next(int i, Unit& u) const {
        const long L = (long)i * G + c; if (L >= nwg) return false;
        int wgid = (int)L; { const int q = nwg / NXCD, r = nwg % NXCD, xcd = wgid % NXCD, off = wgid / NXCD; wgid = (xcd < r ? xcd * (q + 1) : r * (q + 1) + (xcd - r) * q) + off; }
        const int nig = WGM * nN, gid = wgid / nig, fm = gid * WGM, gsz = (nM - fm) < WGM ? (nM - fm) : WGM;
        u.pm = fm + ((wgid % nig) % gsz); u.pn = (wgid % nig) / gsz; u.kt0 = 0; u.nt = ntK; u.slab = -1; return true;
    }
    __device__ __forceinline__ void a_ready(const Unit&) const {}
    __device__ __forceinline__ void done(const Unit&) const {}
};

struct MixedOrder {
    StaticOrder so; int nLat, nCtx, S, ntS;
    __host__ __device__ void init(int N, int K, int S_, int G_, int c_, bool ctx_on = true) { so.init(32 * BM, N, K, G_, c_); nLat = so.nwg; S = S_; nCtx = ctx_on ? 2 * so.nN * S_ : 0; ntS = K / BK / S_; }
    __host__ __device__ bool next(int i, Unit& u) const {
        if (so.next(i, u)) return true;
        const long j = (long)i * so.G + so.c - nLat; if (j >= nCtx) return false;
        const int s = (int)j % S, rest = (int)j / S; u.pm = 32 + (rest & 1); u.pn = rest >> 1; u.kt0 = s * ntS; u.nt = ntS; u.slab = S > 1 ? s : -1; return true;
    }
    __device__ __forceinline__ void a_ready(const Unit&) const {}
    __device__ __forceinline__ void done(const Unit&) const {}
};

__device__ __forceinline__ unsigned cvt_pk_bf16(float lo, float hi) { unsigned r; asm volatile("s_nop 0\n\tv_cvt_pk_bf16_f32 %0, %1, %2" : "=v"(r) : "v"(lo), "v"(hi)); return r; }
typedef float f32x2 __attribute__((ext_vector_type(2)));
__device__ __forceinline__ f32x2 gelu_pk(f32x2 v) {
    const f32x2 av = __builtin_elementwise_abs(v), d = av * 0.2316418882f + 1.0f;
    f32x2 t; t.x = __builtin_amdgcn_rcpf(d.x); t.y = __builtin_amdgcn_rcpf(d.y);
    f32x2 q = t * 0.5307027145f + (-0.7265760135f); q = q * t + 0.7107068705f; q = q * t + (-0.142248368f); q = q * t + 0.127414796f; q = q * t;
    const f32x2 s = (v * v) * (-0.72134752044f);
    f32x2 e; e.x = __builtin_amdgcn_exp2f(s.x); e.y = __builtin_amdgcn_exp2f(s.y);
    const f32x2 m = v * (q * e), r = v - m;
    f32x2 o; o.x = v.x < 0.f ? m.x : r.x; o.y = v.y < 0.f ? m.y : r.y; return o;
}

__device__ __forceinline__ float fast_silu(float g) { return g * __builtin_amdgcn_rcpf(1.0f + __builtin_amdgcn_exp2f(-1.4426950408889634f * g)); }
struct EpiNone { static constexpr bool PERM = true, AFTER_DRAIN = false;
    __device__ __forceinline__ void operator()(const f32x4 (&acc)[2][2][4][2], const Unit& u, int wr, int wc, int fr, int fq) const { asm volatile("" :: "v"(acc[0][0][0][0][0]), "v"(acc[1][1][3][1][3])); } };
struct EpiSwiGLU {
    static constexpr bool PERM = true, AFTER_DRAIN = false;
    bf16_t* O; int ldh;
    __device__ __forceinline__ void operator()(const f32x4 (&acc)[2][2][4][2], const Unit& u, int wr, int wc, int fr, int fq) const {
        const int row0 = u.pm * BM + wr * 64 + fr, col0 = u.pn * HALF + wc * 32 + 8 * fq;
#pragma unroll
        for (int ai = 0; ai < 2; ++ai)
#pragma unroll
            for (int m = 0; m < 4; ++m) {
                bf16_t* rowp = O + (size_t)(row0 + ai * HALF + m * 16) * ldh + col0;
                const f32x4 g0 = acc[ai][0][m][0], g1 = acc[ai][0][m][1], u0 = acc[ai][1][m][0], u1 = acc[ai][1][m][1];
                u32x4 w;
                w.x = cvt_pk_bf16(fast_silu(g0[0]) * u0[0], fast_silu(g0[1]) * u0[1]); w.y = cvt_pk_bf16(fast_silu(g0[2]) * u0[2], fast_silu(g0[3]) * u0[3]);
                w.z = cvt_pk_bf16(fast_silu(g1[0]) * u1[0], fast_silu(g1[1]) * u1[1]); w.w = cvt_pk_bf16(fast_silu(g1[2]) * u1[2], fast_silu(g1[3]) * u1[3]);
                *(u32x4*)rowp = w;
            }
    }
};
struct EpiF32 {
    static constexpr bool PERM = true, AFTER_DRAIN = false;
    bf16_t* O; int ldc; bf16_t* slabs;
    __device__ __forceinline__ void operator()(const f32x4 (&acc)[2][2][4][2], const Unit& u, int wr, int wc, int fr, int fq) const {
        int pm_ = u.pm, pn_ = u.pn, sl_ = u.slab; asm volatile("" : "+s"(pm_), "+s"(pn_), "+s"(sl_));
        const int col0 = pn_ * BM + wc * 32 + 8 * fq;
        bf16_t* rb = (sl_ >= 0 ? slabs + (size_t)((pm_ - 32 + 2 * sl_) * BM) * ldc : O + (size_t)(pm_ * BM) * ldc) + (size_t)(wr * 64 + fr) * ldc + col0;
#pragma unroll
        for (int ai = 0; ai < 2; ++ai)
#pragma unroll
            for (int m = 0; m < 4; ++m) { bf16_t* rowp = rb + (size_t)(ai * HALF + m * 16) * ldc;
#pragma unroll
                for (int bj = 0; bj < 2; ++bj) { const f32x4 v0 = acc[ai][bj][m][0], v1 = acc[ai][bj][m][1];
                    u32x4 w; w.x = cvt_pk_bf16(v0[0], v0[1]); w.y = cvt_pk_bf16(v0[2], v0[3]); w.z = cvt_pk_bf16(v1[0], v1[1]); w.w = cvt_pk_bf16(v1[2], v1[3]);
                    *(u32x4*)(rowp + bj * HALF) = w; } }
    }
};
constexpr size_t WSO_MiB = 1u << 20, WSO_ZS = 1209 * WSO_MiB, WSO_ROPE = 2 * WSO_MiB, WSO_AU = 408 * WSO_MiB, WSO_QB = 425 * WSO_MiB, WSO_KB = 442 * WSO_MiB, WSO_VTL = 447 * WSO_MiB, WSO_VTC = 451 * WSO_MiB, WSO_HZL = 452 * WSO_MiB, WSO_HZC = 500 * WSO_MiB;
struct EpiWin {
    static constexpr bool PERM = true, AFTER_DRAIN = false;
    unsigned char* ws; float qscale;
    __device__ __forceinline__ void store_slab(const f32x4 (&acc)[2][2][4][2], int pm, int pn, int slab, int wr, int wc, int fr, int fq) const {
        bf16_t* zs = (bf16_t*)(ws + WSO_ZS) + ((size_t)slab * 512 + (pm - 32) * BM + wr * 64 + fr) * 4096 + pn * BM + wc * 32 + 8 * fq;
#pragma unroll
        for (int ai = 0; ai < 2; ++ai)
#pragma unroll
            for (int m = 0; m < 4; ++m) { bf16_t* rowp = zs + (size_t)(ai * HALF + m * 16) * 4096;
#pragma unroll
                for (int bj = 0; bj < 2; ++bj) { const f32x4 v0 = acc[ai][bj][m][0], v1 = acc[ai][bj][m][1];
                    u32x4 w; w.x = cvt_pk_bf16(v0[0], v0[1]); w.y = cvt_pk_bf16(v0[2], v0[3]); w.z = cvt_pk_bf16(v1[0], v1[1]); w.w = cvt_pk_bf16(v1[2], v1[3]);
                    *(u32x4*)(rowp + bj * HALF) = w; } }
    }
    __device__ __forceinline__ void operator()(const f32x4 (&acc)[2][2][4][2], const Unit& u, int wr, int wc, int fr, int fq) const {
        int pm_ = u.pm, pn_ = u.pn, sl_ = u.slab; asm volatile("" : "+s"(pm_), "+s"(pn_), "+s"(sl_));
        if (sl_ >= 0) { store_slab(acc, pm_, pn_, sl_, wr, wc, fr, fq); return; }
        finish<2, 4>(acc, pm_ * BM, pm_, pn_, wr, wc, fr, fq);
    }
    template <int NAI, int NM> __device__ __forceinline__ void finish(const f32x4 (&acc)[NAI][2][NM][2], int rbase, int pm_, int pn_, int wr, int wc, int fr_in, int fq_in) const {
        int fr = fr_in, fq = fq_in; asm volatile("" : "+v"(fr), "+v"(fq));
        const int row0 = rbase + wr * 64 + fr; const int pn = pn_; const bool lat = pm_ < 32;
        bf16_t* AU = (bf16_t*)(ws + WSO_AU); bf16_t* QB = (bf16_t*)(ws + WSO_QB); bf16_t* KB = (bf16_t*)(ws + WSO_KB); bf16_t* VTl = (bf16_t*)(ws + WSO_VTL); bf16_t* VTc = (bf16_t*)(ws + WSO_VTC);
        float* HZl = (float*)(ws + WSO_HZL); float* HZc = (float*)(ws + WSO_HZC); const float* ropeC = (const float*)(ws + WSO_ROPE); const float* ropeS = ropeC + 2048;
#ifndef EWM
#define EWM 15
#endif
        if (pn < 4) { if (EWM & 1) {
            const int col0 = pn * BM + wc * 32 + 8 * fq;
#pragma unroll
            for (int ai = 0; ai < NAI; ++ai)
#pragma unroll
                for (int m = 0; m < NM; ++m) { bf16_t* rowp = AU + (size_t)(row0 + ai * HALF + m * 16) * 1024 + col0;
#pragma unroll
                    for (int bj = 0; bj < 2; ++bj) { const f32x4 v0 = acc[ai][bj][m][0], v1 = acc[ai][bj][m][1];
                        const f32x2 a = gelu_pk((f32x2){v0[0], v0[1]}), b = gelu_pk((f32x2){v0[2], v0[3]}), c = gelu_pk((f32x2){v1[0], v1[1]}), d = gelu_pk((f32x2){v1[2], v1[3]});
                        u32x4 w; w.x = cvt_pk_bf16(a.x, a.y); w.y = cvt_pk_bf16(b.x, b.y); w.z = cvt_pk_bf16(c.x, c.y); w.w = cvt_pk_bf16(d.x, d.y);
                        *(u32x4*)(rowp + bj * HALF) = w; } } }
        } else if (pn < 9) { if (EWM & 2) {
            const bool isq = pn < 8; const int head = isq ? 2 * (pn - 4) + (wc >> 1) : (wc >> 1); const int e0 = 32 * (wc & 1) + 8 * fq; const int fi = 8 * fq;
            bf16_t* base = isq ? QB : KB; const int ld = isq ? 1024 : 256; const float sc = isq ? qscale : 1.0f;
#pragma unroll
            for (int ai = 0; ai < NAI; ++ai)
#pragma unroll
                for (int m = 0; m < NM; ++m) { const int r = row0 + ai * HALF + m * 16; bf16_t* rowp = base + (size_t)r * ld + head * 128 + e0;
                    f32x4 x1a = acc[ai][0][m][0], x1b = acc[ai][0][m][1], x2a = acc[ai][1][m][0], x2b = acc[ai][1][m][1];
                    if (lat) { const int pos = r & 4095; const int a = (wc & 1) ? (pos & 63) : (pos >> 6);
                        const f32x4 c0 = *(const f32x4*)(ropeC + a * 32 + fi), c1 = *(const f32x4*)(ropeC + a * 32 + fi + 4), s0 = *(const f32x4*)(ropeS + a * 32 + fi), s1 = *(const f32x4*)(ropeS + a * 32 + fi + 4);
                        const f32x4 o1a = x1a * c0 - x2a * s0, o2a = x2a * c0 + x1a * s0, o1b = x1b * c1 - x2b * s1, o2b = x2b * c1 + x1b * s1;
                        x1a = o1a; x2a = o2a; x1b = o1b; x2b = o2b; }
                    x1a = x1a * sc; x1b = x1b * sc; x2a = x2a * sc; x2b = x2b * sc;
                    u32x4 w1, w2; w1.x = cvt_pk_bf16(x1a[0], x1a[1]); w1.y = cvt_pk_bf16(x1a[2], x1a[3]); w1.z = cvt_pk_bf16(x1b[0], x1b[1]); w1.w = cvt_pk_bf16(x1b[2], x1b[3]);
                    w2.x = cvt_pk_bf16(x2a[0], x2a[1]); w2.y = cvt_pk_bf16(x2a[2], x2a[3]); w2.z = cvt_pk_bf16(x2b[0], x2b[1]); w2.w = cvt_pk_bf16(x2b[2], x2b[3]);
                    *(u32x4*)rowp = w1; *(u32x4*)(rowp + 64) = w2; asm volatile("" ::: "memory"); } }
        } else if (pn == 9) { if (EWM & 4) {
            typedef __attribute__((address_space(1))) bf16_t gbf;
            gbf* vb = (gbf*)(lat ? VTl : VTc); const unsigned ldp = lat ? 4096u : 256u;
#pragma unroll
            for (int ai = 0; ai < NAI; ++ai)
#pragma unroll
                for (int m = 0; m < NM; ++m) { const int r = row0 + ai * HALF + m * 16;
                    const unsigned rb = lat ? (unsigned)(r >> 12) * (256u * 4096u) + (unsigned)(r & 4095) : (unsigned)((r - 8192) >> 8) * (256u * 256u) + (unsigned)((r - 8192) & 255);
#pragma unroll
                    for (int bj = 0; bj < 2; ++bj)
#pragma unroll
                        for (int n = 0; n < 2; ++n) { const f32x4 v = acc[ai][bj][m][n]; const unsigned d0 = (unsigned)(bj * 128 + wc * 32 + 8 * fq + 4 * n);
                            const unsigned p0 = cvt_pk_bf16(v[0], v[1]), p1 = cvt_pk_bf16(v[2], v[3]); const unsigned o = rb + d0 * ldp;
                            vb[o] = (bf16_t)(p0 & 0xffffu); vb[o + ldp] = (bf16_t)(p0 >> 16); vb[o + 2u * ldp] = (bf16_t)(p1 & 0xffffu); vb[o + 3u * ldp] = (bf16_t)(p1 >> 16);
                            asm volatile("" ::: "memory"); } }
        } }
        else { if (EWM & 8) {
            typedef __attribute__((address_space(1))) float gfl;
            gfl* hb = (gfl*)(lat ? HZl : HZc); const unsigned ldp = lat ? 4096u : 256u;
            const unsigned cc0 = (unsigned)((pn - 10) * BM + wc * 32 + 8 * fq);
#pragma unroll
            for (int ai = 0; ai < NAI; ++ai)
#pragma unroll
                for (int m = 0; m < NM; ++m) { const int r = row0 + ai * HALF + m * 16;
                    const unsigned rb = lat ? (unsigned)(r >> 12) * (1536u * 4096u) + (unsigned)(r & 4095) : (unsigned)((r - 8192) >> 8) * (1536u * 256u) + (unsigned)((r - 8192) & 255);
#pragma unroll
                    for (int bj = 0; bj < 2; ++bj)
#pragma unroll
                        for (int n = 0; n < 2; ++n) { const f32x4 v = acc[ai][bj][m][n]; const unsigned o = rb + (cc0 + (unsigned)(bj * 128 + 4 * n)) * ldp;
                            hb[o] = v[0]; hb[o + ldp] = v[1]; hb[o + 2u * ldp] = v[2]; hb[o + 3u * ldp] = v[3];
                            asm volatile("" ::: "memory"); } }
        } }
    }
};
template <class Epi, class Sched, bool ALIGN_EPI = false, bool SP2 = false>
__device__ __forceinline__ void gemm_phase(PG8_LAS unsigned char* lds, const Gemm g, const Sched& S, const Epi& E, const int tid) {
    const int wid = __builtin_amdgcn_readfirstlane(tid >> 6), lane = tid & 63, wr = wid >> 2, wc = wid & 3, fr = lane & 15, fq = lane >> 4;
    const int K = g.K;
    unsigned voffA[2], voffB[2];
#pragma unroll
    for (int i = 0; i < 2; ++i) { int R, C; stage_rc(tid * 16 + i * 8192, R, C); const int Rb = Epi::PERM ? ((R & ~31) + perm32(R & 31)) : R;
        voffA[i] = (unsigned)(R * K + C) * 2u; voffB[i] = (unsigned)(Rb * K + C) * 2u; }
    const size_t kstep = (size_t)(BK * 2);
    const size_t hstep = (size_t)HALF * K * 2;
    const size_t tstep = 2 * hstep;
    const unsigned ldsw = (unsigned)wid * 1024u;
    const int aoff = lds_byte(wr * 64 + fr, fq * 8), boff = lds_byte(wc * 32 + fr, fq * 8);
#define PG8_SA(b, h) (((b) * 2 + (h)) * HTB)
#define PG8_SB(b, h) ((4 + (b) * 2 + (h)) * HTB)
#define PG8_STAGE(bufoff, gbase, voff) do { _Pragma("unroll") for (int _i = 0; _i < 2; ++_i) \
        __builtin_amdgcn_global_load_lds((const unsigned*)((const char*)(gbase) + (voff)[_i]), (PG8_LAS unsigned*)(lds + (bufoff) + ldsw + _i * 8192), 16, 0, 0); } while (0)
#define PG8_LDA(dst, b, h) do { _Pragma("unroll") for (int m = 0; m < 4; ++m) _Pragma("unroll") for (int k = 0; k < 2; ++k) dst[m][k] = *(const PG8_LAS bf16x8*)(lds + PG8_SA(b, h) + aoff + m * 2048 + k * 1024); } while (0)
#define PG8_LDB(dst, b, h) do { _Pragma("unroll") for (int n = 0; n < 2; ++n) _Pragma("unroll") for (int k = 0; k < 2; ++k) dst[n][k] = *(const PG8_LAS bf16x8*)(lds + PG8_SB(b, h) + boff + n * 2048 + k * 1024); } while (0)
#define PG8_MMA(ai, bj, At, Bt) do { __builtin_amdgcn_s_setprio(1); _Pragma("unroll") for (int m = 0; m < 4; ++m) _Pragma("unroll") for (int n = 0; n < 2; ++n) _Pragma("unroll") for (int k = 0; k < 2; ++k) \
        acc[ai][bj][m][n] = __builtin_amdgcn_mfma_f32_16x16x32_bf16(Bt[n][k], At[m][k], acc[ai][bj][m][n], 0, 0, 0); __builtin_amdgcn_s_setprio(0); } while (0)
#define PG8_WAIT_V(n) asm volatile("s_waitcnt vmcnt(" #n ")" ::: "memory")
#define PG8_WAIT_L(n) asm volatile("s_waitcnt lgkmcnt(" #n ")" ::: "memory")
#define PG8_BAR __builtin_amdgcn_s_barrier()
#define PG8_SCHED __builtin_amdgcn_sched_barrier(0)
    Unit cur, nxt; int ui = 0;
    if (!S.next(0, cur)) return;
    f32x4 acc[2][2][4][2];
#pragma unroll
    for (int a = 0; a < 2; ++a)
#pragma unroll
        for (int b = 0; b < 2; ++b)
#pragma unroll
            for (int m = 0; m < 4; ++m)
#pragma unroll
                for (int n = 0; n < 2; ++n) acc[a][b][m][n] = (f32x4){0.f, 0.f, 0.f, 0.f};
    bf16x8 At[4][2], B0[2][2], B1[2][2];
    const char* cA = (const char*)g.A + (size_t)cur.pm * tstep + (size_t)cur.kt0 * kstep; const char* cB = (const char*)g.Bt + (size_t)cur.pn * tstep + (size_t)cur.kt0 * kstep;
    S.a_ready(cur);
    if constexpr (SP2) {
        PG8_STAGE(PG8_SB(0, 0), cB, voffB); PG8_STAGE(PG8_SB(0, 1), cB + hstep, voffB); PG8_STAGE(PG8_SA(0, 0), cA, voffA); PG8_STAGE(PG8_SA(0, 1), cA + hstep, voffA);
        if (wr == 1) PG8_BAR;
        PG8_WAIT_V(2); PG8_BAR;
        PG8_STAGE(PG8_SB(1, 0), cB + kstep, voffB); PG8_STAGE(PG8_SA(1, 0), cA + kstep, voffA); PG8_STAGE(PG8_SB(1, 1), cB + hstep + kstep, voffB);
        PG8_WAIT_V(6); PG8_BAR;
    } else {
        PG8_STAGE(PG8_SB(0, 0), cB, voffB); PG8_STAGE(PG8_SA(0, 0), cA, voffA); PG8_STAGE(PG8_SB(0, 1), cB + hstep, voffB); PG8_STAGE(PG8_SA(0, 1), cA + hstep, voffA);
        if (wr == 1) PG8_BAR;
        PG8_WAIT_V(4); PG8_BAR;
        PG8_STAGE(PG8_SB(1, 0), cB + kstep, voffB); PG8_STAGE(PG8_SA(1, 0), cA + kstep, voffA); PG8_STAGE(PG8_SB(1, 1), cB + hstep + kstep, voffB);
        PG8_WAIT_V(6); PG8_BAR;
    }
    for (;;) {
        const bool has_next = S.next(ui + 1, nxt);
        const char* nA = has_next ? (const char*)g.A + (size_t)nxt.pm * tstep + (size_t)nxt.kt0 * kstep : cA; const char* nB = has_next ? (const char*)g.Bt + (size_t)nxt.pn * tstep + (size_t)nxt.kt0 * kstep : cB;
        const int nt = cur.nt;
        for (int t = 0; t < nt; t += 2) {
            const bool last = (t == nt - 2);
            const char* a1 = cA + (size_t)(t + 1) * kstep;
            const char* a2 = last ? nA : cA + (size_t)(t + 2) * kstep; const char* b2 = last ? nB : cB + (size_t)(t + 2) * kstep;
            const char* a3 = a2 + kstep; const char* b3 = b2 + kstep;
            if (last && has_next) S.a_ready(nxt);
            if constexpr (SP2) {
            PG8_LDB(B0, 0, 0); PG8_LDB(B1, 0, 1); PG8_SCHED; PG8_LDA(At, 0, 0); PG8_STAGE(PG8_SA(1, 1), a1 + hstep, voffA);
            PG8_WAIT_V(8); PG8_WAIT_L(0); PG8_BAR; PG8_MMA(0, 0, At, B0); PG8_MMA(0, 1, At, B1); PG8_BAR; PG8_SCHED;
            PG8_LDA(At, 0, 1); PG8_STAGE(PG8_SB(0, 0), b2, voffB); PG8_STAGE(PG8_SB(0, 1), b2 + hstep, voffB); PG8_STAGE(PG8_SA(0, 0), a2, voffA);
            PG8_WAIT_V(8); PG8_WAIT_L(0); PG8_BAR; PG8_MMA(1, 0, At, B0); PG8_MMA(1, 1, At, B1); PG8_BAR; PG8_SCHED;
            PG8_LDB(B0, 1, 0); PG8_LDB(B1, 1, 1); PG8_SCHED; PG8_LDA(At, 1, 0); PG8_STAGE(PG8_SA(0, 1), a2 + hstep, voffA);
            PG8_WAIT_V(8); PG8_WAIT_L(0); PG8_BAR; PG8_MMA(0, 0, At, B0); PG8_MMA(0, 1, At, B1); PG8_BAR; PG8_SCHED;
            PG8_LDA(At, 1, 1); PG8_STAGE(PG8_SB(1, 0), b3, voffB); PG8_STAGE(PG8_SB(1, 1), b3 + hstep, voffB); PG8_STAGE(PG8_SA(1, 0), a3, voffA);
            PG8_WAIT_V(8); PG8_WAIT_L(0); PG8_BAR; PG8_MMA(1, 0, At, B0); PG8_MMA(1, 1, At, B1); PG8_BAR; PG8_SCHED;
            } else {
            PG8_LDB(B0, 0, 0); PG8_SCHED; PG8_LDA(At, 0, 0); PG8_STAGE(PG8_SA(1, 1), a1 + hstep, voffA);
            PG8_WAIT_L(8); PG8_BAR; PG8_WAIT_L(0); PG8_MMA(0, 0, At, B0); PG8_BAR; PG8_SCHED;
            PG8_LDB(B1, 0, 1); PG8_STAGE(PG8_SB(0, 0), b2, voffB);
            PG8_BAR; PG8_WAIT_L(0); PG8_MMA(0, 1, At, B1); PG8_BAR;
            PG8_LDA(At, 0, 1); PG8_STAGE(PG8_SA(0, 0), a2, voffA);
            PG8_BAR; PG8_WAIT_L(0); PG8_MMA(1, 0, At, B0); PG8_BAR; PG8_SCHED;
            PG8_STAGE(PG8_SB(0, 1), b2 + hstep, voffB);
            PG8_WAIT_V(6); PG8_BAR; PG8_MMA(1, 1, At, B1); PG8_BAR;
            PG8_LDB(B0, 1, 0); PG8_SCHED; PG8_LDA(At, 1, 0); PG8_STAGE(PG8_SA(0, 1), a2 + hstep, voffA);
            PG8_WAIT_L(8); PG8_BAR; PG8_WAIT_L(0); PG8_MMA(0, 0, At, B0); PG8_BAR; PG8_SCHED;
            PG8_LDB(B1, 1, 1); PG8_STAGE(PG8_SB(1, 0), b3, voffB);
            PG8_BAR; PG8_WAIT_L(0); PG8_MMA(0, 1, At, B1); PG8_BAR;
            PG8_LDA(At, 1, 1); PG8_STAGE(PG8_SA(1, 0), a3, voffA);
            PG8_BAR; PG8_WAIT_L(0); PG8_MMA(1, 0, At, B0); PG8_BAR; PG8_SCHED;
            PG8_STAGE(PG8_SB(1, 1), b3 + hstep, voffB);
            PG8_WAIT_V(6); PG8_BAR; PG8_MMA(1, 1, At, B1); PG8_BAR;
            }
        }
        if constexpr (ALIGN_EPI) { if (wr == 0) PG8_BAR; }
        if constexpr (!Epi::AFTER_DRAIN) { E(acc, cur, wr, wc, fr, fq); S.done(cur); }
        if (!has_next) break;
#pragma unroll
        for (int a = 0; a < 2; ++a)
#pragma unroll
            for (int b = 0; b < 2; ++b)
#pragma unroll
                for (int m = 0; m < 4; ++m)
#pragma unroll
                    for (int n = 0; n < 2; ++n) acc[a][b][m][n] = (f32x4){0.f, 0.f, 0.f, 0.f};
        cur = nxt; cA = nA; cB = nB; ++ui;
        if constexpr (ALIGN_EPI) { if (wr == 1) PG8_BAR; }
    }
    PG8_WAIT_V(0);
    if constexpr (!ALIGN_EPI) { if (wr == 0) PG8_BAR; }
    PG8_BAR;
    if constexpr (Epi::AFTER_DRAIN) { E.fused(acc, cur, wr, wc, fr, fq, lds, wid, lane); S.done(cur); }
#undef PG8_SA
#undef PG8_SB
#undef PG8_STAGE
#undef PG8_LDA
#undef PG8_LDB
#undef PG8_MMA
#undef PG8_WAIT_V
#undef PG8_WAIT_L
#undef PG8_BAR
#undef PG8_SCHED
}
}
constexpr int NWAVES = 8;
constexpr int DM = 2048, BATCH = 2, SEQ = 4096, DEPTH = 4, CTXL = 256, FF = 5632, HD = 128, NMOD = 9;
constexpr int ML = BATCH * SEQ, MC = BATCH * CTXL, MA = ML + MC;
constexpr int INC = 4096, DMIX = 2048, SGW = 512, HYW = 512;
constexpr int A_END = 1024, Q_END = 2048, K_END = 2304, V_END = 2560;
constexpr float NORM_EPS = 1e-6f;
constexpr float QSCALE = 0.08838834764831845f * 1.4426950408889634f;
constexpr float LOG2E = 1.4426950408889634f;
#ifndef MK_MULTI
#define MK_MULTI 0
#endif

constexpr size_t MiB = 1u << 20;
constexpr size_t WS_CTL = 0, CTL_ZERO_BYTES = 1 * MiB;
constexpr size_t WS_MOD = 1 * MiB;
constexpr size_t WS_ROPE = 2 * MiB;
constexpr size_t WS_KFS = 2 * MiB + 65536;
constexpr size_t WS_HD2 = 3 * MiB;
constexpr size_t WS_KFL = 8 * MiB;
constexpr size_t WS_KFC = 136 * MiB;
constexpr size_t WS_X = 144 * MiB;
constexpr size_t WS_XLO = WS_X + 36 * MiB;
constexpr size_t WS_XN = 212 * MiB;
constexpr size_t WS_H = 246 * MiB;
constexpr size_t WS_Y = 340 * MiB;
constexpr size_t WS_AU = 408 * MiB;
constexpr size_t WS_QB = 425 * MiB;
constexpr size_t WS_KB = 442 * MiB;
constexpr size_t WS_VTL = 447 * MiB;
constexpr size_t WS_VTC = 451 * MiB;
constexpr size_t WS_HZL = 452 * MiB;
constexpr size_t WS_HZC = 500 * MiB;
constexpr size_t WS_MIX = 503 * MiB;
constexpr size_t WS_W = 537 * MiB;
constexpr size_t WL_GU1 = 0, WL_D1 = 44 * MiB, WL_IN = 66 * MiB, WL_OUT = 82 * MiB, WL_GU2 = 90 * MiB, WL_D2 = 134 * MiB, WL_STRIDE = 156 * MiB;
constexpr size_t WS_YS = WS_W + DEPTH * WL_STRIDE;
constexpr size_t WS_ZS = WS_YS + 48 * MiB;
constexpr size_t WS_COTL = WS_ZS + 64 * MiB;
constexpr size_t WS_COTC = WS_COTL + 8 * MiB;
constexpr size_t WS_END = WS_COTC + 1 * MiB;
constexpr int S_DOWN = 11, S_OUT = 4, S_IN = 4;
constexpr int CW_TMO = 0, CW_CODE = 1;
constexpr int CW_BAR = 4096;
constexpr int CW_Q = 16384;
static_assert((CW_Q + 32 * 64) * 4 <= (int)CTL_ZERO_BYTES, "CTL words inside the memset region");

constexpr int RING_OFF = 0, RING_BYTES = 139264;
constexpr int LDSCTL_OFF = RING_BYTES, MISC_OFF = LDSCTL_OFF + 320;
constexpr int LDS_BYTES = 147456;
static_assert(MISC_OFF + 128 <= LDS_BYTES, "LDS map");
static_assert(WS_ROPE == pg8::WSO_ROPE && WS_AU == pg8::WSO_AU && WS_QB == pg8::WSO_QB && WS_KB == pg8::WSO_KB && WS_VTL == pg8::WSO_VTL && WS_VTC == pg8::WSO_VTC && WS_HZL == pg8::WSO_HZL && WS_HZC == pg8::WSO_HZC && WS_ZS == pg8::WSO_ZS, "EpiWin offsets");
#define GAS __attribute__((address_space(1)))
#define LAS __attribute__((address_space(3)))
typedef unsigned short bf16;
typedef unsigned v4u __attribute__((ext_vector_type(4)));
typedef float f32x4 __attribute__((ext_vector_type(4)));
typedef short bf16x8 __attribute__((ext_vector_type(8)));
typedef GAS unsigned gu32;
typedef GAS unsigned long long gu64;
#define RLX_AGENT __ATOMIC_RELAXED, __HIP_MEMORY_SCOPE_AGENT
#define LDS_WAIT() asm volatile("s_waitcnt lgkmcnt(0)" ::: "memory")
#define VM_WAIT() asm volatile("s_waitcnt vmcnt(0)" ::: "memory")
__device__ __forceinline__ unsigned long long rt() { return __builtin_amdgcn_s_memrealtime(); }
__device__ __forceinline__ unsigned f2bf(float f) { unsigned u = __builtin_bit_cast(unsigned, f); return (u + 0x7fffu + ((u >> 16) & 1u)) >> 16; }
__device__ __forceinline__ unsigned pk2(float lo, float hi) { return f2bf(lo) | (f2bf(hi) << 16); }

#define XB_TMO      128
#define XB_XCNT(j)  (256  + 64 * (j))
#define XB_XSUB(j)  (1280 + 64 * (j))
#define XB_XGEN(j)  (2304 + 64 * (j))
#define XB_TOP      3328
#define XB_TOPGEN   3392
#define XCD_BAR_WORDS 3456
#define XB_SPIN_CAP (1u << 18)

__device__ __forceinline__ unsigned xb_ld(unsigned* p)              { return __hip_atomic_load(p, __ATOMIC_RELAXED, __HIP_MEMORY_SCOPE_AGENT); }
__device__ __forceinline__ unsigned xb_add(unsigned* p, unsigned v) { return __hip_atomic_fetch_add(p, v, __ATOMIC_RELAXED, __HIP_MEMORY_SCOPE_AGENT); }
__device__ __forceinline__ unsigned xb_xcc_id() { return (unsigned)__builtin_amdgcn_s_getreg((3 << 11) | 20) & 0xFu; }
#define XB_SPIN(cond, bar) do { unsigned _sp = 0; while (cond) { __builtin_amdgcn_s_sleep(1); \
    if ((++_sp & 255u) == 0u) { if (xb_ld(&(bar)[XB_TMO])) break; if (_sp > XB_SPIN_CAP) { atomicAdd(&(bar)[XB_TMO], 1u); break; } } } } while (0)

struct XcdBarrier {
    unsigned* bar; unsigned x;
    volatile LAS unsigned* st;
};

__device__ __forceinline__ XcdBarrier xcd_barrier_post(unsigned* bar, volatile LAS unsigned* st) {
    XcdBarrier b; b.bar = bar; b.x = xb_xcc_id(); b.st = st;
    if (threadIdx.x == 0) (void)xb_add(&bar[XB_XCNT(b.x)], 1u);
    return b;
}
__device__ __forceinline__ void xcd_barrier_complete(unsigned* bar, unsigned x, unsigned& nloc, unsigned& nx) {
    const unsigned G = gridDim.x * gridDim.y * gridDim.z;
    unsigned sum, cnt, mine, sp = 0u;
    for (;;) {
        sum = 0u; cnt = 0u; mine = 0u;
#pragma unroll
        for (unsigned j = 0; j < 16; ++j) { const unsigned c = xb_ld(&bar[XB_XCNT(j)]); sum += c; cnt += (c > 0u) ? 1u : 0u; mine = (j == x) ? c : mine; }
        if (sum == G) break;
        __builtin_amdgcn_s_sleep(1);
        if ((++sp & 255u) == 0u) { if (xb_ld(&bar[XB_TMO])) break; if (sp > XB_SPIN_CAP) { atomicAdd(&bar[XB_TMO], 1u); break; } }
    }
    nloc = mine > 0u ? mine : 1u; nx = cnt > 0u ? cnt : 1u;
}

__device__ __forceinline__ void xcd_barrier(const XcdBarrier& b) {
    asm volatile("s_waitcnt vmcnt(0)" ::: "memory");
    __syncthreads();
    if (threadIdx.x == 0) {
        unsigned* bar = b.bar;
        __builtin_amdgcn_s_waitcnt(0);
        unsigned nloc = b.st[0], nx = b.st[1];
        if (nloc == 0u) { xcd_barrier_complete(bar, b.x, nloc, nx); b.st[0] = nloc; b.st[1] = nx; }
        const unsigned old = xb_add(&bar[XB_XSUB(b.x)], 1u);
        const unsigned gen = old / nloc;
        if (old + 1u == (gen + 1u) * nloc) {
            __builtin_amdgcn_fence(__ATOMIC_RELEASE, "agent");
            asm volatile("s_waitcnt vmcnt(0)" ::: "memory");
            const unsigned og = xb_add(&bar[XB_TOP], 1u);
            const unsigned tg = og / nx;
            if (og + 1u == (tg + 1u) * nx) xb_add(&bar[XB_TOPGEN], 1u);
            else XB_SPIN(xb_ld(&bar[XB_TOPGEN]) == tg, bar);
            __builtin_amdgcn_fence(__ATOMIC_ACQUIRE, "agent");
            xb_add(&bar[XB_XGEN(b.x)], 1u);
            asm volatile("s_waitcnt vmcnt(0)" ::: "memory");
        } else {
            XB_SPIN(xb_ld(&bar[XB_XGEN(b.x)]) == gen, bar);
            __builtin_amdgcn_fence(__ATOMIC_ACQUIRE, "agent");
            asm volatile("s_waitcnt vmcnt(0)" ::: "memory");
        }
    }
    __syncthreads();
}

typedef float f32x2 __attribute__((ext_vector_type(2)));
typedef float f32x16 __attribute__((ext_vector_type(16)));
typedef unsigned u32x2 __attribute__((ext_vector_type(2)));
struct Frame {
    LAS unsigned char* lds;
    volatile LAS unsigned* MISC;
    gu32* ctl;
    int tid, lane, wave, G, bx;
    const float* const* in;
    float* out;
    unsigned char* ws;
};
enum InIdx { I_X = 0, I_C, I_CTX, I_CCTX, I_WADA, I_BADA, I_NORMG, I_F1G, I_F1U, I_F1D, I_WIN, I_SGUG, I_SGUW, I_SGUB, I_SINK, I_HCW, I_HCB, I_HW1, I_HB1, I_HW2, I_HB2, I_HW3, I_HFREQ, I_HSKIP, I_WOUT, I_F2G, I_F2U, I_F2D };

__device__ __forceinline__ float dpp_add(float v, float src_unused, int) { return v; }
#define WS_DPP(v, ctrl) ((v) + __builtin_bit_cast(float, __builtin_amdgcn_update_dpp(0, __builtin_bit_cast(int, (v)), (ctrl), 0xF, 0xF, true)))
__device__ __forceinline__ float wave_sum(float v) {
    v = WS_DPP(v, 0xB1);
    v = WS_DPP(v, 0x4E);
    v = WS_DPP(v, 0x124);
    v = WS_DPP(v, 0x128);
    v += __shfl_xor(v, 16); v += __shfl_xor(v, 32);
    return v;
}
__device__ __forceinline__ unsigned cvtpk(float lo, float hi) { return pg8::cvt_pk_bf16(lo, hi); }
__device__ __forceinline__ float bf_lo(unsigned w) { return __uint_as_float(w << 16); }
__device__ __forceinline__ float bf_hi(unsigned w) { return __uint_as_float(w & 0xffff0000u); }
__device__ __forceinline__ float sin_rev(float r) { r -= rintf(r); return __builtin_amdgcn_sinf(r); }
__device__ __forceinline__ float cos_rev(float r) { r -= rintf(r); return __builtin_amdgcn_cosf(r); }
__device__ __forceinline__ float sin_rad(float x) { return sin_rev(x * 0.15915494309189535f); }

__device__ __forceinline__ void p0_transpose_tile(const float* W, int K, int N, bf16* WT, int k0, int n0, int drow0, LAS float* scr, int lane) {
#pragma unroll 8
    for (int i = 0; i < 32; ++i) { const int kk = 2 * i + (lane >> 5); scr[kk * 33 + (lane & 31)] = __builtin_nontemporal_load((const GAS float*)W + (size_t)(k0 + kk) * N + n0 + (lane & 31)); }
    LDS_WAIT(); asm volatile("" ::: "memory");
    const int c = lane & 7;
#pragma unroll
    for (int j = 0; j < 4; ++j) { const int n = (lane >> 3) + 8 * j; const LAS float* s = scr + (8 * c) * 33 + n;
        v4u o; o.x = pk2(s[0 * 33], s[1 * 33]); o.y = pk2(s[2 * 33], s[3 * 33]); o.z = pk2(s[4 * 33], s[5 * 33]); o.w = pk2(s[6 * 33], s[7 * 33]);
        __builtin_nontemporal_store(o, (GAS v4u*)(WT + (size_t)(drow0 + n) * K + k0 + 8 * c)); }
    LDS_WAIT(); asm volatile("" ::: "memory");
}
__device__ __forceinline__ int win_drow(int n0) {
    if (n0 < A_END || n0 >= K_END) return n0;
    const bool isq = n0 < Q_END; const int qc = n0 - (isq ? A_END : Q_END);
    const int head = qc >> 7, qd = (qc >> 5) & 3;
    const int pn = isq ? 4 + (head >> 1) : 8;
    return pn * 256 + 128 * (qd & 1) + 64 * (head & 1) + 32 * (qd >> 1);
}
constexpr int CV_FF = (DM / 64) * (FF / 32);
constexpr int CV_IN = (DM / 64) * (INC / 32);
constexpr int CV_OUT = (DM / 64) * (DMIX / 32);
constexpr int CV_LAYER = 6 * CV_FF + CV_IN + CV_OUT;
__device__ __forceinline__ void p0_convert_item(Frame& F, int it, LAS float* scr) {
    const int l = it / CV_LAYER; int r = it % CV_LAYER;
    unsigned char* wl = F.ws + WS_W + (size_t)l * WL_STRIDE;
    const size_t ffo = (size_t)l * DM * FF;
    if (r < 4 * CV_FF) {
        const int which = r / CV_FF; r -= which * CV_FF;
        const float* W = (which == 0 ? F.in[I_F1G] : which == 1 ? F.in[I_F1U] : which == 2 ? F.in[I_F2G] : F.in[I_F2U]) + ffo;
        bf16* WT = (bf16*)(wl + (which < 2 ? WL_GU1 : WL_GU2));
        const int nblk = FF / 32, kb = r / nblk, nb = r % nblk, n0 = 32 * nb;
        const int drow0 = 256 * (n0 >> 7) + 128 * (which & 1) + (n0 & 127);
        p0_transpose_tile(W, DM, FF, WT, 64 * kb, n0, drow0, scr, F.lane); return; }
    r -= 4 * CV_FF;
    if (r < 2 * CV_FF) {
        const int which = r / CV_FF; r -= which * CV_FF;
        const float* W = (which == 0 ? F.in[I_F1D] : F.in[I_F2D]) + ffo;
        bf16* WT = (bf16*)(wl + (which == 0 ? WL_D1 : WL_D2));
        const int nblk = DM / 32, kb = r / nblk, nb = r % nblk;
        p0_transpose_tile(W, FF, DM, WT, 64 * kb, 32 * nb, 32 * nb, scr, F.lane); return; }
    r -= 2 * CV_FF;
    if (r < CV_IN) { const float* W = F.in[I_WIN] + (size_t)l * DM * INC; const int nblk = INC / 32, kb = r / nblk, nb = r % nblk;
        p0_transpose_tile(W, DM, INC, (bf16*)(wl + WL_IN), 64 * kb, 32 * nb, win_drow(32 * nb), scr, F.lane); return; }
    r -= CV_IN;
    { const float* W = F.in[I_WOUT] + (size_t)l * DMIX * DM; const int nblk = DM / 32, kb = r / nblk, nb = r % nblk;
        p0_transpose_tile(W, DMIX, DM, (bf16*)(wl + WL_OUT), 64 * kb, 32 * nb, 32 * nb, scr, F.lane); }
}
__device__ __forceinline__ void p0_ada_item(Frame& F, int it) {
    LAS float* sv = (LAS float*)(F.lds + RING_OFF);
    LAS float* red = sv + 3 * DM;
    const int l = it >> 6, nb = it & 63;
    for (int i = F.tid; i < 3 * DM; i += NWAVES * 64) { const int r = i / DM, k = i % DM; const float c = r < 2 ? F.in[I_C][r * DM + k] : F.in[I_CCTX][k]; sv[i] = c / (1.0f + __expf(-c)); }
    __syncthreads();
    const float* W = F.in[I_WADA] + (size_t)l * DM * (NMOD * DM) + nb * 288 + 4 * F.lane;
    const bool ex = F.lane < 8;
    f32x4 a0 = {0.f, 0.f, 0.f, 0.f}, a1 = a0, a2 = a0, e0 = a0, e1 = a0, e2 = a0;
    const int kb = F.wave * 256;
#pragma unroll 4
    for (int k = 0; k < 256; ++k) { const float* wr = W + (size_t)(kb + k) * (NMOD * DM);
        const f32x4 w = __builtin_nontemporal_load((const GAS f32x4*)wr); f32x4 we = {0.f, 0.f, 0.f, 0.f}; if (ex) we = __builtin_nontemporal_load((const GAS f32x4*)(wr + 256));
        const float s0 = sv[kb + k], s1 = sv[DM + kb + k], s2 = sv[2 * DM + kb + k];
        a0 += w * s0; a1 += w * s1; a2 += w * s2; e0 += we * s0; e1 += we * s1; e2 += we * s2; }
    *(LAS f32x4*)(red + (F.wave * 3 + 0) * 288 + 4 * F.lane) = a0; *(LAS f32x4*)(red + (F.wave * 3 + 1) * 288 + 4 * F.lane) = a1; *(LAS f32x4*)(red + (F.wave * 3 + 2) * 288 + 4 * F.lane) = a2;
    if (ex) { *(LAS f32x4*)(red + (F.wave * 3 + 0) * 288 + 256 + 4 * F.lane) = e0; *(LAS f32x4*)(red + (F.wave * 3 + 1) * 288 + 256 + 4 * F.lane) = e1; *(LAS f32x4*)(red + (F.wave * 3 + 2) * 288 + 256 + 4 * F.lane) = e2; }
    __syncthreads();
    for (int i = F.tid; i < 3 * 288; i += NWAVES * 64) { const int r = i / 288, n = i % 288; float s = 0.f;
#pragma unroll
        for (int w = 0; w < 8; ++w) s += red[(w * 3 + r) * 288 + n];
        const int col = nb * 288 + n;
        ((float*)(F.ws + WS_MOD))[((size_t)l * 3 + r) * (NMOD * DM) + col] = s + F.in[I_BADA][(size_t)l * (NMOD * DM) + col]; }
    __syncthreads();
}
__device__ __forceinline__ void p0_hd2_row(Frame& F, int l, int tp) {
    const bool ctx = tp >= SEQ; const int L = ctx ? CTXL : SEQ; const int t = ctx ? tp - SEQ : tp; const int lane = F.lane;
    float feat = 0.f;
    if (lane == 0) feat = (float)t / (float)(L - 1);
    else if (lane < 33) { const int j = (lane - 1) & 15; const double band = 1e-4 + (double)j * ((15.0 - 1e-4) / 15.0); const double rev = band * (double)t / (double)L; const float fr = (float)(rev - floor(rev));
        feat = lane < 17 ? __builtin_amdgcn_cosf(fr) : -__builtin_amdgcn_sinf(fr); }
    const float* w1 = F.in[I_HW1] + (size_t)l * 33 * 64; const float* w2 = F.in[I_HW2] + (size_t)l * 64 * 64;
    const float fq = F.in[I_HFREQ][l * 64 + lane];
    float a = F.in[I_HB1][l * 64 + lane];
#pragma unroll
    for (int i = 0; i < 33; ++i) a += __shfl(feat, i) * w1[i * 64 + lane];
    const float h1 = sin_rad(fq * a);
    float b = F.in[I_HB2][l * 64 + lane];
#pragma unroll 16
    for (int i = 0; i < 64; ++i) b += __shfl(h1, i) * w2[i * 64 + lane];
    ((float*)(F.ws + WS_HD2))[((size_t)l * (SEQ + CTXL) + tp) * 64 + lane] = sin_rad(fq * b);
}
__device__ __forceinline__ void p0_rope_entry(Frame& F, int idx) {
    const int a = idx >> 5, i = idx & 31;
    const double inv = exp2(-(double)i * (13.287712379549449 / 32.0));
    double x = (double)a * inv; const double k = rint(x * 0.6366197723675814);
    x = x - k * 1.5707963267948966 - k * 6.123233995736766e-17;
    const double x2 = x * x;
    double s = x * (1.0 + x2 * (-1.0 / 6 + x2 * (1.0 / 120 + x2 * (-1.0 / 5040 + x2 * (1.0 / 362880 + x2 * (-1.0 / 39916800 + x2 * (1.0 / 6227020800.0)))))));
    double c = 1.0 + x2 * (-0.5 + x2 * (1.0 / 24 + x2 * (-1.0 / 720 + x2 * (1.0 / 40320 + x2 * (-1.0 / 3628800 + x2 * (1.0 / 479001600.0 + x2 * (-1.0 / 87178291200.0)))))));
    const int q = ((int)k) & 3; double cs, sn;
    if (q == 0) { cs = c; sn = s; } else if (q == 1) { cs = -s; sn = c; } else if (q == 2) { cs = -c; sn = -s; } else { cs = s; sn = -c; }
    float* rp = (float*)(F.ws + WS_ROPE); rp[idx] = (float)cs; rp[2048 + idx] = (float)sn;
}
__device__ __forceinline__ void p0_prologue(Frame& F) {
#ifndef P0M
#define P0M 15
#endif
    if (P0M & 1) for (int it = F.bx; it < DEPTH * 64; it += F.G) p0_ada_item(F, it);
    const int gw = F.bx * NWAVES + F.wave, NGW = F.G * NWAVES;
    if (P0M & 2) for (int it = gw; it < DEPTH * (SEQ + CTXL); it += NGW) p0_hd2_row(F, it / (SEQ + CTXL), it % (SEQ + CTXL));
    if (P0M & 4) if (F.bx == F.G - 1) for (int i = F.tid; i < 2048; i += NWAVES * 64) p0_rope_entry(F, i);
}
__device__ __forceinline__ void p0_convert_all(Frame& F) {
    const int gw = F.bx * NWAVES + F.wave, NGW = F.G * NWAVES;
    LAS float* scr = (LAS float*)(F.lds + RING_OFF + F.wave * 16384);
    for (int it = gw; it < DEPTH * CV_LAYER; it += NGW) p0_convert_item(F, it, scr);
}

__device__ __forceinline__ void p1_filter_item(Frame& F, int it) {
    const int cb = it & 63, Lsel = (it >> 6) & 1, l = it >> 7;
    const int L = Lsel ? CTXL : SEQ;
    LAS float* W3s = (LAS float*)(F.lds + RING_OFF);
    LAS float* red = W3s + 64 * 32;
    for (int i = F.tid; i < 64 * 32; i += NWAVES * 64) { const int j = i >> 5, lc = i & 31; const int o = lc >> 4, dir = (lc >> 3) & 1, ci = lc & 7;
        W3s[i] = F.in[I_HW3][((size_t)l * 64 + j) * 2048 + o * 1024 + dir * 512 + cb * 8 + ci]; }
    __syncthreads();
    float asum[16];
#pragma unroll
    for (int i = 0; i < 16; ++i) asum[i] = 0.f;
    const float* hd2 = (const float*)(F.ws + WS_HD2) + ((size_t)l * (SEQ + CTXL) + (Lsel ? SEQ : 0)) * 64;
    float* kf = Lsel ? (float*)(F.ws + WS_KFC) + ((size_t)l * 512 + cb * 8) * 2 * 512 : (float*)(F.ws + WS_KFL) + ((size_t)l * 512 + cb * 8) * 2 * 8192;
    const int N2 = 2 * L;
    const int ngrp = Lsel ? 1 : 4;
    for (int grp = 0; grp < ngrp; ++grp) {
        const int tb = F.tid + 1024 * grp;
        if (!Lsel || F.tid < 128) {
            const int tstep = Lsel ? 128 : 512;
            float acc[2][32];
#pragma unroll
            for (int k = 0; k < 2; ++k)
#pragma unroll
                for (int i = 0; i < 32; ++i) acc[k][i] = 0.f;
#pragma unroll 2
            for (int j4 = 0; j4 < 16; ++j4) {
                f32x4 hv[2];
#pragma unroll
                for (int k = 0; k < 2; ++k) hv[k] = *(const f32x4*)(hd2 + (size_t)(tb + tstep * k) * 64 + 4 * j4);
#pragma unroll
                for (int jj = 0; jj < 4; ++jj) { const LAS f32x4* wr = (const LAS f32x4*)(W3s + (j4 * 4 + jj) * 32);
#pragma unroll
                    for (int q = 0; q < 8; ++q) { const f32x4 w = wr[q];
#pragma unroll
                        for (int k = 0; k < 2; ++k) { const float h = hv[k][jj]; acc[k][4 * q + 0] += h * w[0]; acc[k][4 * q + 1] += h * w[1]; acc[k][4 * q + 2] += h * w[2]; acc[k][4 * q + 3] += h * w[3]; } } }
            }
#pragma unroll
            for (int k = 0; k < 2; ++k) { int t = tb + tstep * k; asm volatile("" : "+v"(t));
                const float tn = (float)t / (float)(L - 1);
                typedef __attribute__((address_space(1))) float gfl; gfl* kfb = (gfl*)kf;
                const unsigned of = (unsigned)t, ob = (unsigned)(N2 - t);
#pragma unroll
                for (int ci = 0; ci < 8; ++ci) { const int c = cb * 8 + ci;
                    const float delta = 15.350567286626973f - (float)c * ((15.350567286626973f - 3.0701134573253945f) / 511.0f);
                    const float dec = __expf(-tn * delta);
#pragma unroll
                    for (int o = 0; o < 2; ++o) { const float vf = acc[k][o * 16 + ci] * dec, vb = acc[k][o * 16 + 8 + ci] * dec;
                        asum[o * 8 + ci] += fabsf(vf) + fabsf(vb);
                        const unsigned base = (unsigned)(ci * 2 + o) * (unsigned)N2;
                        if (t == 0) { kfb[base] = vf + vb; kfb[base + (unsigned)L] = 0.f; } else { __builtin_nontemporal_store(vf, kfb + base + of); __builtin_nontemporal_store(vb, kfb + base + ob); } } } }
        }
    }
#pragma unroll
    for (int i = 0; i < 16; ++i) { const float s = wave_sum(asum[i]); if (F.lane == 0) red[F.wave * 16 + i] = s; }
    __syncthreads();
    if (F.tid < 16) { float s = 0.f;
#pragma unroll
        for (int w = 0; w < 8; ++w) s += red[w * 16 + F.tid];
        const int o = F.tid >> 3, ci = F.tid & 7;
        ((float*)(F.ws + WS_KFS))[(((size_t)l * 2 + Lsel) * 2 + o) * 512 + cb * 8 + ci] = 1.0f / (s + 1e-6f); }
    __syncthreads();
}

struct X24 { v4u h[4]; u32x2 lo[4]; };
__device__ __forceinline__ void x24_load(const unsigned char* ws, int row, int lane, X24& p) {
    const GAS v4u* hp = (const GAS v4u*)(ws + WS_X + (size_t)row * (2 * DM)) + lane; const GAS u32x2* lp = (const GAS u32x2*)(ws + WS_XLO + (size_t)row * DM) + lane;
#pragma unroll
    for (int q = 0; q < 4; ++q) { p.h[q] = __builtin_nontemporal_load(hp + 64 * q); p.lo[q] = __builtin_nontemporal_load(lp + 64 * q); }
}
__device__ __forceinline__ f32x4 x24_un(unsigned h0, unsigned h1, unsigned L) {
    f32x4 r; r.x = __uint_as_float((h0 << 16) | ((L & 0xffu) << 8)); r.y = __uint_as_float((h0 & 0xffff0000u) | (L & 0xff00u));
    r.z = __uint_as_float((h1 << 16) | ((L >> 8) & 0xff00u)); r.w = __uint_as_float((h1 & 0xffff0000u) | ((L >> 16) & 0xff00u)); return r;
}
__device__ __forceinline__ void x24_unpack(const X24& p, f32x4 (&xv)[8]) {
#pragma unroll
    for (int q = 0; q < 4; ++q) { xv[2 * q] = x24_un(p.h[q].x, p.h[q].y, p.lo[q].x); xv[2 * q + 1] = x24_un(p.h[q].z, p.h[q].w, p.lo[q].y); }
}
__device__ __forceinline__ void x24_pk(const f32x4 v, unsigned& h0, unsigned& h1, unsigned& L) {
    const unsigned a = __float_as_uint(v.x) + 0x80u, b = __float_as_uint(v.y) + 0x80u, c = __float_as_uint(v.z) + 0x80u, d = __float_as_uint(v.w) + 0x80u;
    h0 = (a >> 16) | (b & 0xffff0000u); h1 = (c >> 16) | (d & 0xffff0000u);
    L = ((a >> 8) & 0xffu) | (b & 0xff00u) | ((c << 8) & 0xff0000u) | ((d << 16) & 0xff000000u);
}
__device__ __forceinline__ void x24_store(unsigned char* ws, int row, int lane, const f32x4 (&xv)[8]) {
    GAS v4u* hp = (GAS v4u*)(ws + WS_X + (size_t)row * (2 * DM)) + lane; GAS u32x2* lp = (GAS u32x2*)(ws + WS_XLO + (size_t)row * DM) + lane;
#pragma unroll
    for (int q = 0; q < 4; ++q) { unsigned h0, h1, h2, h3, l0, l1; x24_pk(xv[2 * q], h0, h1, l0); x24_pk(xv[2 * q + 1], h2, h3, l1); const v4u h = {h0, h1, h2, h3}; const u32x2 lo = {l0, l1};
        __builtin_nontemporal_store(h, hp + 64 * q); __builtin_nontemporal_store(lo, lp + 64 * q); }
}
template <int N> __device__ __forceinline__ void slab_sum(const bf16* yrow, int s, f32x4 (&yv)[8]) {
    u32x2 t[N][8];
#pragma unroll
    for (int i = 0; i < N; ++i)
#pragma unroll
        for (int j = 0; j < 8; ++j) t[i][j] = __builtin_nontemporal_load((const GAS u32x2*)(yrow + (size_t)(s + i) * (512 * DM) + 256 * j));
#pragma unroll
    for (int i = 0; i < N; ++i)
#pragma unroll
        for (int j = 0; j < 8; ++j) { const u32x2 w = t[i][j]; yv[j] += (f32x4){bf_lo(w.x), bf_hi(w.x), bf_lo(w.y), bf_hi(w.y)}; }
}
template <bool HAS_Y, bool HAS_NEXT, bool FINAL, bool LAT>
__device__ __forceinline__ void thin_row(Frame& F, int row, int l, int k, float coef, int ln, int kn, int S) {
    const int r = LAT ? (row >> 12) : 2;
    int lane_ = F.lane; asm volatile("" : "+v"(lane_)); const int lane = lane_;
    f32x4 xv[8]; X24 px;
    if (HAS_Y) x24_load(F.ws, row, lane, px);
    else { const float* xsrc = LAT ? F.in[I_X] + (size_t)row * DM : F.in[I_CTX] + (size_t)(row - ML) * DM;
#pragma unroll
        for (int j = 0; j < 8; ++j) xv[j] = __builtin_nontemporal_load((const GAS f32x4*)(xsrc + 4 * lane + 256 * j)); }
    if (HAS_Y) {
        const float* gate = (const float*)(F.ws + WS_MOD) + ((size_t)l * 3 + r) * (NMOD * DM) + (3 * k + 2) * DM;
        const float* gp = F.in[I_NORMG] + ((size_t)l * 6 + 2 * k + 1) * DM;
        f32x4 yv[8]; float ss = 0.f;
        if (LAT) {
            const bf16* yrow = (const bf16*)(F.ws + WS_Y) + (size_t)row * DM;
#pragma unroll
            for (int j = 0; j < 8; ++j) { const u32x2 w = __builtin_nontemporal_load((const GAS u32x2*)(yrow + 4 * lane + 256 * j)); yv[j] = (f32x4){bf_lo(w.x), bf_hi(w.x), bf_lo(w.y), bf_hi(w.y)}; }
        } else {
            const bf16* yrow = (const bf16*)(F.ws + WS_YS) + (size_t)(row - ML) * DM + 4 * lane;
#pragma unroll
            for (int j = 0; j < 8; ++j) yv[j] = (f32x4){0.f, 0.f, 0.f, 0.f};
            int s = 0;
            for (; s + 6 <= S; s += 6) slab_sum<6>(yrow, s, yv);
            const int rem = S - s;
            if (rem == 5) slab_sum<5>(yrow, s, yv); else if (rem == 4) slab_sum<4>(yrow, s, yv); else if (rem == 3) slab_sum<3>(yrow, s, yv); else if (rem == 2) slab_sum<2>(yrow, s, yv); else if (rem == 1) slab_sum<1>(yrow, s, yv);
        }
#pragma unroll
        for (int j = 0; j < 8; ++j) { ss += (yv[j].x * yv[j].x + yv[j].y * yv[j].y) + (yv[j].z * yv[j].z + yv[j].w * yv[j].w); }
        const float rstd = coef * rsqrtf(wave_sum(ss) * (1.0f / DM) + NORM_EPS);
        x24_unpack(px, xv);
#pragma unroll
        for (int j = 0; j < 8; ++j) { const f32x4 g = *(const f32x4*)(gate + 4 * lane + 256 * j), q = *(const f32x4*)(gp + 4 * lane + 256 * j); xv[j] += (yv[j] * rstd) * (g * q); }
    }
    if (FINAL) { if (LAT) {
#pragma unroll
        for (int j = 0; j < 8; ++j) *(GAS f32x4*)(F.out + (size_t)row * DM + 4 * lane + 256 * j) = xv[j]; }
    } else x24_store(F.ws, row, lane, xv);
    if (HAS_NEXT) {
        float ss = 0.f;
#pragma unroll
        for (int j = 0; j < 8; ++j) ss += (xv[j].x * xv[j].x + xv[j].y * xv[j].y) + (xv[j].z * xv[j].z + xv[j].w * xv[j].w);
        const float rstd = rsqrtf(wave_sum(ss) * (1.0f / DM) + NORM_EPS);
        const float* mod = (const float*)(F.ws + WS_MOD) + ((size_t)ln * 3 + r) * (NMOD * DM) + (3 * kn) * DM;
        const float* gq = F.in[I_NORMG] + ((size_t)ln * 6 + 2 * kn) * DM;
        bf16* xn = (bf16*)(F.ws + WS_XN) + (size_t)row * DM;
#pragma unroll
        for (int j = 0; j < 8; ++j) { const f32x4 g = *(const f32x4*)(gq + 4 * lane + 256 * j), sc = *(const f32x4*)(mod + 4 * lane + 256 * j), sh = *(const f32x4*)(mod + DM + 4 * lane + 256 * j);
            const f32x4 o = (xv[j] * rstd) * g * (sc + 1.0f) + sh;
            u32x2 w; w.x = cvtpk(o.x, o.y); w.y = cvtpk(o.z, o.w); *(GAS u32x2*)(xn + 4 * lane + 256 * j) = w; }
    }
}
template <bool HAS_Y, bool HAS_NEXT, bool FINAL>
__device__ __forceinline__ void thin_rows2(Frame& F, int rA, int rB, int l, int k, float coef, int ln, int kn) {
    const int r = rA >> 12; int lane_ = F.lane; asm volatile("" : "+v"(lane_)); const int lane = lane_;
    f32x4 xv[2][8]; X24 px[2];
    if (HAS_Y) { x24_load(F.ws, rA, lane, px[0]); x24_load(F.ws, rB, lane, px[1]); }
    else {
#pragma unroll
        for (int p = 0; p < 2; ++p)
#pragma unroll
            for (int j = 0; j < 8; ++j) xv[p][j] = __builtin_nontemporal_load((const GAS f32x4*)(F.in[I_X] + (size_t)(p ? rB : rA) * DM + 4 * lane + 256 * j));
    }
    if (HAS_Y) {
        const float* gate = (const float*)(F.ws + WS_MOD) + ((size_t)l * 3 + r) * (NMOD * DM) + (3 * k + 2) * DM;
        const float* gp = F.in[I_NORMG] + ((size_t)l * 6 + 2 * k + 1) * DM;
        u32x2 yw[2][8];
#pragma unroll
        for (int p = 0; p < 2; ++p) { const bf16* yrow = (const bf16*)(F.ws + WS_Y) + (size_t)(p ? rB : rA) * DM;
#pragma unroll
            for (int j = 0; j < 8; ++j) yw[p][j] = __builtin_nontemporal_load((const GAS u32x2*)(yrow + 4 * lane + 256 * j)); }
        f32x4 gg[8];
#pragma unroll
        for (int j = 0; j < 8; ++j) gg[j] = *(const f32x4*)(gate + 4 * lane + 256 * j) * *(const f32x4*)(gp + 4 * lane + 256 * j);
#pragma unroll
        for (int p = 0; p < 2; ++p) { float ss = 0.f; f32x4 yv[8];
#pragma unroll
            for (int j = 0; j < 8; ++j) { const u32x2 w = yw[p][j]; yv[j] = (f32x4){bf_lo(w.x), bf_hi(w.x), bf_lo(w.y), bf_hi(w.y)}; ss += (yv[j].x * yv[j].x + yv[j].y * yv[j].y) + (yv[j].z * yv[j].z + yv[j].w * yv[j].w); }
            const float rstd = coef * rsqrtf(wave_sum(ss) * (1.0f / DM) + NORM_EPS);
            x24_unpack(px[p], xv[p]);
#pragma unroll
            for (int j = 0; j < 8; ++j) xv[p][j] += (yv[j] * rstd) * gg[j]; }
    }
#pragma unroll
    for (int p = 0; p < 2; ++p) { const int row = p ? rB : rA;
        if (FINAL) {
#pragma unroll
            for (int j = 0; j < 8; ++j) *(GAS f32x4*)(F.out + (size_t)row * DM + 4 * lane + 256 * j) = xv[p][j];
        } else x24_store(F.ws, row, lane, xv[p]); }
    if (HAS_NEXT) {
        const float* mod = (const float*)(F.ws + WS_MOD) + ((size_t)ln * 3 + r) * (NMOD * DM) + (3 * kn) * DM;
        const float* gq = F.in[I_NORMG] + ((size_t)ln * 6 + 2 * kn) * DM;
        float rstd[2];
#pragma unroll
        for (int p = 0; p < 2; ++p) { float ss = 0.f;
#pragma unroll
            for (int j = 0; j < 8; ++j) ss += (xv[p][j].x * xv[p][j].x + xv[p][j].y * xv[p][j].y) + (xv[p][j].z * xv[p][j].z + xv[p][j].w * xv[p][j].w);
            rstd[p] = rsqrtf(wave_sum(ss) * (1.0f / DM) + NORM_EPS); }
#pragma unroll
        for (int j = 0; j < 8; ++j) { const f32x4 g = *(const f32x4*)(gq + 4 * lane + 256 * j), sc = *(const f32x4*)(mod + 4 * lane + 256 * j), sh = *(const f32x4*)(mod + DM + 4 * lane + 256 * j);
            const f32x4 gs = g * (sc + 1.0f);
#pragma unroll
            for (int p = 0; p < 2; ++p) { const f32x4 o = (xv[p][j] * rstd[p]) * gs + sh; bf16* xn = (bf16*)(F.ws + WS_XN) + (size_t)(p ? rB : rA) * DM;
                u32x2 w; w.x = cvtpk(o.x, o.y); w.y = cvtpk(o.z, o.w); *(GAS u32x2*)(xn + 4 * lane + 256 * j) = w; } }
    }
}
template <bool HAS_NEXT, bool FINAL>
__device__ __forceinline__ void thin_rows4(Frame& F, int gw, int NGW, float coef, const LAS float* prm) {
    int lane_ = F.lane; asm volatile("" : "+v"(lane_)); const int lane = lane_;
    X24 px[4]; u32x2 yw[4][8];
#define THIN_LD(i) do { const int row_ = gw + NGW * (i); x24_load(F.ws, row_, lane, px[i]); const bf16* yrow = (const bf16*)(F.ws + WS_Y) + (size_t)row_ * DM; \
        _Pragma("unroll") for (int j = 0; j < 8; ++j) yw[i][j] = __builtin_nontemporal_load((const GAS u32x2*)(yrow + 4 * lane + 256 * j)); } while (0)
    THIN_LD(0); THIN_LD(1); THIN_LD(2);
#pragma unroll
    for (int i = 0; i < 4; ++i) { const int row = gw + NGW * i; const int r = row >> 12;
        f32x4 xv[8], yv[8]; float ss = 0.f;
#pragma unroll
        for (int j = 0; j < 8; ++j) { const u32x2 w = yw[i][j]; yv[j] = (f32x4){bf_lo(w.x), bf_hi(w.x), bf_lo(w.y), bf_hi(w.y)}; ss += (yv[j].x * yv[j].x + yv[j].y * yv[j].y) + (yv[j].z * yv[j].z + yv[j].w * yv[j].w); }
        x24_unpack(px[i], xv);
        if (i == 0) THIN_LD(3);
        const float rstd = coef * rsqrtf(wave_sum(ss) * (1.0f / DM) + NORM_EPS);
#pragma unroll
        for (int j = 0; j < 8; ++j) { const f32x4 gg = *(const LAS f32x4*)(prm + (0 * 2 + r) * DM + 4 * lane + 256 * j); xv[j] += (yv[j] * rstd) * gg; }
        if (FINAL) {
#pragma unroll
            for (int j = 0; j < 8; ++j) *(GAS f32x4*)(F.out + (size_t)row * DM + 4 * lane + 256 * j) = xv[j];
        } else x24_store(F.ws, row, lane, xv);
        if (HAS_NEXT) { float s2 = 0.f;
#pragma unroll
            for (int j = 0; j < 8; ++j) s2 += (xv[j].x * xv[j].x + xv[j].y * xv[j].y) + (xv[j].z * xv[j].z + xv[j].w * xv[j].w);
            const float rstd2 = rsqrtf(wave_sum(s2) * (1.0f / DM) + NORM_EPS);
            bf16* xn = (bf16*)(F.ws + WS_XN) + (size_t)row * DM;
#pragma unroll
            for (int j = 0; j < 8; ++j) { const f32x4 gs = *(const LAS f32x4*)(prm + (1 * 2 + r) * DM + 4 * lane + 256 * j), sh = *(const LAS f32x4*)(prm + (2 * 2 + r) * DM + 4 * lane + 256 * j);
                const f32x4 o = (xv[j] * rstd2) * gs + sh;
                u32x2 w; w.x = cvtpk(o.x, o.y); w.y = cvtpk(o.z, o.w); *(GAS u32x2*)(xn + 4 * lane + 256 * j) = w; } }
    }
}
template <bool HAS_Y, bool HAS_NEXT, bool FINAL>
__device__ __forceinline__ void thin_phase(Frame& F, int l, int k, float coef, int ln, int kn, int S) {
    const int gw = F.bx * NWAVES + F.wave, NGW = F.G * NWAVES;
    LAS float* prm = (LAS float*)(F.lds + RING_OFF);
    const bool four = HAS_Y && !FINAL && 4 * NGW == ML;
    if (four) {
        const int t4 = 4 * F.tid;
#pragma unroll
        for (int r = 0; r < 2; ++r) {
            const float* gate = (const float*)(F.ws + WS_MOD) + ((size_t)l * 3 + r) * (NMOD * DM) + (3 * k + 2) * DM; const float* gp = F.in[I_NORMG] + ((size_t)l * 6 + 2 * k + 1) * DM;
            *(LAS f32x4*)(prm + (0 * 2 + r) * DM + t4) = *(const f32x4*)(gate + t4) * *(const f32x4*)(gp + t4);
            if (HAS_NEXT) { const float* mod = (const float*)(F.ws + WS_MOD) + ((size_t)ln * 3 + r) * (NMOD * DM) + (3 * kn) * DM; const float* gq = F.in[I_NORMG] + ((size_t)ln * 6 + 2 * kn) * DM;
                *(LAS f32x4*)(prm + (1 * 2 + r) * DM + t4) = *(const f32x4*)(gq + t4) * (*(const f32x4*)(mod + t4) + 1.0f); *(LAS f32x4*)(prm + (2 * 2 + r) * DM + t4) = *(const f32x4*)(mod + DM + t4); } }
        __syncthreads();
    }
    if (!FINAL && S >= 0) { if (F.G * 2 >= MC) { if (F.wave < 2) { const int rc = F.bx * 2 + F.wave; if (rc < MC) thin_row<HAS_Y, HAS_NEXT, FINAL, false>(F, ML + rc, l, k, coef, ln, kn, S); } }
                            else for (int row = ML + gw; row < MA; row += NGW) thin_row<HAS_Y, HAS_NEXT, FINAL, false>(F, row, l, k, coef, ln, kn, S); }
    if (four) thin_rows4<HAS_NEXT, FINAL>(F, gw, NGW, coef, prm);
    else if (2 * NGW == SEQ) { for (int row = gw; row < ML; row += 2 * NGW) thin_rows2<HAS_Y, HAS_NEXT, FINAL>(F, row, row + NGW, l, k, coef, ln, kn); }
    else for (int row = gw; row < ML; row += NGW) thin_row<HAS_Y, HAS_NEXT, FINAL, true>(F, row, l, k, coef, ln, kn, S);
}
typedef float cpx __attribute__((ext_vector_type(2)));
__device__ __forceinline__ float fadd_(float a, float b) { float r; asm("v_add_f32 %0, %1, %2" : "=v"(r) : "v"(a), "v"(b)); return r; }
__device__ __forceinline__ float fsub_(float a, float b) { float r; asm("v_sub_f32 %0, %1, %2" : "=v"(r) : "v"(a), "v"(b)); return r; }
__device__ __forceinline__ float fmul_(float a, float b) { float r; asm("v_mul_f32 %0, %1, %2" : "=v"(r) : "v"(a), "v"(b)); return r; }
__device__ __forceinline__ float ffma_(float a, float b, float c) { float r; asm("v_fma_f32 %0, %1, %2, %3" : "=v"(r) : "v"(a), "v"(b), "v"(c)); return r; }
__device__ __forceinline__ float ffnma_(float a, float b, float c) { float r; asm("v_fma_f32 %0, -%1, %2, %3" : "=v"(r) : "v"(a), "v"(b), "v"(c)); return r; }
__device__ __forceinline__ cpx cmul(cpx a, cpx b) { return cpx{ffnma_(a.y, b.y, fmul_(a.x, b.x)), ffma_(a.y, b.x, fmul_(a.x, b.y))}; }
__device__ __forceinline__ cpx cadd(cpx a, cpx b) { return cpx{fadd_(a.x, b.x), fadd_(a.y, b.y)}; }
__device__ __forceinline__ cpx csub(cpx a, cpx b) { return cpx{fsub_(a.x, b.x), fsub_(a.y, b.y)}; }
template <bool INV> __device__ __forceinline__ cpx mul_mi(cpx a) { return INV ? cpx{-a.y, a.x} : cpx{a.y, -a.x}; }
template <bool INV> __device__ __forceinline__ cpx twid(float frac) { float c = __builtin_amdgcn_cosf(frac), s = __builtin_amdgcn_sinf(frac); asm volatile("s_nop 1" : "+v"(c), "+v"(s)); return cpx{c, INV ? s : -s}; }
template <bool INV> __device__ __forceinline__ void dft4(cpx& a0, cpx& a1, cpx& a2, cpx& a3) {
    const cpx s0 = cadd(a0, a2), s1 = csub(a0, a2), s2 = cadd(a1, a3), d = csub(a1, a3);
    a0 = cadd(s0, s2); a2 = csub(s0, s2);
    if (INV) { a1 = cpx{fsub_(s1.x, d.y), fadd_(s1.y, d.x)}; a3 = cpx{fadd_(s1.x, d.y), fsub_(s1.y, d.x)}; }
    else     { a1 = cpx{fadd_(s1.x, d.y), fsub_(s1.y, d.x)}; a3 = cpx{fsub_(s1.x, d.y), fadd_(s1.y, d.x)}; }
}
template <bool INV> __device__ __forceinline__ void dft16(cpx (&v)[16]) {
    constexpr float C1 = 0.9238795325112867f, S1 = 0.3826834323650898f, R = 0.7071067811865476f;
    cpx t[4][4];
#pragma unroll
    for (int j = 0; j < 4; ++j) { cpx a0 = v[j], a1 = v[j + 4], a2 = v[j + 8], a3 = v[j + 12]; dft4<INV>(a0, a1, a2, a3); t[0][j] = a0; t[1][j] = a1; t[2][j] = a2; t[3][j] = a3; }
    const float sg = INV ? 1.0f : -1.0f;
    t[1][1] = cmul(t[1][1], cpx{C1, sg * S1}); t[1][2] = cmul(t[1][2], cpx{R, sg * R});   t[1][3] = cmul(t[1][3], cpx{S1, sg * C1});
    t[2][1] = cmul(t[2][1], cpx{R, sg * R});   t[2][2] = mul_mi<INV>(t[2][2]);             t[2][3] = cmul(t[2][3], cpx{-R, sg * R});
    t[3][1] = cmul(t[3][1], cpx{S1, sg * C1}); t[3][2] = cmul(t[3][2], cpx{-R, sg * R});  t[3][3] = cmul(t[3][3], cpx{-C1, -sg * S1});
#pragma unroll
    for (int q = 0; q < 4; ++q) { cpx a0 = t[q][0], a1 = t[q][1], a2 = t[q][2], a3 = t[q][3]; dft4<INV>(a0, a1, a2, a3); v[q] = a0; v[4 + q] = a1; v[8 + q] = a2; v[12 + q] = a3; }
}
constexpr int FFT_HALF_STRIDE = 4096 + 256;
__device__ __forceinline__ int fpos(int e) { return e + (e >> 4); }
template <bool INV> __device__ __forceinline__ void fft_pass_rt(LAS cpx* reg, int tid, int logn) {
    asm volatile("" : "+v"(tid));
    const int st = 1 << (logn - 4); const int u = tid & 255; LAS cpx* base = reg + (tid >> 8) * FFT_HALF_STRIDE;
    const int j = u & (st - 1), b0 = (u >> (logn - 4)) << logn;
    const int p0 = fpos(b0 + j), sp = st + (st >> 4);
    cpx v[16];
#pragma unroll
    for (int q = 0; q < 16; ++q) v[q] = base[p0 + q * sp];
    const int nm = (1 << logn) - 1; const float rn = __int_as_float((127 - logn) << 23);
    if (INV) {
        if (logn > 4) {
            cpx wq[16]; wq[1] = twid<true>((float)j * rn); wq[2] = cmul(wq[1], wq[1]); wq[3] = cmul(wq[2], wq[1]); wq[4] = cmul(wq[2], wq[2]);
#pragma unroll
            for (int q = 5; q < 8; ++q) wq[q] = cmul(wq[4], wq[q - 4]);
            wq[8] = cmul(wq[4], wq[4]);
#pragma unroll
            for (int q = 9; q < 16; ++q) wq[q] = cmul(wq[8], wq[q - 8]);
#pragma unroll
            for (int q = 1; q < 16; ++q) v[q] = cmul(v[q], wq[q]);
        }
        dft16<true>(v);
    } else {
        dft16<false>(v);
        if (logn > 4) {
            cpx wq[16]; wq[1] = twid<false>((float)j * rn); wq[2] = cmul(wq[1], wq[1]); wq[3] = cmul(wq[2], wq[1]); wq[4] = cmul(wq[2], wq[2]);
#pragma unroll
            for (int q = 5; q < 8; ++q) wq[q] = cmul(wq[4], wq[q - 4]);
            wq[8] = cmul(wq[4], wq[4]);
#pragma unroll
            for (int q = 9; q < 16; ++q) wq[q] = cmul(wq[8], wq[q - 8]);
#pragma unroll
            for (int q = 1; q < 16; ++q) v[q] = cmul(v[q], wq[q]);
        }
    }
#pragma unroll
    for (int q = 0; q < 16; ++q) base[p0 + q * sp] = v[q];
}
__device__ __forceinline__ float short_conv(const float* z, int t, int L, float w0, float w1, float w2, float b) {
    const float zm = t > 0 ? z[t - 1] : 0.f, z0 = z[t], zp = t < L - 1 ? z[t + 1] : 0.f;
    return zm * w0 + z0 * w1 + zp * w2 + b;
}
__device__ __forceinline__ void hyena_lat_item(Frame& F, int l, int c) {
    LAS cpx* RA = (LAS cpx*)(F.lds + RING_OFF); LAS cpx* RB = RA + 2 * FFT_HALF_STRIDE;
    const float* hz0 = (const float*)(F.ws + WS_HZL); const float* hz1 = hz0 + (size_t)1536 * 4096;
    const float* cw = F.in[I_HCW] + (size_t)l * 3 * 1536; const float* cbv = F.in[I_HCB] + (size_t)l * 1536;
    const float* kfl = (const float*)(F.ws + WS_KFL) + ((size_t)l * 512 + c) * 2 * 8192;
    const float* kfs = (const float*)(F.ws + WS_KFS) + ((size_t)l * 2 + 0) * 2 * 512;
    const int tid = F.tid;
    int t0_ = 8 * tid; asm volatile("" : "+v"(t0_)); const int t0 = t0_;
    float a0[8], a1[8], g0[2][8], g1[2][8];
#pragma unroll
    for (int part = 0; part < 3; ++part) { const int cc = part * 512 + c; const float w0 = cw[cc], w1 = cw[1536 + cc], w2 = cw[3072 + cc], bb = cbv[cc];
#pragma unroll
        for (int bt = 0; bt < 2; ++bt) { const float* z = (bt ? hz1 : hz0) + (size_t)cc * 4096 + t0;
            const f32x4 za = *(const GAS f32x4*)z, zb = *(const GAS f32x4*)(z + 4);
            float zm = z[t0 > 0 ? -1 : 0], zp = z[t0 + 8 < 4096 ? 8 : 7]; zm = t0 > 0 ? zm : 0.f; zp = t0 + 8 < 4096 ? zp : 0.f;
            const float zz[10] = {zm, za[0], za[1], za[2], za[3], zb[0], zb[1], zb[2], zb[3], zp};
#pragma unroll
            for (int i = 0; i < 8; ++i) { const float s = zz[i] * w0 + zz[i + 1] * w1 + zz[i + 2] * w2 + bb;
                if (part == 0) { if (bt) a1[i] = s; else a0[i] = s; } else { if (bt) g1[part - 1][i] = s; else g0[part - 1][i] = s; } } } }
    float kq[2][16];
#pragma unroll
    for (int o = 0; o < 2; ++o) { const float sc = kfs[o * 512 + c]; const float* kf = kfl + o * 8192 + t0;
        const f32x4 ka = __builtin_nontemporal_load((const GAS f32x4*)kf), kb = __builtin_nontemporal_load((const GAS f32x4*)(kf + 4)), kc = __builtin_nontemporal_load((const GAS f32x4*)(kf + 4096)), kd = __builtin_nontemporal_load((const GAS f32x4*)(kf + 4100));
#pragma unroll
        for (int i = 0; i < 4; ++i) { kq[o][2 * i] = ka[i] * sc; kq[o][2 * i + 1] = kc[i] * sc; kq[o][2 * (i + 4)] = kb[i] * sc; kq[o][2 * (i + 4) + 1] = kd[i] * sc; } }
    const float frb = (float)t0 * (1.0f / 8192.0f); float wbc = __builtin_amdgcn_cosf(frb), wbs = __builtin_amdgcn_sinf(frb); asm volatile("s_nop 1" : "+v"(wbc), "+v"(wbs)); const cpx wb = cpx{wbc, -wbs};
    constexpr float WC[8] = {1.0f, 0.99999970586288223f, 0.99999882345170188f, 0.99999735276697821f, 0.99999529380957619f, 0.99999264658070719f, 0.99998941108192840f, 0.99998558731514291f};
    constexpr float WS[8] = {0.0f, 0.00076699031874270453f, 0.0015339801862847655f, 0.0023009691514258030f, 0.0030679567629659761f, 0.0038349425697062270f, 0.0046019261204485705f, 0.0053689069639963418f};
#pragma unroll 1
    for (int o = 0; o < 2; ++o) {
        { int tq = t0; float wbx = wb.x, wby = wb.y; asm volatile("" : "+v"(tq), "+v"(wbx), "+v"(wby)); const cpx wbl = cpx{wbx, wby};
#pragma unroll
          for (int i = 0; i < 8; ++i) { const int j = tq + i; const float k0 = o ? kq[1][2 * i] : kq[0][2 * i], k1 = o ? kq[1][2 * i + 1] : kq[0][2 * i + 1]; const float d = k0 - k1;
              const cpx w = i ? cmul(wbl, cpx{WC[i], -WS[i]}) : wbl;
              RB[fpos(j)] = cpx{k0 + k1, 0.f}; RB[FFT_HALF_STRIDE + fpos(j)] = cpx{d * w.x, d * w.y};
              const cpx z = cpx{a0[i], a1[i]}; RA[fpos(j)] = z; RA[FFT_HALF_STRIDE + fpos(j)] = cmul(z, w); } }
        __syncthreads();
#pragma unroll 1
        for (int p = 0; p < 2; ++p) {
#pragma unroll 1
            for (int r = 0; r < 2; ++r) fft_pass_rt<false>(r ? RB : RA, tid, 12 - 4 * p);
            __syncthreads();
        }
        { int tq = tid; asm volatile("" : "+v"(tq)); const int u = tq & 255; LAS cpx* bA = RA + (tq >> 8) * FFT_HALF_STRIDE + 17 * u; LAS cpx* bB = bA + 2 * FFT_HALF_STRIDE;
          cpx v[16], f[16];
#pragma unroll
          for (int q = 0; q < 16; ++q) { v[q] = bA[q]; f[q] = bB[q]; }
          dft16<false>(v); dft16<false>(f);
#pragma unroll
          for (int q = 0; q < 16; ++q) v[q] = cmul(v[q], f[q]);
          dft16<true>(v);
#pragma unroll
          for (int q = 0; q < 16; ++q) bA[q] = v[q]; }
        __syncthreads();
#pragma unroll 1
        for (int p = 1; p < 3; ++p) { fft_pass_rt<true>(RA, tid, 4 + 4 * p); __syncthreads(); }
        { const float sk = F.in[I_HSKIP][((size_t)l * 2 + o) * 512 + c]; int tq = t0; float wbx = wb.x, wby = wb.y; asm volatile("" : "+v"(tq), "+v"(wbx), "+v"(wby)); const cpx wbl = cpx{wbx, wby};
#pragma unroll
          for (int i = 0; i < 8; ++i) { const int j = tq + i; const cpx wf = i ? cmul(wbl, cpx{WC[i], -WS[i]}) : wbl; const cpx wc = cpx{wf.x, -wf.y};
              const cpx lo = RA[fpos(j)], up = cmul(RA[FFT_HALF_STRIDE + fpos(j)], wc);
              const float y0 = (lo.x + up.x) * (1.0f / 8192.0f), y1 = (lo.y + up.y) * (1.0f / 8192.0f);
              const float x0 = o ? g0[1][i] : g0[0][i], x1 = o ? g1[1][i] : g1[0][i];
              a0[i] = x0 * (y0 + a0[i] * sk); a1[i] = x1 * (y1 + a1[i] * sk); } }
    }
    __syncthreads();
    { bf16* cot = (bf16*)(F.ws + WS_COTL) + (size_t)c * 4096 + t0;
      const v4u w0 = {cvtpk(a0[0], a0[1]), cvtpk(a0[2], a0[3]), cvtpk(a0[4], a0[5]), cvtpk(a0[6], a0[7])}, w1 = {cvtpk(a1[0], a1[1]), cvtpk(a1[2], a1[3]), cvtpk(a1[4], a1[5]), cvtpk(a1[6], a1[7])};
      *(GAS v4u*)cot = w0; *(GAS v4u*)(cot + (size_t)512 * 4096) = w1; }
}
__device__ __forceinline__ void hyena_ctx_item(Frame& F, int l, int it) {
    const int cq = F.tid >> 7, r = F.tid & 127, b = r >> 6, tq = r & 63, c = 4 * it + cq, t0 = 4 * tq;
    LAS float* K0 = (LAS float*)(F.lds + RING_OFF) + cq * 1536; LAS float* K1 = K0 + 512; LAS float* U = K1 + 512;
    const float* kfc = (const float*)(F.ws + WS_KFC) + ((size_t)l * 512 + c) * 2 * 512;
    const float* kfs = (const float*)(F.ws + WS_KFS) + ((size_t)l * 2 + 1) * 2 * 512;
    const float* cw = F.in[I_HCW] + (size_t)l * 3 * 1536; const float* cbv = F.in[I_HCB] + (size_t)l * 1536;
    const float sk0 = F.in[I_HSKIP][((size_t)l * 2 + 0) * 512 + c], sk1 = F.in[I_HSKIP][((size_t)l * 2 + 1) * 512 + c];
    const float* hz = (const float*)(F.ws + WS_HZC) + (size_t)b * 1536 * 256;
    const f32x4 k0v = *(const GAS f32x4*)(kfc + 4 * r) * kfs[c], k1v = *(const GAS f32x4*)(kfc + 512 + 4 * r) * kfs[512 + c];
    float xs[3][4];
#pragma unroll
    for (int part = 0; part < 3; ++part) { const int cc = part * 512 + c; const float* z = hz + (size_t)cc * 256 + t0; const float w0 = cw[cc], w1 = cw[1536 + cc], w2 = cw[3072 + cc], bb = cbv[cc];
        const f32x4 zc = *(const GAS f32x4*)z; const float zm = t0 > 0 ? z[-1] : 0.f, zp = t0 + 4 < 256 ? z[4] : 0.f;
        xs[part][0] = zm * w0 + zc[0] * w1 + zc[1] * w2 + bb; xs[part][1] = zc[0] * w0 + zc[1] * w1 + zc[2] * w2 + bb;
        xs[part][2] = zc[1] * w0 + zc[2] * w1 + zc[3] * w2 + bb; xs[part][3] = zc[2] * w0 + zc[3] * w1 + zp * w2 + bb; }
    *(LAS f32x4*)(K0 + 4 * r) = k0v; *(LAS f32x4*)(K1 + 4 * r) = k1v;
    *(LAS f32x4*)(U + b * 256 + t0) = (f32x4){xs[0][0], xs[0][1], xs[0][2], xs[0][3]};
    float cur[4] = {xs[0][0], xs[0][1], xs[0][2], xs[0][3]};
#pragma unroll 1
    for (int o = 0; o < 2; ++o) {
        __syncthreads();
        const LAS float* K = o ? K1 : K0; const LAS float* Ub = U + b * 256;
        float y[4] = {0.f, 0.f, 0.f, 0.f};
        f32x4 ghi = *(const LAS f32x4*)(K + (t0 & 511)), glo = *(const LAS f32x4*)(K + ((t0 - 4) & 511));
#pragma unroll 4
        for (int s = 0; s < 256; s += 4) {
            const f32x4 u = *(const LAS f32x4*)(Ub + s);
            const float kk[8] = {glo[0], glo[1], glo[2], glo[3], ghi[0], ghi[1], ghi[2], ghi[3]};
#pragma unroll
            for (int k = 0; k < 4; ++k)
#pragma unroll
                for (int j = 0; j < 4; ++j) y[k] += u[j] * kk[4 + k - j];
            ghi = glo; glo = *(const LAS f32x4*)(K + ((t0 - s - 8) & 511));
        }
        const float sk = o ? sk1 : sk0;
#pragma unroll
        for (int k = 0; k < 4; ++k) cur[k] = (o ? xs[2][k] : xs[1][k]) * (y[k] + cur[k] * sk);
        __syncthreads();
        if (o == 0) *(LAS f32x4*)(U + b * 256 + t0) = (f32x4){cur[0], cur[1], cur[2], cur[3]};
    }
    u32x2 w; w.x = cvtpk(cur[0], cur[1]); w.y = cvtpk(cur[2], cur[3]);
    *(GAS u32x2*)((bf16*)(F.ws + WS_COTC) + ((size_t)b * 512 + c) * 256 + t0) = w;
    __syncthreads();
}
__device__ __forceinline__ void hy_transpose_item(Frame& F, int it) {
    LAS bf16* T = (LAS bf16*)(F.lds + RING_OFF);
    const bool lat = it < 256; const int x = lat ? it : it - 256;
    const int tt = lat ? (x & 15) : 0, ct = lat ? ((x >> 4) & 7) : (x & 7), b = lat ? (x >> 7) : (x >> 3);
    const int L = lat ? 4096 : 256;
    const bf16* src = (lat ? (const bf16*)(F.ws + WS_COTL) : (const bf16*)(F.ws + WS_COTC)) + ((size_t)b * 512 + ct * 64) * L + tt * 256;
    v4u d[4];
#pragma unroll
    for (int i = 0; i < 4; ++i) { const int id = F.tid + 512 * i, ch = id >> 5, k = id & 31; d[i] = __builtin_nontemporal_load((const GAS v4u*)(src + (size_t)ch * L + 8 * k)); }
#pragma unroll
    for (int i = 0; i < 4; ++i) { const int id = F.tid + 512 * i, ch = id >> 5, k = id & 31; LAS unsigned* tp = (LAS unsigned*)(T + ch * 264 + 8 * k); tp[0] = d[i].x; tp[1] = d[i].y; tp[2] = d[i].z; tp[3] = d[i].w; }
    __syncthreads();
#pragma unroll
    for (int i = 0; i < 4; ++i) { const int id = F.tid + 512 * i, t = id >> 3, cc = id & 7; unsigned w[4];
#pragma unroll
        for (int k = 0; k < 4; ++k) w[k] = (unsigned)T[(8 * cc + 2 * k) * 264 + t] | ((unsigned)T[(8 * cc + 2 * k + 1) * 264 + t] << 16);
        const size_t row = (size_t)(lat ? b * SEQ : ML + b * CTXL) + tt * 256 + t;
        *(GAS v4u*)((bf16*)(F.ws + WS_MIX) + row * DMIX + 1536 + ct * 64 + 8 * cc) = (v4u){w[0], w[1], w[2], w[3]}; }
    __syncthreads();
}
constexpr int KT_STRIDE = 272, VT_STRIDE = 264;
constexpr int KT_BYTES = 128 * KT_STRIDE;
__device__ __forceinline__ f32x16 mfma32(bf16x8 a, bf16x8 b, f32x16 c) { return __builtin_amdgcn_mfma_f32_32x32x16_bf16(a, b, c, 0, 0, 0); }
__device__ __forceinline__ void attn_item(Frame& F, int l, int it) {
    const bool lat = it < 256; int nblk, pair, kh, b;
    if (lat) { nblk = it & 31; pair = (it >> 5) & 1; kh = (it >> 6) & 1; b = it >> 7; } else { const int x = it - 256; nblk = x & 1; pair = (x >> 1) & 1; kh = (x >> 2) & 1; b = x >> 3; }
    int lane_ = F.lane; asm volatile("" : "+v"(lane_));
    const int w = F.wave, lane = lane_, h = lane >> 5, ql = lane & 31;
    const int hq = 4 * kh + 2 * pair + (w >> 2);
    const int qi = 32 * (w & 3) + ql;
    const size_t qrow = (size_t)(lat ? b * SEQ : ML + b * CTXL) + 128 * nblk + qi;
    const bf16* QBp = (const bf16*)(F.ws + WS_QB); const bf16* KBp = (const bf16*)(F.ws + WS_KB);
    const bf16* VTl = (const bf16*)(F.ws + WS_VTL); const bf16* VTc = (const bf16*)(F.ws + WS_VTC);
    LAS unsigned char* Kt = F.lds + RING_OFF; LAS unsigned char* Vt = Kt + KT_BYTES;
    LAS unsigned char* Ost = F.lds + RING_OFF + 69632 + w * 8704;
    const size_t wrow = qrow - ql;
    { v4u qd[8];
#pragma unroll
      for (int i = 0; i < 8; ++i) { const int id = lane + 64 * i; qd[i] = *(const GAS v4u*)(QBp + (wrow + (id >> 4)) * 1024 + hq * 128 + 8 * (id & 15)); }
#pragma unroll
      for (int i = 0; i < 8; ++i) { const int id = lane + 64 * i; *(LAS v4u*)(Ost + (id >> 4) * 272 + (id & 15) * 16) = qd[i]; } }
    bf16x8 qf[8];
#pragma unroll
    for (int s = 0; s < 8; ++s) qf[s] = *(const LAS bf16x8*)(Ost + ql * 272 + (16 * s + 8 * h) * 2);
    float m = F.in[I_SINK][l * 8 + hq] * LOG2E; float lsum = h == 0 ? 1.0f : 0.0f;
    f32x16 O[4];
#pragma unroll
    for (int dt = 0; dt < 4; ++dt)
#pragma unroll
        for (int r = 0; r < 16; ++r) O[dt][r] = 0.f;
    const int ntiles = lat ? 5 : 2;
#define ATT_TILE(t, ksrc, vsrc, vld) do { if ((t) < 2) { ksrc = KBp + (size_t)(ML + b * CTXL + 128 * (t)) * 256 + kh * 128; vsrc = VTc + (size_t)((b * 2 + kh) * 128) * 256 + 128 * (t); vld = 256; } \
        else { const int kb_ = nblk + (t) - 3; ksrc = KBp + (size_t)(b * SEQ + 128 * kb_) * 256 + kh * 128; vsrc = VTl + (size_t)((b * 2 + kh) * 128) * 4096 + 128 * kb_; vld = 4096; } } while (0)
#define ATT_LOAD(ksrc, vsrc, vld) do { _Pragma("unroll") for (int i = 0; i < 4; ++i) { const int id = F.tid + 512 * i, row = id >> 4, ch = id & 15; \
        kd[i] = *(const GAS v4u*)(ksrc + (size_t)row * 256 + ch * 8); vd[i] = *(const GAS v4u*)(vsrc + (size_t)row * vld + ch * 8); } } while (0)
    v4u kd[4], vd[4];
    int ti = 0;
    { const bf16* ksrc; const bf16* vsrc; int vld; ATT_TILE(0, ksrc, vsrc, vld); ATT_LOAD(ksrc, vsrc, vld); }
    while (ti < ntiles) {
        const int type = ti < 2 ? 0 : (ti == 2 ? 1 : (ti == 3 ? 0 : 2));
        __syncthreads();
#pragma unroll
        for (int i = 0; i < 4; ++i) { const int id = F.tid + 512 * i, row = id >> 4, ch = id & 15;
            *(LAS v4u*)(Kt + row * KT_STRIDE + ch * 16) = kd[i];
            *(LAS u32x2*)(Vt + row * VT_STRIDE + ch * 16) = (u32x2){vd[i].x, vd[i].y}; *(LAS u32x2*)(Vt + row * VT_STRIDE + ch * 16 + 8) = (u32x2){vd[i].z, vd[i].w}; }
        __syncthreads();
        int tn = ti + 1; if (tn == 2 && nblk == 0) tn = 3; if (tn == 4 && nblk == 31) tn = 5;
        if (tn < ntiles) { const bf16* ksrc; const bf16* vsrc; int vld; ATT_TILE(tn, ksrc, vsrc, vld); ATT_LOAD(ksrc, vsrc, vld); }
#pragma unroll 1
        for (int hs = 0; hs < 2; ++hs) {
            f32x16 S[2];
#pragma unroll
            for (int sb = 0; sb < 2; ++sb) {
#pragma unroll
                for (int r = 0; r < 16; ++r) S[sb][r] = 0.f;
#pragma unroll
                for (int s = 0; s < 8; ++s) { const bf16x8 a = *(const LAS bf16x8*)(Kt + (32 * (2 * hs + sb) + ql) * KT_STRIDE + (16 * s + 8 * h) * 2); S[sb] = mfma32(a, qf[s], S[sb]); }
            }
            if (type != 0) {
                int qv = type == 1 ? qi - 4 * h - 64 * hs : -(qi - 4 * h - 64 * hs); asm volatile("" : "+v"(qv));
#pragma unroll
                for (int sb = 0; sb < 2; ++sb)
#pragma unroll
                    for (int r = 0; r < 16; ++r) { const int j0 = 32 * sb + (r & 3) + 8 * (r >> 2); const int jv = type == 1 ? j0 : -j0; if (jv < qv) S[sb][r] = -1e30f; }
            }
            float mx = m;
#pragma unroll
            for (int sb = 0; sb < 2; ++sb)
#pragma unroll
                for (int r = 0; r < 16; ++r) mx = fmaxf(mx, S[sb][r]);
            mx = fmaxf(mx, __shfl_xor(mx, 32));
            const float alpha = __builtin_amdgcn_exp2f(m - mx); m = mx; lsum *= alpha;
#pragma unroll
            for (int dt = 0; dt < 4; ++dt)
#pragma unroll
                for (int r = 0; r < 16; ++r) O[dt][r] *= alpha;
            float ps = 0.f;
#pragma unroll
            for (int sb = 0; sb < 2; ++sb)
#pragma unroll
                for (int r = 0; r < 16; ++r) { const float p = __builtin_amdgcn_exp2f(S[sb][r] - mx); S[sb][r] = p; ps += p; }
            lsum += ps;
#pragma unroll
            for (int sb = 0; sb < 2; ++sb)
#pragma unroll
                for (int s2 = 0; s2 < 2; ++s2) {
                    v4u pw; pw.x = cvtpk(S[sb][8 * s2 + 0], S[sb][8 * s2 + 1]); pw.y = cvtpk(S[sb][8 * s2 + 2], S[sb][8 * s2 + 3]); pw.z = cvtpk(S[sb][8 * s2 + 4], S[sb][8 * s2 + 5]); pw.w = cvtpk(S[sb][8 * s2 + 6], S[sb][8 * s2 + 7]);
                    const bf16x8 pf = __builtin_bit_cast(bf16x8, pw);
#pragma unroll
                    for (int dt = 0; dt < 4; ++dt) { LAS unsigned char* vb = Vt + (32 * dt + ql) * VT_STRIDE + (32 * (2 * hs + sb) + 16 * s2 + 4 * h) * 2;
                        const u32x2 lo = *(const LAS u32x2*)vb, hi = *(const LAS u32x2*)(vb + 16);
                        const bf16x8 a = __builtin_bit_cast(bf16x8, (v4u){lo.x, lo.y, hi.x, hi.y});
                        O[dt] = mfma32(a, pf, O[dt]); }
                    asm volatile("" ::: "memory");
                }
        }
        ti = tn;
    }
#undef ATT_TILE
#undef ATT_LOAD
    const float lt = lsum + __shfl_xor(lsum, 32); const float inv = 1.0f / lt;
    { int lq = lane; asm volatile("" : "+v"(lq));
      const int ql2 = lq & 31, h2 = lq >> 5;
#pragma unroll
      for (int dt = 0; dt < 4; ++dt)
#pragma unroll
          for (int g = 0; g < 4; ++g) { u32x2 wv; wv.x = cvtpk(O[dt][4 * g + 0] * inv, O[dt][4 * g + 1] * inv); wv.y = cvtpk(O[dt][4 * g + 2] * inv, O[dt][4 * g + 3] * inv);
              *(LAS u32x2*)(Ost + ql2 * 272 + (32 * dt + 8 * g + 4 * h2) * 2) = wv; }
      bf16* op = (bf16*)(F.ws + WS_MIX) + ((size_t)(lat ? b * SEQ : ML + b * CTXL) + 128 * nblk + 32 * (w & 3)) * DMIX + 512 + hq * 128;
#pragma unroll
      for (int i = 0; i < 8; ++i) { const int id = lq + 64 * i; *(GAS v4u*)(op + (size_t)(id >> 4) * DMIX + 8 * (id & 15)) = *(const LAS v4u*)(Ost + (id >> 4) * 272 + (id & 15) * 16); } }
    __syncthreads();
}
__device__ __forceinline__ void sgu_item(Frame& F, int l, int it) {
    const int n = it >> 2, g = it & 3; const int row0 = 128 * n;
    int lane_ = F.lane; asm volatile("" : "+v"(lane_));
    const int w = F.wave, lane = lane_, h = lane >> 5, ql = lane & 31;
    LAS unsigned char* VnT = F.lds + RING_OFF;
    const bf16* AU = (const bf16*)(F.ws + WS_AU);
    const int ct = w & 3, qt0 = 2 * (w >> 2);
    const float* Ws = F.in[I_SGUW] + ((size_t)l * 4 + g) * 128 * 128;
    bf16* MIXp = (bf16*)(F.ws + WS_MIX);
    float gam[8];
#pragma unroll
    for (int k = 0; k < 8; ++k) gam[k] = F.in[I_SGUG][l * 512 + 8 * lane + k];
    v4u dd[16];
#pragma unroll
    for (int rr = 0; rr < 16; ++rr) dd[rr] = *(const GAS v4u*)(AU + (size_t)(row0 + 16 * w + rr) * 1024 + 512 + 8 * lane);
    v4u bfr[2][8]; float bs[2];
    LAS unsigned char* Ut = VnT + 128 * 272;
    v4u ud[4];
#pragma unroll
    for (int i = 0; i < 4; ++i) { const int id = (w * 64 + lane) + 512 * i; ud[i] = *(const GAS v4u*)(AU + ((size_t)row0 + (id >> 4)) * 1024 + 128 * g + 8 * (id & 15)); }
#pragma unroll
    for (int qq = 0; qq < 2; ++qq) { const int q = 32 * (qt0 + qq) + ql; const GAS float* wp = (const GAS float*)(Ws + (size_t)q * 128 + 8 * h);
        f32x4 w0[8], w1[8];
#pragma unroll
        for (int s = 0; s < 8; ++s) { w0[s] = *(const GAS f32x4*)(wp + 16 * s); w1[s] = *(const GAS f32x4*)(wp + 16 * s + 4); }
        bs[qq] = F.in[I_SGUB][((size_t)l * 4 + g) * 128 + q];
#pragma unroll
        for (int s = 0; s < 8; ++s) bfr[qq][s] = (v4u){cvtpk(w0[s][0], w0[s][1]), cvtpk(w0[s][2], w0[s][3]), cvtpk(w1[s][0], w1[s][1]), cvtpk(w1[s][2], w1[s][3])}; }
#pragma unroll
    for (int rr = 0; rr < 16; ++rr) {
        const int p = 16 * w + rr; const v4u d = dd[rr];
        float x[8] = {bf_lo(d.x), bf_hi(d.x), bf_lo(d.y), bf_hi(d.y), bf_lo(d.z), bf_hi(d.z), bf_lo(d.w), bf_hi(d.w)};
        float s = 0.f;
#pragma unroll
        for (int k = 0; k < 8; ++k) s += x[k];
        const float mean = wave_sum(s) * (1.0f / 512.0f); float q = 0.f;
#pragma unroll
        for (int k = 0; k < 8; ++k) { x[k] -= mean; q += x[k] * x[k]; }
        const float rstd = rsqrtf(wave_sum(q) * (1.0f / 512.0f) + NORM_EPS);
        if ((lane >> 4) == g) {
#pragma unroll
            for (int k = 0; k < 8; ++k) { const int cl = 8 * (lane & 15) + k; *(LAS bf16*)(VnT + cl * 272 + ((((p >> 3) ^ (lane & 15)) << 4) | ((p & 7) << 1))) = (bf16)f2bf(x[k] * rstd * gam[k]); }
        }
    }
#pragma unroll
    for (int i = 0; i < 4; ++i) { const int id = (w * 64 + lane) + 512 * i; *(LAS v4u*)(Ut + (id >> 4) * 272 + (id & 15) * 16) = ud[i]; }
    __syncthreads();
    bf16x8 af[8];
#pragma unroll
    for (int s = 0; s < 8; ++s) af[s] = *(const LAS bf16x8*)(VnT + (32 * ct + ql) * 272 + (((2 * s + h) ^ (((32 * ct + ql) >> 3) & 15)) << 4));
#pragma unroll
    for (int qq = 0; qq < 2; ++qq) {
        const int q = 32 * (qt0 + qq) + ql;
        f32x16 D;
#pragma unroll
        for (int r = 0; r < 16; ++r) D[r] = 0.f;
#pragma unroll
        for (int s = 0; s < 8; ++s) D = mfma32(af[s], __builtin_bit_cast(bf16x8, bfr[qq][s]), D);
        const size_t row = (size_t)row0 + q;
#pragma unroll
        for (int gi = 0; gi < 4; ++gi) { LAS u32x2* up = (LAS u32x2*)(Ut + q * 272 + (32 * ct + 8 * gi + 4 * h) * 2); const u32x2 u2 = *up;
            u32x2 o; o.x = cvtpk(bf_lo(u2.x) * (D[4 * gi + 0] + bs[qq]), bf_hi(u2.x) * (D[4 * gi + 1] + bs[qq])); o.y = cvtpk(bf_lo(u2.y) * (D[4 * gi + 2] + bs[qq]), bf_hi(u2.y) * (D[4 * gi + 3] + bs[qq]));
            *up = o; }
    }
    __syncthreads();
#pragma unroll
    for (int i = 0; i < 4; ++i) { const int id = (w * 64 + lane) + 512 * i; *(GAS v4u*)(MIXp + ((size_t)row0 + (id >> 4)) * DMIX + 128 * g + 8 * (id & 15)) = *(const LAS v4u*)(Ut + (id >> 4) * 272 + (id & 15) * 16); }
    __syncthreads();
}
#ifndef PHM
#define PHM 0xffffffffu
#endif
#define PON(b) ((PHM >> (b)) & 1u)
__device__ __forceinline__ int grab(Frame& F, int qidx) {
    __syncthreads();
    if (F.tid == 0) F.MISC[16] = __hip_atomic_fetch_add(F.ctl + CW_Q + qidx * 64, 1u, __ATOMIC_RELAXED, __HIP_MEMORY_SCOPE_AGENT);
    __syncthreads();
    return (int)F.MISC[16];
}
#ifndef PROBE_DUP
#define PROBE_DUP 0
#endif
__device__ __forceinline__ Frame phase_frame(const Frame& F);
__device__ __forceinline__ void mixer_phase(Frame& F, int lq) {
    const int l = lq & 3;
    for (int rep = 0; rep < (PROBE_DUP == 12 ? 2 : 1); ++rep)
    if (PON(12)) { Frame P = phase_frame(F);
        const bool remap = P.G == 256;
        for (int it0 = P.bx; it0 < (remap ? 512 : 272); it0 += P.G) { int it = it0; if (remap && it0 >= 256) { const int x = it0 - 256; it = (x >= 128 && x < 144) ? 128 + x : 1 << 20; } if (it < 272) attn_item(P, l, it); } }
    for (int rep = 0; rep < (PROBE_DUP == 13 ? 2 : 1); ++rep)
    if (PON(13)) { Frame P = phase_frame(F); for (int it = P.bx; it < 512; it += P.G) hyena_lat_item(P, l, it); }
    for (int rep = 0; rep < (PROBE_DUP == 14 ? 2 : 1); ++rep)
    if (PON(14)) { Frame P = phase_frame(F); for (int it = P.G - 1 - P.bx; it < 272; it += P.G) sgu_item(P, l, it); }
    for (int rep = 0; rep < (PROBE_DUP == 15 ? 2 : 1); ++rep)
    if (PON(15)) { Frame P = phase_frame(F); for (int it = P.bx; it < 128; it += P.G) hyena_ctx_item(P, l, it); }
}

__device__ __forceinline__ void win_fixup(Frame& F) {
    for (int it = F.bx; it < 256; it += F.G) {
        const int tile = it >> 3, ai = (it >> 2) & 1, m = it & 3;
        const int pm = 32 + (tile & 1), pn = tile >> 1;
        const int wid = F.wave, lane = F.lane, wr = wid >> 2, wc = wid & 3, fr = lane & 15, fq = lane >> 4;
        const bf16* zs = (const bf16*)(F.ws + WS_ZS) + ((size_t)(pm - 32) * 256 + ai * 128 + m * 16 + wr * 64 + fr) * 4096 + pn * 256 + wc * 32 + 8 * fq;
        v4u part[S_IN][2];
#pragma unroll
        for (int s = 0; s < S_IN; ++s)
#pragma unroll
            for (int bj = 0; bj < 2; ++bj) part[s][bj] = __builtin_nontemporal_load((const GAS v4u*)(zs + (size_t)s * 512 * 4096 + bj * 128));
        pg8::f32x4 acc[1][2][1][2];
#pragma unroll
        for (int bj = 0; bj < 2; ++bj) { pg8::f32x4 v0 = {0.f, 0.f, 0.f, 0.f}, v1 = v0;
#pragma unroll
            for (int s = 0; s < S_IN; ++s) { const v4u w = part[s][bj]; v0 += (pg8::f32x4){bf_lo(w.x), bf_hi(w.x), bf_lo(w.y), bf_hi(w.y)}; v1 += (pg8::f32x4){bf_lo(w.z), bf_hi(w.z), bf_lo(w.w), bf_hi(w.w)}; }
            acc[0][bj][0][0] = v0; acc[0][bj][0][1] = v1; }
        pg8::EpiWin E{F.ws, QSCALE};
        E.finish<1, 1>(acc, pm * 256 + ai * 128 + m * 16, pm, pn, wr, wc, fr, fq);
    }
}
__device__ __forceinline__ Frame phase_frame(const Frame& F) {
    Frame P = F;
    unsigned long long w = (unsigned long long)P.ws; int gg = P.G, bx = P.bx; asm volatile("" : "+s"(w), "+s"(gg), "+s"(bx)); P.ws = (unsigned char*)w; P.G = gg; P.bx = bx;
    P.ctl = (gu32*)(P.ws + WS_CTL);
    int ln; asm volatile("v_mbcnt_lo_u32_b32 %0, -1, 0\n\tv_mbcnt_hi_u32_b32 %0, -1, %0" : "=v"(ln)); P.lane = ln; P.tid = P.wave * 64 + ln;
    return P;
}
struct Args { const float* in[28]; float* out; unsigned char* ws; int ph_lo, ph_hi; };
constexpr int NPH = 2 + 12 * DEPTH;
__global__ void __launch_bounds__(NWAVES * 64, 2) hymba_fwd(Args args) {
    extern __shared__ __attribute__((aligned(16))) unsigned char lds[];
    Frame F;
    F.lds = (LAS unsigned char*)lds;
    F.MISC = (volatile LAS unsigned*)(F.lds + MISC_OFF);
    F.tid = threadIdx.x; F.lane = F.tid & 63; F.wave = __builtin_amdgcn_readfirstlane(F.tid >> 6);
    F.G = gridDim.x; F.bx = blockIdx.x;
    F.in = args.in;
    F.out = args.out; F.ws = args.ws;
    F.ctl = (gu32*)(args.ws + WS_CTL);
    for (int u = F.tid; u < (LDS_BYTES - LDSCTL_OFF) / 4; u += NWAVES * 64) ((LAS unsigned*)(F.lds + LDSCTL_OFF))[u] = 0u;
    __syncthreads();
    XcdBarrier bar; bar.bar = (unsigned*)(F.ctl + CW_BAR); bar.x = 0; bar.st = nullptr;
    if (!MK_MULTI) bar = xcd_barrier_post((unsigned*)(F.ctl + CW_BAR), F.MISC + 8);
    const int lo = args.ph_lo, hi = args.ph_hi;
#ifndef STAMP_LNB
#define STAMP_LNB 0.1823215568f
#endif
#ifndef STAMP_OFS
#define STAMP_OFS 0.0f
#endif
#ifndef STAMP_SEL
#define STAMP_SEL -1
#endif
#define tsb ((unsigned long long*)(args.ws + WS_CTL + 512 * 1024))
#define STAMP(p) do { if (STAMP_SEL >= 0 && blockIdx.x == 0 && threadIdx.x == 0) tsb[p] = __builtin_amdgcn_s_memrealtime(); } while (0)
#ifndef PHM
#define PHM 0xffffffffu
#endif
#define PON(b) ((PHM >> (b)) & 1u)
#define IN(k) (lo <= (k) && (k) < hi)
#define SEAM(k) do { if (!MK_MULTI && (k) + 1 < hi) xcd_barrier(bar); } while (0)

#ifndef PROBE_DUP
#define PROBE_DUP 0
#endif
    STAMP(0);
    if (IN(0)) { if (PON(0)) { Frame P = phase_frame(F); p0_prologue(P); } SEAM(0); }
    if (PROBE_DUP == 1) { { Frame P = phase_frame(F); p0_prologue(P); } xcd_barrier(bar); }
    STAMP(1);
    if (IN(1)) {
        Frame P = phase_frame(F);
        const bool conv_first = ((P.bx >> 3) & 1) != 0;
        if (conv_first) { p0_convert_all(P); __syncthreads(); }
        if (PON(1)) for (int it = P.bx; it < DEPTH * 2 * 64; it += P.G) p1_filter_item(P, it);
        if (!conv_first) { __syncthreads(); p0_convert_all(P); }
        if (PON(2)) thin_phase<false, true, false>(P, 0, 0, 0.f, 0, 0, 0);
        SEAM(1);
    }
    for (int l = 0; l < DEPTH; ++l) {
        const int pb = 2 + 12 * l;
        STAMP(pb + 0);
        if (IN(pb + 0) && PON(3)) {
            Frame P = phase_frame(F); unsigned char* wl = P.ws + WS_W + (size_t)l * WL_STRIDE;
            pg8::Gemm g{(const pg8::bf16_t*)(P.ws + WS_XN), (const pg8::bf16_t*)(wl + WL_GU1), MA, 2 * FF, DM}; pg8::MixedOrder S; S.init(2 * FF, DM, 1, P.G, P.bx);
            pg8::EpiSwiGLU E{(pg8::bf16_t*)(P.ws + WS_H), FF};
            pg8::gemm_phase<pg8::EpiSwiGLU, pg8::MixedOrder, true, true>(P.lds + RING_OFF, g, S, E, P.tid);
            if (PROBE_DUP == 5) { xcd_barrier(bar); pg8::gemm_phase<pg8::EpiSwiGLU, pg8::MixedOrder, true, true>(P.lds + RING_OFF, g, S, E, P.tid); }
            if (PROBE_DUP == 7) { xcd_barrier(bar); pg8::EpiNone EN; pg8::gemm_phase<pg8::EpiNone, pg8::MixedOrder, true, true>(P.lds + RING_OFF, g, S, EN, P.tid); }
        }
        if (IN(pb + 0)) SEAM(pb + 0);
        if (PROBE_DUP == 20) { for (int rep = 0; rep < 8; ++rep) xcd_barrier(bar); }
        STAMP(pb + 1);
        if (IN(pb + 1) && PON(4)) {
            Frame P = phase_frame(F); unsigned char* wl = P.ws + WS_W + (size_t)l * WL_STRIDE;
            pg8::Gemm g{(const pg8::bf16_t*)(P.ws + WS_H), (const pg8::bf16_t*)(wl + WL_D1), MA, DM, FF}; pg8::MixedOrder S; S.init(DM, FF, S_DOWN, P.G, P.bx);
            pg8::EpiF32 E{(pg8::bf16_t*)(P.ws + WS_Y), DM, (pg8::bf16_t*)(P.ws + WS_YS)};
            pg8::gemm_phase<pg8::EpiF32, pg8::MixedOrder, true, true>(P.lds + RING_OFF, g, S, E, P.tid);
            if (PROBE_DUP == 4) { xcd_barrier(bar); pg8::gemm_phase<pg8::EpiF32, pg8::MixedOrder, true, true>(P.lds + RING_OFF, g, S, E, P.tid); }
        }
        if (IN(pb + 1)) SEAM(pb + 1);
        STAMP(pb + 2);
        if (IN(pb + 2)) { if (PON(5)) { Frame P = phase_frame(F); thin_phase<true, true, false>(P, l, 0, 0.5f, l, 1, S_DOWN); } SEAM(pb + 2); }
        STAMP(pb + 3);
        if (IN(pb + 3) && PON(6)) {
            Frame P = phase_frame(F); unsigned char* wl = P.ws + WS_W + (size_t)l * WL_STRIDE;
            pg8::Gemm g{(const pg8::bf16_t*)(P.ws + WS_XN), (const pg8::bf16_t*)(wl + WL_IN), MA, INC, DM}; pg8::MixedOrder S; S.init(INC, DM, S_IN, P.G, P.bx);
            pg8::EpiWin E{P.ws, QSCALE};
            pg8::gemm_phase<pg8::EpiWin, pg8::MixedOrder, true, true>(P.lds + RING_OFF, g, S, E, P.tid);
        }
        if (IN(pb + 3)) SEAM(pb + 3);
        STAMP(pb + 4);
        if (IN(pb + 4)) { if (PON(6)) { Frame P = phase_frame(F); win_fixup(P); } SEAM(pb + 4); }
        STAMP(pb + 5);
        if (IN(pb + 5)) { { Frame P = phase_frame(F); mixer_phase(P, l); } SEAM(pb + 5); }
        STAMP(pb + 6);
        if (IN(pb + 6)) { { Frame P = phase_frame(F); for (int it = P.bx; it < 272; it += P.G) hy_transpose_item(P, it); } SEAM(pb + 6); }
        STAMP(pb + 7);
        if (PROBE_DUP == 3) { { Frame P = phase_frame(F); mixer_phase(P, l + 4); } xcd_barrier(bar); }
        if (PROBE_DUP == 6) { { Frame P = phase_frame(F); win_fixup(P); } xcd_barrier(bar);
            { Frame P = phase_frame(F); for (int it = P.bx; it < 272; it += P.G) hy_transpose_item(P, it); } xcd_barrier(bar); }
        if (IN(pb + 7) && PON(7)) {
            Frame P = phase_frame(F); unsigned char* wl = P.ws + WS_W + (size_t)l * WL_STRIDE;
            pg8::Gemm g{(const pg8::bf16_t*)(P.ws + WS_MIX), (const pg8::bf16_t*)(wl + WL_OUT), MA, DM, DMIX}; pg8::MixedOrder S; S.init(DM, DMIX, S_OUT, P.G, P.bx, l != DEPTH - 1);
            pg8::EpiF32 E{(pg8::bf16_t*)(P.ws + WS_Y), DM, (pg8::bf16_t*)(P.ws + WS_YS)};
            pg8::gemm_phase<pg8::EpiF32, pg8::MixedOrder, true, true>(P.lds + RING_OFF, g, S, E, P.tid);
        }
        if (IN(pb + 7)) SEAM(pb + 7);
        STAMP(pb + 8);
        if (IN(pb + 8)) { if (PON(8)) { Frame P = phase_frame(F); thin_phase<true, true, false>(P, l, 1, 1.0f, l, 2, l == DEPTH - 1 ? -1 : S_OUT); } SEAM(pb + 8); }
        STAMP(pb + 9);
        if (IN(pb + 9) && PON(9)) {
            Frame P = phase_frame(F); unsigned char* wl = P.ws + WS_W + (size_t)l * WL_STRIDE;
            pg8::Gemm g{(const pg8::bf16_t*)(P.ws + WS_XN), (const pg8::bf16_t*)(wl + WL_GU2), MA, 2 * FF, DM}; pg8::MixedOrder S; S.init(2 * FF, DM, 1, P.G, P.bx, l != DEPTH - 1);
            pg8::EpiSwiGLU E{(pg8::bf16_t*)(P.ws + WS_H), FF};
            pg8::gemm_phase<pg8::EpiSwiGLU, pg8::MixedOrder, true, true>(P.lds + RING_OFF, g, S, E, P.tid);
        }
        if (IN(pb + 9)) SEAM(pb + 9);
        STAMP(pb + 10);
        if (IN(pb + 10) && PON(10)) {
            Frame P = phase_frame(F); unsigned char* wl = P.ws + WS_W + (size_t)l * WL_STRIDE;
            pg8::Gemm g{(const pg8::bf16_t*)(P.ws + WS_H), (const pg8::bf16_t*)(wl + WL_D2), MA, DM, FF}; pg8::MixedOrder S; S.init(DM, FF, S_DOWN, P.G, P.bx, l != DEPTH - 1);
            pg8::EpiF32 E{(pg8::bf16_t*)(P.ws + WS_Y), DM, (pg8::bf16_t*)(P.ws + WS_YS)};
            pg8::gemm_phase<pg8::EpiF32, pg8::MixedOrder, true, true>(P.lds + RING_OFF, g, S, E, P.tid);
        }
        if (IN(pb + 10)) SEAM(pb + 10);
        STAMP(pb + 11);
        if (IN(pb + 11)) {
            if (PON(11)) { Frame P = phase_frame(F);
                if (l == DEPTH - 1) thin_phase<true, false, true>(P, l, 2, 0.5f, 0, 0, S_DOWN);
                else thin_phase<true, true, false>(P, l, 2, 0.5f, l + 1, 0, S_DOWN); }
            SEAM(pb + 11);
        }
    }
    if (STAMP_SEL >= 0) {
        STAMP(NPH);
        xcd_barrier(bar);
        if (blockIdx.x == 0 && threadIdx.x == 0) { unsigned long long tot = 0;
            if (STAMP_SEL < 2) tot = tsb[STAMP_SEL + 1] - tsb[STAMP_SEL];
            else for (int l = 0; l < DEPTH; ++l) tot += tsb[2 + 12 * l + (STAMP_SEL - 2) + 1] - tsb[2 + 12 * l + (STAMP_SEL - 2)];
            const float us = (float)tot * 0.01f; const float k = floorf(__logf(us) * (1.0f / STAMP_LNB) + STAMP_OFS);
            args.out[0] = 1000.0f * k; }
    }
#undef IN
#undef SEAM
}

extern "C" void kernel_launch(void* const* d_in, const int* in_sizes, int n_in, void* d_out, int out_size, void* d_ws, size_t ws_size, hipStream_t stream) {
    static int grid = 0;
    if (grid == 0) {
        if (n_in != 28 || in_sizes[0] != ML * DM || out_size != ML * DM || ws_size < WS_END) { fprintf(stderr, "kernel_launch: unexpected shapes (n_in %d, in0 %d, out %d, ws %zu < %zu); nothing launched\n", n_in, n_in > 0 ? in_sizes[0] : -1, out_size, ws_size, (size_t)WS_END); grid = -1; return; }
        int dev = 0, cus = 0, per_cu = 0;
        if (hipGetDevice(&dev) != hipSuccess || hipDeviceGetAttribute(&cus, hipDeviceAttributeMultiprocessorCount, dev) != hipSuccess) { grid = -1; return; }
        if (hipFuncSetAttribute((const void*)hymba_fwd, hipFuncAttributeMaxDynamicSharedMemorySize, LDS_BYTES) != hipSuccess) { fprintf(stderr, "kernel_launch: hipFuncSetAttribute failed\n"); grid = -1; return; }
        if (hipOccupancyMaxActiveBlocksPerMultiprocessor(&per_cu, (const void*)hymba_fwd, NWAVES * 64, LDS_BYTES) != hipSuccess || per_cu < 1)
            fprintf(stderr, "kernel_launch: note: occupancy query reports %d workgroups per CU\n", per_cu);
        (void)hipGetLastError();
        grid = cus;
    }
    if (grid < 0) return;
    if (hipMemsetAsync((char*)d_ws + WS_CTL, 0, CTL_ZERO_BYTES, stream) != hipSuccess) { fprintf(stderr, "kernel_launch: hipMemsetAsync failed\n"); return; }
    Args a{};
    for (int i = 0; i < 28; ++i) a.in[i] = (const float*)d_in[i];
    a.out = (float*)d_out; a.ws = (unsigned char*)d_ws;
#if MK_MULTI
    for (int p = 0; p < NPH; ++p) { a.ph_lo = p; a.ph_hi = p + 1; hipLaunchKernelGGL(hymba_fwd, dim3(grid), dim3(NWAVES * 64), LDS_BYTES, stream, a); }
#else
    a.ph_lo = 0; a.ph_hi = NPH;
    hipLaunchKernelGGL(hymba_fwd, dim3(grid), dim3(NWAVES * 64), LDS_BYTES, stream, a);
#endif
    const hipError_t le = hipPeekAtLastError();
    if (le != hipSuccess) fprintf(stderr, "kernel_launch: launch failed: %s\n", hipGetErrorName(le));
}
```

```cpp
#include <hip/hip_runtime.h>
#include <cstdio>
#include <cstdint>
namespace pg8 {
#define PG8_LAS __attribute__((address_space(3)))
typedef unsigned short bf16_t;
typedef short bf16x8 __attribute__((ext_vector_type(8)));
typedef float f32x4 __attribute__((ext_vector_type(4)));
typedef unsigned u32x4 __attribute__((ext_vector_type(4)));
constexpr int BM = 256, BK = 64, HALF = 128, HTB = HALF * BK * 2  , STAGE_BYTES = 8 * HTB, NXCD = 8, WGM = 8;

__host__ __device__ __forceinline__ int lds_byte(int r, int c) { const int st = (r >> 4) * 2 + (c >> 5), rr = r & 15, cc = c & 31, ob = rr * 64 + cc * 2; return st * 1024 + (ob ^ (((ob >> 9) & 1) << 5)); }
__host__ __device__ __forceinline__ void stage_rc(int b, int& R, int& C) { const int st = b / 1024, sb = b % 1024, swz = sb ^ (((sb >> 9) & 1) << 5); R = (st >> 1) * 16 + swz / 64; C = (st & 1) * 32 + (swz % 64) / 2; }
__host__ __device__ __forceinline__ int perm32(int rho) { const int n = rho >> 4, i = rho & 15; return 8 * (i >> 2) + 4 * n + (i & 3); }

struct Unit { int pm, pn, kt0, nt, slab; };
struct Gemm { const bf16_t* A; const bf16_t* Bt; int M, N, K; };

struct StaticOrder {
    int nM, nN, nwg, G, c, ntK;
    __host__ __device__ void init(int M, int N, int K, int G_, int c_) { nM = M / BM; nN = N / BM; nwg = nM * nN; G = G_; c = c_; ntK = K / BK; }
    __host__ __device__ bool next(int i, Unit& u) const {
        const long L = (long)i * G + c; if (L >= nwg) return false;
        int wgid = (int)L; { const int q = nwg / NXCD, r = nwg % NXCD, xcd = wgid % NXCD, off = wgid / NXCD; wgid = (xcd < r ? xcd * (q + 1) : r * (q + 1) + (xcd - r) * q) + off; }
        const int nig = WGM * nN, gid = wgid / nig, fm = gid * WGM, gsz = (nM - fm) < WGM ? (nM - fm) : WGM;
        u.pm = fm + ((wgid % nig) % gsz); u.pn = (wgid % nig) / gsz; u.kt0 = 0; u.nt = ntK; u.slab = -1; return true;
    }
    __device__ __forceinline__ void a_ready(const Unit&) const {}
    __device__ __forceinline__ void done(const Unit&) const {}
};

struct MixedOrder {
    StaticOrder so; int nLat, nCtx, S, ntS;
    __host__ __device__ void init(int N, int K, int S_, int G_, int c_, bool ctx_on = true) { so.init(32 * BM, N, K, G_, c_); nLat = so.nwg; S = S_; nCtx = ctx_on ? 2 * so.nN * S_ : 0; ntS = K / BK / S_; }
    __host__ __device__ bool next(int i, Unit& u) const {
        if (so.next(i, u)) return true;
        const long j = (long)i * so.G + so.c - nLat; if (j >= nCtx) return false;
        const int s = (int)j % S, rest = (int)j / S; u.pm = 32 + (rest & 1); u.pn = rest >> 1; u.kt0 = s * ntS; u.nt = ntS; u.slab = S > 1 ? s : -1; return true;
    }
    __device__ __forceinline__ void a_ready(const Unit&) const {}
    __device__ __forceinline__ void done(const Unit&) const {}
};

__device__ __forceinline__ unsigned cvt_pk_bf16(float lo, float hi) { unsigned r; asm volatile("s_nop 0\n\tv_cvt_pk_bf16_f32 %0, %1, %2" : "=v"(r) : "v"(lo), "v"(hi)); return r; }
typedef float f32x2 __attribute__((ext_vector_type(2)));
__device__ __forceinline__ f32x2 gelu_pk(f32x2 v) {
    const f32x2 av = __builtin_elementwise_abs(v), d = av * 0.2316418882f + 1.0f;
    f32x2 t; t.x = __builtin_amdgcn_rcpf(d.x); t.y = __builtin_amdgcn_rcpf(d.y);
    f32x2 q = t * 0.5307027145f + (-0.7265760135f); q = q * t + 0.7107068705f; q = q * t + (-0.142248368f); q = q * t + 0.127414796f; q = q * t;
    const f32x2 s = (v * v) * (-0.72134752044f);
    f32x2 e; e.x = __builtin_amdgcn_exp2f(s.x); e.y = __builtin_amdgcn_exp2f(s.y);
    const f32x2 m = v * (q * e), r = v - m;
    f32x2 o; o.x = v.x < 0.f ? m.x : r.x; o.y = v.y < 0.f ? m.y : r.y; return o;
}

__device__ __forceinline__ float fast_silu(float g) { return g * __builtin_amdgcn_rcpf(1.0f + __builtin_amdgcn_exp2f(-1.4426950408889634f * g)); }
struct EpiNone { static constexpr bool PERM = true, AFTER_DRAIN = false;
    __device__ __forceinline__ void operator()(const f32x4 (&acc)[2][2][4][2], const Unit& u, int wr, int wc, int fr, int fq) const { asm volatile("" :: "v"(acc[0][0][0][0][0]), "v"(acc[1][1][3][1][3])); } };
struct EpiSwiGLU {
    static constexpr bool PERM = true, AFTER_DRAIN = false;
    bf16_t* O; int ldh;
    __device__ __forceinline__ void operator()(const f32x4 (&acc)[2][2][4][2], const Unit& u, int wr, int wc, int fr, int fq) const {
        const int row0 = u.pm * BM + wr * 64 + fr, col0 = u.pn * HALF + wc * 32 + 8 * fq;
#pragma unroll
        for (int ai = 0; ai < 2; ++ai)
#pragma unroll
            for (int m = 0; m < 4; ++m) {
                bf16_t* rowp = O + (size_t)(row0 + ai * HALF + m * 16) * ldh + col0;
                const f32x4 g0 = acc[ai][0][m][0], g1 = acc[ai][0][m][1], u0 = acc[ai][1][m][0], u1 = acc[ai][1][m][1];
                u32x4 w;
                w.x = cvt_pk_bf16(fast_silu(g0[0]) * u0[0], fast_silu(g0[1]) * u0[1]); w.y = cvt_pk_bf16(fast_silu(g0[2]) * u0[2], fast_silu(g0[3]) * u0[3]);
                w.z = cvt_pk_bf16(fast_silu(g1[0]) * u1[0], fast_silu(g1[1]) * u1[1]); w.w = cvt_pk_bf16(fast_silu(g1[2]) * u1[2], fast_silu(g1[3]) * u1[3]);
                *(u32x4*)rowp = w;
            }
    }
};
struct EpiF32 {
    static constexpr bool PERM = true, AFTER_DRAIN = false;
    bf16_t* O; int ldc; bf16_t* slabs;
    __device__ __forceinline__ void operator()(const f32x4 (&acc)[2][2][4][2], const Unit& u, int wr, int wc, int fr, int fq) const {
        int pm_ = u.pm, pn_ = u.pn, sl_ = u.slab; asm volatile("" : "+s"(pm_), "+s"(pn_), "+s"(sl_));
        const int col0 = pn_ * BM + wc * 32 + 8 * fq;
        bf16_t* rb = (sl_ >= 0 ? slabs + (size_t)((pm_ - 32 + 2 * sl_) * BM) * ldc : O + (size_t)(pm_ * BM) * ldc) + (size_t)(wr * 64 + fr) * ldc + col0;
#pragma unroll
        for (int ai = 0; ai < 2; ++ai)
#pragma unroll
            for (int m = 0; m < 4; ++m) { bf16_t* rowp = rb + (size_t)(ai * HALF + m * 16) * ldc;
#pragma unroll
                for (int bj = 0; bj < 2; ++bj) { const f32x4 v0 = acc[ai][bj][m][0], v1 = acc[ai][bj][m][1];
                    u32x4 w; w.x = cvt_pk_bf16(v0[0], v0[1]); w.y = cvt_pk_bf16(v0[2], v0[3]); w.z = cvt_pk_bf16(v1[0], v1[1]); w.w = cvt_pk_bf16(v1[2], v1[3]);
                    *(u32x4*)(rowp + bj * HALF) = w; } }
    }
};
constexpr size_t WSO_MiB = 1u << 20, WSO_ZS = 1209 * WSO_MiB, WSO_ROPE = 2 * WSO_MiB, WSO_AU = 408 * WSO_MiB, WSO_QB = 425 * WSO_MiB, WSO_KB = 442 * WSO_MiB, WSO_VTL = 447 * WSO_MiB, WSO_VTC = 451 * WSO_MiB, WSO_HZL = 452 * WSO_MiB, WSO_HZC = 500 * WSO_MiB;
struct EpiWin {
    static constexpr bool PERM = true, AFTER_DRAIN = false;
    unsigned char* ws; float qscale;
    __device__ __forceinline__ void store_slab(const f32x4 (&acc)[2][2][4][2], int pm, int pn, int slab, int wr, int wc, int fr, int fq) const {
        bf16_t* zs = (bf16_t*)(ws + WSO_ZS) + ((size_t)slab * 512 + (pm - 32) * BM + wr * 64 + fr) * 4096 + pn * BM + wc * 32 + 8 * fq;
#pragma unroll
        for (int ai = 0; ai < 2; ++ai)
#pragma unroll
            for (int m = 0; m < 4; ++m) { bf16_t* rowp = zs + (size_t)(ai * HALF + m * 16) * 4096;
#pragma unroll
                for (int bj = 0; bj < 2; ++bj) { const f32x4 v0 = acc[ai][bj][m][0], v1 = acc[ai][bj][m][1];
                    u32x4 w; w.x = cvt_pk_bf16(v0[0], v0[1]); w.y = cvt_pk_bf16(v0[2], v0[3]); w.z = cvt_pk_bf16(v1[0], v1[1]); w.w = cvt_pk_bf16(v1[2], v1[3]);
                    *(u32x4*)(rowp + bj * HALF) = w; } }
    }
    __device__ __forceinline__ void operator()(const f32x4 (&acc)[2][2][4][2], const Unit& u, int wr, int wc, int fr, int fq) const {
        int pm_ = u.pm, pn_ = u.pn, sl_ = u.slab; asm volatile("" : "+s"(pm_), "+s"(pn_), "+s"(sl_));
        if (sl_ >= 0) { store_slab(acc, pm_, pn_, sl_, wr, wc, fr, fq); return; }
        finish<2, 4>(acc, pm_ * BM, pm_, pn_, wr, wc, fr, fq);
    }
    template <int NAI, int NM> __device__ __forceinline__ void finish(const f32x4 (&acc)[NAI][2][NM][2], int rbase, int pm_, int pn_, int wr, int wc, int fr_in, int fq_in) const {
        int fr = fr_in, fq = fq_in; asm volatile("" : "+v"(fr), "+v"(fq));
        const int row0 = rbase + wr * 64 + fr; const int pn = pn_; const bool lat = pm_ < 32;
        bf16_t* AU = (bf16_t*)(ws + WSO_AU); bf16_t* QB = (bf16_t*)(ws + WSO_QB); bf16_t* KB = (bf16_t*)(ws + WSO_KB); bf16_t* VTl = (bf16_t*)(ws + WSO_VTL); bf16_t* VTc = (bf16_t*)(ws + WSO_VTC);
        float* HZl = (float*)(ws + WSO_HZL); float* HZc = (float*)(ws + WSO_HZC); const float* ropeC = (const float*)(ws + WSO_ROPE); const float* ropeS = ropeC + 2048;
#ifndef EWM
#define EWM 15
#endif
        if (pn < 4) { if (EWM & 1) {
            const int col0 = pn * BM + wc * 32 + 8 * fq;
#pragma unroll
            for (int ai = 0; ai < NAI; ++ai)
#pragma unroll
                for (int m = 0; m < NM; ++m) { bf16_t* rowp = AU + (size_t)(row0 + ai * HALF + m * 16) * 1024 + col0;
#pragma unroll
                    for (int bj = 0; bj < 2; ++bj) { const f32x4 v0 = acc[ai][bj][m][0], v1 = acc[ai][bj][m][1];
                        const f32x2 a = gelu_pk((f32x2){v0[0], v0[1]}), b = gelu_pk((f32x2){v0[2], v0[3]}), c = gelu_pk((f32x2){v1[0], v1[1]}), d = gelu_pk((f32x2){v1[2], v1[3]});
                        u32x4 w; w.x = cvt_pk_bf16(a.x, a.y); w.y = cvt_pk_bf16(b.x, b.y); w.z = cvt_pk_bf16(c.x, c.y); w.w = cvt_pk_bf16(d.x, d.y);
                        *(u32x4*)(rowp + bj * HALF) = w; } } }
        } else if (pn < 9) { if (EWM & 2) {
            const bool isq = pn < 8; const int head = isq ? 2 * (pn - 4) + (wc >> 1) : (wc >> 1); const int e0 = 32 * (wc & 1) + 8 * fq; const int fi = 8 * fq;
            bf16_t* base = isq ? QB : KB; const int ld = isq ? 1024 : 256; const float sc = isq ? qscale : 1.0f;
#pragma unroll
            for (int ai = 0; ai < NAI; ++ai)
#pragma unroll
                for (int m = 0; m < NM; ++m) { const int r = row0 + ai * HALF + m * 16; bf16_t* rowp = base + (size_t)r * ld + head * 128 + e0;
                    f32x4 x1a = acc[ai][0][m][0], x1b = acc[ai][0][m][1], x2a = acc[ai][1][m][0], x2b = acc[ai][1][m][1];
                    if (lat) { const int pos = r & 4095; const int a = (wc & 1) ? (pos & 63) : (pos >> 6);
                        const f32x4 c0 = *(const f32x4*)(ropeC + a * 32 + fi), c1 = *(const f32x4*)(ropeC + a * 32 + fi + 4), s0 = *(const f32x4*)(ropeS + a * 32 + fi), s1 = *(const f32x4*)(ropeS + a * 32 + fi + 4);
                        const f32x4 o1a = x1a * c0 - x2a * s0, o2a = x2a * c0 + x1a * s0, o1b = x1b * c1 - x2b * s1, o2b = x2b * c1 + x1b * s1;
                        x1a = o1a; x2a = o2a; x1b = o1b; x2b = o2b; }
                    x1a = x1a * sc; x1b = x1b * sc; x2a = x2a * sc; x2b = x2b * sc;
                    u32x4 w1, w2; w1.x = cvt_pk_bf16(x1a[0], x1a[1]); w1.y = cvt_pk_bf16(x1a[2], x1a[3]); w1.z = cvt_pk_bf16(x1b[0], x1b[1]); w1.w = cvt_pk_bf16(x1b[2], x1b[3]);
                    w2.x = cvt_pk_bf16(x2a[0], x2a[1]); w2.y = cvt_pk_bf16(x2a[2], x2a[3]); w2.z = cvt_pk_bf16(x2b[0], x2b[1]); w2.w = cvt_pk_bf16(x2b[2], x2b[3]);
                    *(u32x4*)rowp = w1; *(u32x4*)(rowp + 64) = w2; asm volatile("" ::: "memory"); } }
        } else if (pn == 9) { if (EWM & 4) {
            typedef __attribute__((address_space(1))) bf16_t gbf;
            gbf* vb = (gbf*)(lat ? VTl : VTc); const unsigned ldp = lat ? 4096u : 256u;
#pragma unroll
            for (int ai = 0; ai < NAI; ++ai)
#pragma unroll
                for (int m = 0; m < NM; ++m) { const int r = row0 + ai * HALF + m * 16;
                    const unsigned rb = lat ? (unsigned)(r >> 12) * (256u * 4096u) + (unsigned)(r & 4095) : (unsigned)((r - 8192) >> 8) * (256u * 256u) + (unsigned)((r - 8192) & 255);
#pragma unroll
                    for (int bj = 0; bj < 2; ++bj)
#pragma unroll
                        for (int n = 0; n < 2; ++n) { const f32x4 v = acc[ai][bj][m][n]; const unsigned d0 = (unsigned)(bj * 128 + wc * 32 + 8 * fq + 4 * n);
                            const unsigned p0 = cvt_pk_bf16(v[0], v[1]), p1 = cvt_pk_bf16(v[2], v[3]); const unsigned o = rb + d0 * ldp;
                            vb[o] = (bf16_t)(p0 & 0xffffu); vb[o + ldp] = (bf16_t)(p0 >> 16); vb[o + 2u * ldp] = (bf16_t)(p1 & 0xffffu); vb[o + 3u * ldp] = (bf16_t)(p1 >> 16);
                            asm volatile("" ::: "memory"); } }
        } }
        else { if (EWM & 8) {
            typedef __attribute__((address_space(1))) float gfl;
            gfl* hb = (gfl*)(lat ? HZl : HZc); const unsigned ldp = lat ? 4096u : 256u;
            const unsigned cc0 = (unsigned)((pn - 10) * BM + wc * 32 + 8 * fq);
#pragma unroll
            for (int ai = 0; ai < NAI; ++ai)
#pragma unroll
                for (int m = 0; m < NM; ++m) { const int r = row0 + ai * HALF + m * 16;
                    const unsigned rb = lat ? (unsigned)(r >> 12) * (1536u * 4096u) + (unsigned)(r & 4095) : (unsigned)((r - 8192) >> 8) * (1536u * 256u) + (unsigned)((r - 8192) & 255);
#pragma unroll
                    for (int bj = 0; bj < 2; ++bj)
#pragma unroll
                        for (int n = 0; n < 2; ++n) { const f32x4 v = acc[ai][bj][m][n]; const unsigned o = rb + (cc0 + (unsigned)(bj * 128 + 4 * n)) * ldp;
                            hb[o] = v[0]; hb[o + ldp] = v[1]; hb[o + 2u * ldp] = v[2]; hb[o + 3u * ldp] = v[3];
                            asm volatile("" ::: "memory"); } }
        } }
    }
};
template <class Epi, class Sched, bool ALIGN_EPI = false, bool SP2 = false>
__device__ __forceinline__ void gemm_phase(PG8_LAS unsigned char* lds, const Gemm g, const Sched& S, const Epi& E, const int tid) {
    const int wid = __builtin_amdgcn_readfirstlane(tid >> 6), lane = tid & 63, wr = wid >> 2, wc = wid & 3, fr = lane & 15, fq = lane >> 4;
    const int K = g.K;
    unsigned voffA[2], voffB[2];
#pragma unroll
    for (int i = 0; i < 2; ++i) { int R, C; stage_rc(tid * 16 + i * 8192, R, C); const int Rb = Epi::PERM ? ((R & ~31) + perm32(R & 31)) : R;
        voffA[i] = (unsigned)(R * K + C) * 2u; voffB[i] = (unsigned)(Rb * K + C) * 2u; }
    const size_t kstep = (size_t)(BK * 2);
    const size_t hstep = (size_t)HALF * K * 2;
    const size_t tstep = 2 * hstep;
    const unsigned ldsw = (unsigned)wid * 1024u;
    const int aoff = lds_byte(wr * 64 + fr, fq * 8), boff = lds_byte(wc * 32 + fr, fq * 8);
#define PG8_SA(b, h) (((b) * 2 + (h)) * HTB)
#define PG8_SB(b, h) ((4 + (b) * 2 + (h)) * HTB)
#define PG8_STAGE(bufoff, gbase, voff) do { _Pragma("unroll") for (int _i = 0; _i < 2; ++_i) \
        __builtin_amdgcn_global_load_lds((const unsigned*)((const char*)(gbase) + (voff)[_i]), (PG8_LAS unsigned*)(lds + (bufoff) + ldsw + _i * 8192), 16, 0, 0); } while (0)
#define PG8_LDA(dst, b, h) do { _Pragma("unroll") for (int m = 0; m < 4; ++m) _Pragma("unroll") for (int k = 0; k < 2; ++k) dst[m][k] = *(const PG8_LAS bf16x8*)(lds + PG8_SA(b, h) + aoff + m * 2048 + k * 1024); } while (0)
#define PG8_LDB(dst, b, h) do { _Pragma("unroll") for (int n = 0; n < 2; ++n) _Pragma("unroll") for (int k = 0; k < 2; ++k) dst[n][k] = *(const PG8_LAS bf16x8*)(lds + PG8_SB(b, h) + boff + n * 2048 + k * 1024); } while (0)
#define PG8_MMA(ai, bj, At, Bt) do { __builtin_amdgcn_s_setprio(1); _Pragma("unroll") for (int m = 0; m < 4; ++m) _Pragma("unroll") for (int n = 0; n < 2; ++n) _Pragma("unroll") for (int k = 0; k < 2; ++k) \
        acc[ai][bj][m][n] = __builtin_amdgcn_mfma_f32_16x16x32_bf16(Bt[n][k], At[m][k], acc[ai][bj][m][n], 0, 0, 0); __builtin_amdgcn_s_setprio(0); } while (0)
#define PG8_WAIT_V(n) asm volatile("s_waitcnt vmcnt(" #n ")" ::: "memory")
#define PG8_WAIT_L(n) asm volatile("s_waitcnt lgkmcnt(" #n ")" ::: "memory")
#define PG8_BAR __builtin_amdgcn_s_barrier()
#define PG8_SCHED __builtin_amdgcn_sched_barrier(0)
    Unit cur, nxt; int ui = 0;
    if (!S.next(0, cur)) return;
    f32x4 acc[2][2][4][2];
#pragma unroll
    for (int a = 0; a < 2; ++a)
#pragma unroll
        for (int b = 0; b < 2; ++b)
#pragma unroll
            for (int m = 0; m < 4; ++m)
#pragma unroll
                for (int n = 0; n < 2; ++n) acc[a][b][m][n] = (f32x4){0.f, 0.f, 0.f, 0.f};
    bf16x8 At[4][2], B0[2][2], B1[2][2];
    const char* cA = (const char*)g.A + (size_t)cur.pm * tstep + (size_t)cur.kt0 * kstep; const char* cB = (const char*)g.Bt + (size_t)cur.pn * tstep + (size_t)cur.kt0 * kstep;
    S.a_ready(cur);
    if constexpr (SP2) {
        PG8_STAGE(PG8_SB(0, 0), cB, voffB); PG8_STAGE(PG8_SB(0, 1), cB + hstep, voffB); PG8_STAGE(PG8_SA(0, 0), cA, voffA); PG8_STAGE(PG8_SA(0, 1), cA + hstep, voffA);
        if (wr == 1) PG8_BAR;
        PG8_WAIT_V(2); PG8_BAR;
        PG8_STAGE(PG8_SB(1, 0), cB + kstep, voffB); PG8_STAGE(PG8_SA(1, 0), cA + kstep, voffA); PG8_STAGE(PG8_SB(1, 1), cB + hstep + kstep, voffB);
        PG8_WAIT_V(6); PG8_BAR;
    } else {
        PG8_STAGE(PG8_SB(0, 0), cB, voffB); PG8_STAGE(PG8_SA(0, 0), cA, voffA); PG8_STAGE(PG8_SB(0, 1), cB + hstep, voffB); PG8_STAGE(PG8_SA(0, 1), cA + hstep, voffA);
        if (wr == 1) PG8_BAR;
        PG8_WAIT_V(4); PG8_BAR;
        PG8_STAGE(PG8_SB(1, 0), cB + kstep, voffB); PG8_STAGE(PG8_SA(1, 0), cA + kstep, voffA); PG8_STAGE(PG8_SB(1, 1), cB + hstep + kstep, voffB);
        PG8_WAIT_V(6); PG8_BAR;
    }
    for (;;) {
        const bool has_next = S.next(ui + 1, nxt);
        const char* nA = has_next ? (const char*)g.A + (size_t)nxt.pm * tstep + (size_t)nxt.kt0 * kstep : cA; const char* nB = has_next ? (const char*)g.Bt + (size_t)nxt.pn * tstep + (size_t)nxt.kt0 * kstep : cB;
        const int nt = cur.nt;
        for (int t = 0; t < nt; t += 2) {
            const bool last = (t == nt - 2);
            const char* a1 = cA + (size_t)(t + 1) * kstep;
            const char* a2 = last ? nA : cA + (size_t)(t + 2) * kstep; const char* b2 = last ? nB : cB + (size_t)(t + 2) * kstep;
            const char* a3 = a2 + kstep; const char* b3 = b2 + kstep;
            if (last && has_next) S.a_ready(nxt);
            if constexpr (SP2) {
            PG8_LDB(B0, 0, 0); PG8_LDB(B1, 0, 1); PG8_SCHED; PG8_LDA(At, 0, 0); PG8_STAGE(PG8_SA(1, 1), a1 + hstep, voffA);
            PG8_WAIT_V(8); PG8_WAIT_L(0); PG8_BAR; PG8_MMA(0, 0, At, B0); PG8_MMA(0, 1, At, B1); PG8_BAR; PG8_SCHED;
            PG8_LDA(At, 0, 1); PG8_STAGE(PG8_SB(0, 0), b2, voffB); PG8_STAGE(PG8_SB(0, 1), b2 + hstep, voffB); PG8_STAGE(PG8_SA(0, 0), a2, voffA);
            PG8_WAIT_V(8); PG8_WAIT_L(0); PG8_BAR; PG8_MMA(1, 0, At, B0); PG8_MMA(1, 1, At, B1); PG8_BAR; PG8_SCHED;
            PG8_LDB(B0, 1, 0); PG8_LDB(B1, 1, 1); PG8_SCHED; PG8_LDA(At, 1, 0); PG8_STAGE(PG8_SA(0, 1), a2 + hstep, voffA);
            PG8_WAIT_V(8); PG8_WAIT_L(0); PG8_BAR; PG8_MMA(0, 0, At, B0); PG8_MMA(0, 1, At, B1); PG8_BAR; PG8_SCHED;
            PG8_LDA(At, 1, 1); PG8_STAGE(PG8_SB(1, 0), b3, voffB); PG8_STAGE(PG8_SB(1, 1), b3 + hstep, voffB); PG8_STAGE(PG8_SA(1, 0), a3, voffA);
            PG8_WAIT_V(8); PG8_WAIT_L(0); PG8_BAR; PG8_MMA(1, 0, At, B0); PG8_MMA(1, 1, At, B1); PG8_BAR; PG8_SCHED;
            } else {
            PG8_LDB(B0, 0, 0); PG8_SCHED; PG8_LDA(At, 0, 0); PG8_STAGE(PG8_SA(1, 1), a1 + hstep, voffA);
            PG8_WAIT_L(8); PG8_BAR; PG8_WAIT_L(0); PG8_MMA(0, 0, At, B0); PG8_BAR; PG8_SCHED;
            PG8_LDB(B1, 0, 1); PG8_STAGE(PG8_SB(0, 0), b2, voffB);
            PG8_BAR; PG8_WAIT_L(0); PG8_MMA(0, 1, At, B1); PG8_BAR;
            PG8_LDA(At, 0, 1); PG8_STAGE(PG8_SA(0, 0), a2, voffA);
            PG8_BAR; PG8_WAIT_L(0); PG8_MMA(1, 0, At, B0); PG8_BAR; PG8_SCHED;
            PG8_STAGE(PG8_SB(0, 1), b2 + hstep, voffB);
            PG8_WAIT_V(6); PG8_BAR; PG8_MMA(1, 1, At, B1); PG8_BAR;
            PG8_LDB(B0, 1, 0); PG8_SCHED; PG8_LDA(At, 1, 0); PG8_STAGE(PG8_SA(0, 1), a2 + hstep, voffA);
            PG8_WAIT_L(8); PG8_BAR; PG8_WAIT_L(0); PG8_MMA(0, 0, At, B0); PG8_BAR; PG8_SCHED;
            PG8_LDB(B1, 1, 1); PG8_STAGE(PG8_SB(1, 0), b3, voffB);
            PG8_BAR; PG8_WAIT_L(0); PG8_MMA(0, 1, At, B1); PG8_BAR;
            PG8_LDA(At, 1, 1); PG8_STAGE(PG8_SA(1, 0), a3, voffA);
            PG8_BAR; PG8_WAIT_L(0); PG8_MMA(1, 0, At, B0); PG8_BAR; PG8_SCHED;
            PG8_STAGE(PG8_SB(1, 1), b3 + hstep, voffB);
            PG8_WAIT_V(6); PG8_BAR; PG8_MMA(1, 1, At, B1); PG8_BAR;
            }
        }
        if constexpr (ALIGN_EPI) { if (wr == 0) PG8_BAR; }
        if constexpr (!Epi::AFTER_DRAIN) { E(acc, cur, wr, wc, fr, fq); S.done(cur); }
        if (!has_next) break;
#pragma unroll
        for (int a = 0; a < 2; ++a)
#pragma unroll
            for (int b = 0; b < 2; ++b)
#pragma unroll
                for (int m = 0; m < 4; ++m)
#pragma unroll
                    for (int n = 0; n < 2; ++n) acc[a][b][m][n] = (f32x4){0.f, 0.f, 0.f, 0.f};
        cur = nxt; cA = nA; cB = nB; ++ui;
        if constexpr (ALIGN_EPI) { if (wr == 1) PG8_BAR; }
    }
    PG8_WAIT_V(0);
    if constexpr (!ALIGN_EPI) { if (wr == 0) PG8_BAR; }
    PG8_BAR;
    if constexpr (Epi::AFTER_DRAIN) { E.fused(acc, cur, wr, wc, fr, fq, lds, wid, lane); S.done(cur); }
#undef PG8_SA
#undef PG8_SB
#undef PG8_STAGE
#undef PG8_LDA
#undef PG8_LDB
#undef PG8_MMA
#undef PG8_WAIT_V
#undef PG8_WAIT_L
#undef PG8_BAR
#undef PG8_SCHED
}
}
constexpr int NWAVES = 8;
constexpr int DM = 2048, BATCH = 2, SEQ = 4096, DEPTH = 4, CTXL = 256, FF = 5632, HD = 128, NMOD = 9;
constexpr int ML = BATCH * SEQ, MC = BATCH * CTXL, MA = ML + MC;
constexpr int INC = 4096, DMIX = 2048, SGW = 512, HYW = 512;
constexpr int A_END = 1024, Q_END = 2048, K_END = 2304, V_END = 2560;
constexpr float NORM_EPS = 1e-6f;
constexpr float QSCALE = 0.08838834764831845f * 1.4426950408889634f;
constexpr float LOG2E = 1.4426950408889634f;
#ifndef MK_MULTI
#define MK_MULTI 0
#endif

constexpr size_t MiB = 1u << 20;
constexpr size_t WS_CTL = 0, CTL_ZERO_BYTES = 1 * MiB;
constexpr size_t WS_MOD = 1 * MiB;
constexpr size_t WS_ROPE = 2 * MiB;
constexpr size_t WS_KFS = 2 * MiB + 65536;
constexpr size_t WS_HD2 = 3 * MiB;
constexpr size_t WS_KFL = 8 * MiB;
constexpr size_t WS_KFC = 136 * MiB;
constexpr size_t WS_X = 144 * MiB;
constexpr size_t WS_XLO = WS_X + 36 * MiB;
constexpr size_t WS_XN = 212 * MiB;
constexpr size_t WS_H = 246 * MiB;
constexpr size_t WS_Y = 340 * MiB;
constexpr size_t WS_AU = 408 * MiB;
constexpr size_t WS_QB = 425 * MiB;
constexpr size_t WS_KB = 442 * MiB;
constexpr size_t WS_VTL = 447 * MiB;
constexpr size_t WS_VTC = 451 * MiB;
constexpr size_t WS_HZL = 452 * MiB;
constexpr size_t WS_HZC = 500 * MiB;
constexpr size_t WS_MIX = 503 * MiB;
constexpr size_t WS_W = 537 * MiB;
constexpr size_t WL_GU1 = 0, WL_D1 = 44 * MiB, WL_IN = 66 * MiB, WL_OUT = 82 * MiB, WL_GU2 = 90 * MiB, WL_D2 = 134 * MiB, WL_STRIDE = 156 * MiB;
constexpr size_t WS_YS = WS_W + DEPTH * WL_STRIDE;
constexpr size_t WS_ZS = WS_YS + 48 * MiB;
constexpr size_t WS_COTL = WS_ZS + 64 * MiB;
constexpr size_t WS_COTC = WS_COTL + 8 * MiB;
constexpr size_t WS_END = WS_COTC + 1 * MiB;
constexpr int S_DOWN = 11, S_OUT = 4, S_IN = 4;
constexpr int CW_TMO = 0, CW_CODE = 1;
constexpr int CW_BAR = 4096;
constexpr int CW_Q = 16384;
static_assert((CW_Q + 32 * 64) * 4 <= (int)CTL_ZERO_BYTES, "CTL words inside the memset region");

constexpr int RING_OFF = 0, RING_BYTES = 139264;
constexpr int LDSCTL_OFF = RING_BYTES, MISC_OFF = LDSCTL_OFF + 320;
constexpr int LDS_BYTES = 147456;
static_assert(MISC_OFF + 128 <= LDS_BYTES, "LDS map");
static_assert(WS_ROPE == pg8::WSO_ROPE && WS_AU == pg8::WSO_AU && WS_QB == pg8::WSO_QB && WS_KB == pg8::WSO_KB && WS_VTL == pg8::WSO_VTL && WS_VTC == pg8::WSO_VTC && WS_HZL == pg8::WSO_HZL && WS_HZC == pg8::WSO_HZC && WS_ZS == pg8::WSO_ZS, "EpiWin offsets");
#define GAS __attribute__((address_space(1)))
#define LAS __attribute__((address_space(3)))
typedef unsigned short bf16;
typedef unsigned v4u __attribute__((ext_vector_type(4)));
typedef float f32x4 __attribute__((ext_vector_type(4)));
typedef short bf16x8 __attribute__((ext_vector_type(8)));
typedef GAS unsigned gu32;
typedef GAS unsigned long long gu64;
#define RLX_AGENT __ATOMIC_RELAXED, __HIP_MEMORY_SCOPE_AGENT
#define LDS_WAIT() asm volatile("s_waitcnt lgkmcnt(0)" ::: "memory")
#define VM_WAIT() asm volatile("s_waitcnt vmcnt(0)" ::: "memory")
__device__ __forceinline__ unsigned long long rt() { return __builtin_amdgcn_s_memrealtime(); }
__device__ __forceinline__ unsigned f2bf(float f) { unsigned u = __builtin_bit_cast(unsigned, f); return (u + 0x7fffu + ((u >> 16) & 1u)) >> 16; }
__device__ __forceinline__ unsigned pk2(float lo, float hi) { return f2bf(lo) | (f2bf(hi) << 16); }

#define XB_TMO      128
#define XB_XCNT(j)  (256  + 64 * (j))
#define XB_XSUB(j)  (1280 + 64 * (j))
#define XB_XGEN(j)  (2304 + 64 * (j))
#define XB_TOP      3328
#define XB_TOPGEN   3392
#define XCD_BAR_WORDS 3456
#define XB_SPIN_CAP (1u << 18)

__device__ __forceinline__ unsigned xb_ld(unsigned* p)              { return __hip_atomic_load(p, __ATOMIC_RELAXED, __HIP_MEMORY_SCOPE_AGENT); }
__device__ __forceinline__ unsigned xb_add(unsigned* p, unsigned v) { return __hip_atomic_fetch_add(p, v, __ATOMIC_RELAXED, __HIP_MEMORY_SCOPE_AGENT); }
__device__ __forceinline__ unsigned xb_xcc_id() { return (unsigned)__builtin_amdgcn_s_getreg((3 << 11) | 20) & 0xFu; }
#define XB_SPIN(cond, bar) do { unsigned _sp = 0; while (cond) { __builtin_amdgcn_s_sleep(1); \
    if ((++_sp & 255u) == 0u) { if (xb_ld(&(bar)[XB_TMO])) break; if (_sp > XB_SPIN_CAP) { atomicAdd(&(bar)[XB_TMO], 1u); break; } } } } while (0)

struct XcdBarrier {
    unsigned* bar; unsigned x;
    volatile LAS unsigned* st;
};

__device__ __forceinline__ XcdBarrier xcd_barrier_post(unsigned* bar, volatile LAS unsigned* st) {
    XcdBarrier b; b.bar = bar; b.x = xb_xcc_id(); b.st = st;
    if (threadIdx.x == 0) (void)xb_add(&bar[XB_XCNT(b.x)], 1u);
    return b;
}
__device__ __forceinline__ void xcd_barrier_complete(unsigned* bar, unsigned x, unsigned& nloc, unsigned& nx) {
    const unsigned G = gridDim.x * gridDim.y * gridDim.z;
    unsigned sum, cnt, mine, sp = 0u;
    for (;;) {
        sum = 0u; cnt = 0u; mine = 0u;
#pragma unroll
        for (unsigned j = 0; j < 16; ++j) { const unsigned c = xb_ld(&bar[XB_XCNT(j)]); sum += c; cnt += (c > 0u) ? 1u : 0u; mine = (j == x) ? c : mine; }
        if (sum == G) break;
        __builtin_amdgcn_s_sleep(1);
        if ((++sp & 255u) == 0u) { if (xb_ld(&bar[XB_TMO])) break; if (sp > XB_SPIN_CAP) { atomicAdd(&bar[XB_TMO], 1u); break; } }
    }
    nloc = mine > 0u ? mine : 1u; nx = cnt > 0u ? cnt : 1u;
}

__device__ __forceinline__ void xcd_barrier(const XcdBarrier& b) {
    asm volatile("s_waitcnt vmcnt(0)" ::: "memory");
    __syncthreads();
    if (threadIdx.x == 0) {
        unsigned* bar = b.bar;
        __builtin_amdgcn_s_waitcnt(0);
        unsigned nloc = b.st[0], nx = b.st[1];
        if (nloc == 0u) { xcd_barrier_complete(bar, b.x, nloc, nx); b.st[0] = nloc; b.st[1] = nx; }
        const unsigned old = xb_add(&bar[XB_XSUB(b.x)], 1u);
        const unsigned gen = old / nloc;
        if (old + 1u == (gen + 1u) * nloc) {
            __builtin_amdgcn_fence(__ATOMIC_RELEASE, "agent");
            asm volatile("s_waitcnt vmcnt(0)" ::: "memory");
            const unsigned og = xb_add(&bar[XB_TOP], 1u);
            const unsigned tg = og / nx;
            if (og + 1u == (tg + 1u) * nx) xb_add(&bar[XB_TOPGEN], 1u);
            else XB_SPIN(xb_ld(&bar[XB_TOPGEN]) == tg, bar);
            __builtin_amdgcn_fence(__ATOMIC_ACQUIRE, "agent");
            xb_add(&bar[XB_XGEN(b.x)], 1u);
            asm volatile("s_waitcnt vmcnt(0)" ::: "memory");
        } else {
            XB_SPIN(xb_ld(&bar[XB_XGEN(b.x)]) == gen, bar);
            __builtin_amdgcn_fence(__ATOMIC_ACQUIRE, "agent");
            asm volatile("s_waitcnt vmcnt(0)" ::: "memory");
        }
    }
    __syncthreads();
}

typedef float f32x2 __attribute__((ext_vector_type(2)));
typedef float f32x16 __attribute__((ext_vector_type(16)));
typedef unsigned u32x2 __attribute__((ext_vector_type(2)));
struct Frame {
    LAS unsigned char* lds;
    volatile LAS unsigned* MISC;
    gu32* ctl;
    int tid, lane, wave, G, bx;
    const float* const* in;
    float* out;
    unsigned char* ws;
};
enum InIdx { I_X = 0, I_C, I_CTX, I_CCTX, I_WADA, I_BADA, I_NORMG, I_F1G, I_F1U, I_F1D, I_WIN, I_SGUG, I_SGUW, I_SGUB, I_SINK, I_HCW, I_HCB, I_HW1, I_HB1, I_HW2, I_HB2, I_HW3, I_HFREQ, I_HSKIP, I_WOUT, I_F2G, I_F2U, I_F2D };

__device__ __forceinline__ float dpp_add(float v, float src_unused, int) { return v; }
#define WS_DPP(v, ctrl) ((v) + __builtin_bit_cast(float, __builtin_amdgcn_update_dpp(0, __builtin_bit_cast(int, (v)), (ctrl), 0xF, 0xF, true)))
__device__ __forceinline__ float wave_sum(float v) {
    v = WS_DPP(v, 0xB1);
    v = WS_DPP(v, 0x4E);
    v = WS_DPP(v, 0x124);
    v = WS_DPP(v, 0x128);
    v += __shfl_xor(v, 16); v += __shfl_xor(v, 32);
    return v;
}
__device__ __forceinline__ unsigned cvtpk(float lo, float hi) { return pg8::cvt_pk_bf16(lo, hi); }
__device__ __forceinline__ float bf_lo(unsigned w) { return __uint_as_float(w << 16); }
__device__ __forceinline__ float bf_hi(unsigned w) { return __uint_as_float(w & 0xffff0000u); }
__device__ __forceinline__ float sin_rev(float r) { r -= rintf(r); return __builtin_amdgcn_sinf(r); }
__device__ __forceinline__ float cos_rev(float r) { r -= rintf(r); return __builtin_amdgcn_cosf(r); }
__device__ __forceinline__ float sin_rad(float x) { return sin_rev(x * 0.15915494309189535f); }

__device__ __forceinline__ void p0_transpose_tile(const float* W, int K, int N, bf16* WT, int k0, int n0, int drow0, LAS float* scr, int lane) {
#pragma unroll 8
    for (int i = 0; i < 32; ++i) { const int kk = 2 * i + (lane >> 5); scr[kk * 33 + (lane & 31)] = __builtin_nontemporal_load((const GAS float*)W + (size_t)(k0 + kk) * N + n0 + (lane & 31)); }
    LDS_WAIT(); asm volatile("" ::: "memory");
    const int c = lane & 7;
#pragma unroll
    for (int j = 0; j < 4; ++j) { const int n = (lane >> 3) + 8 * j; const LAS float* s = scr + (8 * c) * 33 + n;
        v4u o; o.x = pk2(s[0 * 33], s[1 * 33]); o.y = pk2(s[2 * 33], s[3 * 33]); o.z = pk2(s[4 * 33], s[5 * 33]); o.w = pk2(s[6 * 33], s[7 * 33]);
        __builtin_nontemporal_store(o, (GAS v4u*)(WT + (size_t)(drow0 + n) * K + k0 + 8 * c)); }
    LDS_WAIT(); asm volatile("" ::: "memory");
}
__device__ __forceinline__ int win_drow(int n0) {
    if (n0 < A_END || n0 >= K_END) return n0;
    const bool isq = n0 < Q_END; const int qc = n0 - (isq ? A_END : Q_END);
    const int head = qc >> 7, qd = (qc >> 5) & 3;
    const int pn = isq ? 4 + (head >> 1) : 8;
    return pn * 256 + 128 * (qd & 1) + 64 * (head & 1) + 32 * (qd >> 1);
}
constexpr int CV_FF = (DM / 64) * (FF / 32);
constexpr int CV_IN = (DM / 64) * (INC / 32);
constexpr int CV_OUT = (DM / 64) * (DMIX / 32);
constexpr int CV_LAYER = 6 * CV_FF + CV_IN + CV_OUT;
__device__ __forceinline__ void p0_convert_item(Frame& F, int it, LAS float* scr) {
    const int l = it / CV_LAYER; int r = it % CV_LAYER;
    unsigned char* wl = F.ws + WS_W + (size_t)l * WL_STRIDE;
    const size_t ffo = (size_t)l * DM * FF;
    if (r < 4 * CV_FF) {
        const int which = r / CV_FF; r -= which * CV_FF;
        const float* W = (which == 0 ? F.in[I_F1G] : which == 1 ? F.in[I_F1U] : which == 2 ? F.in[I_F2G] : F.in[I_F2U]) + ffo;
        bf16* WT = (bf16*)(wl + (which < 2 ? WL_GU1 : WL_GU2));
        const int nblk = FF / 32, kb = r / nblk, nb = r % nblk, n0 = 32 * nb;
        const int drow0 = 256 * (n0 >> 7) + 128 * (which & 1) + (n0 & 127);
        p0_transpose_tile(W, DM, FF, WT, 64 * kb, n0, drow0, scr, F.lane); return; }
    r -= 4 * CV_FF;
    if (r < 2 * CV_FF) {
        const int which = r / CV_FF; r -= which * CV_FF;
        const float* W = (which == 0 ? F.in[I_F1D] : F.in[I_F2D]) + ffo;
        bf16* WT = (bf16*)(wl + (which == 0 ? WL_D1 : WL_D2));
        const int nblk = DM / 32, kb = r / nblk, nb = r % nblk;
        p0_transpose_tile(W, FF, DM, WT, 64 * kb, 32 * nb, 32 * nb, scr, F.lane); return; }
    r -= 2 * CV_FF;
    if (r < CV_IN) { const float* W = F.in[I_WIN] + (size_t)l * DM * INC; const int nblk = INC / 32, kb = r / nblk, nb = r % nblk;
        p0_transpose_tile(W, DM, INC, (bf16*)(wl + WL_IN), 64 * kb, 32 * nb, win_drow(32 * nb), scr, F.lane); return; }
    r -= CV_IN;
    { const float* W = F.in[I_WOUT] + (size_t)l * DMIX * DM; const int nblk = DM / 32, kb = r / nblk, nb = r % nblk;
        p0_transpose_tile(W, DMIX, DM, (bf16*)(wl + WL_OUT), 64 * kb, 32 * nb, 32 * nb, scr, F.lane); }
}
__device__ __forceinline__ void p0_ada_item(Frame& F, int it) {
    LAS float* sv = (LAS float*)(F.lds + RING_OFF);
    LAS float* red = sv + 3 * DM;
    const int l = it >> 6, nb = it & 63;
    for (int i = F.tid; i < 3 * DM; i += NWAVES * 64) { const int r = i / DM, k = i % DM; const float c = r < 2 ? F.in[I_C][r * DM + k] : F.in[I_CCTX][k]; sv[i] = c / (1.0f + __expf(-c)); }
    __syncthreads();
    const float* W = F.in[I_WADA] + (size_t)l * DM * (NMOD * DM) + nb * 288 + 4 * F.lane;
    const bool ex = F.lane < 8;
    f32x4 a0 = {0.f, 0.f, 0.f, 0.f}, a1 = a0, a2 = a0, e0 = a0, e1 = a0, e2 = a0;
    const int kb = F.wave * 256;
#pragma unroll 4
    for (int k = 0; k < 256; ++k) { const float* wr = W + (size_t)(kb + k) * (NMOD * DM);
        const f32x4 w = __builtin_nontemporal_load((const GAS f32x4*)wr); f32x4 we = {0.f, 0.f, 0.f, 0.f}; if (ex) we = __builtin_nontemporal_load((const GAS f32x4*)(wr + 256));
        const float s0 = sv[kb + k], s1 = sv[DM + kb + k], s2 = sv[2 * DM + kb + k];
        a0 += w * s0; a1 += w * s1; a2 += w * s2; e0 += we * s0; e1 += we * s1; e2 += we * s2; }
    *(LAS f32x4*)(red + (F.wave * 3 + 0) * 288 + 4 * F.lane) = a0; *(LAS f32x4*)(red + (F.wave * 3 + 1) * 288 + 4 * F.lane) = a1; *(LAS f32x4*)(red + (F.wave * 3 + 2) * 288 + 4 * F.lane) = a2;
    if (ex) { *(LAS f32x4*)(red + (F.wave * 3 + 0) * 288 + 256 + 4 * F.lane) = e0; *(LAS f32x4*)(red + (F.wave * 3 + 1) * 288 + 256 + 4 * F.lane) = e1; *(LAS f32x4*)(red + (F.wave * 3 + 2) * 288 + 256 + 4 * F.lane) = e2; }
    __syncthreads();
    for (int i = F.tid; i < 3 * 288; i += NWAVES * 64) { const int r = i / 288, n = i % 288; float s = 0.f;
#pragma unroll
        for (int w = 0; w < 8; ++w) s += red[(w * 3 + r) * 288 + n];
        const int col = nb * 288 + n;
        ((float*)(F.ws + WS_MOD))[((size_t)l * 3 + r) * (NMOD * DM) + col] = s + F.in[I_BADA][(size_t)l * (NMOD * DM) + col]; }
    __syncthreads();
}
__device__ __forceinline__ void p0_hd2_row(Frame& F, int l, int tp) {
    const bool ctx = tp >= SEQ; const int L = ctx ? CTXL : SEQ; const int t = ctx ? tp - SEQ : tp; const int lane = F.lane;
    float feat = 0.f;
    if (lane == 0) feat = (float)t / (float)(L - 1);
    else if (lane < 33) { const int j = (lane - 1) & 15; const double band = 1e-4 + (double)j * ((15.0 - 1e-4) / 15.0); const double rev = band * (double)t / (double)L; const float fr = (float)(rev - floor(rev));
        feat = lane < 17 ? __builtin_amdgcn_cosf(fr) : -__builtin_amdgcn_sinf(fr); }
    const float* w1 = F.in[I_HW1] + (size_t)l * 33 * 64; const float* w2 = F.in[I_HW2] + (size_t)l * 64 * 64;
    const float fq = F.in[I_HFREQ][l * 64 + lane];
    float a = F.in[I_HB1][l * 64 + lane];
#pragma unroll
    for (int i = 0; i < 33; ++i) a += __shfl(feat, i) * w1[i * 64 + lane];
    const float h1 = sin_rad(fq * a);
    float b = F.in[I_HB2][l * 64 + lane];
#pragma unroll 16
    for (int i = 0; i < 64; ++i) b += __shfl(h1, i) * w2[i * 64 + lane];
    ((float*)(F.ws + WS_HD2))[((size_t)l * (SEQ + CTXL) + tp) * 64 + lane] = sin_rad(fq * b);
}
__device__ __forceinline__ void p0_rope_entry(Frame& F, int idx) {
    const int a = idx >> 5, i = idx & 31;
    const double inv = exp2(-(double)i * (13.287712379549449 / 32.0));
    double x = (double)a * inv; const double k = rint(x * 0.6366197723675814);
    x = x - k * 1.5707963267948966 - k * 6.123233995736766e-17;
    const double x2 = x * x;
    double s = x * (1.0 + x2 * (-1.0 / 6 + x2 * (1.0 / 120 + x2 * (-1.0 / 5040 + x2 * (1.0 / 362880 + x2 * (-1.0 / 39916800 + x2 * (1.0 / 6227020800.0)))))));
    double c = 1.0 + x2 * (-0.5 + x2 * (1.0 / 24 + x2 * (-1.0 / 720 + x2 * (1.0 / 40320 + x2 * (-1.0 / 3628800 + x2 * (1.0 / 479001600.0 + x2 * (-1.0 / 87178291200.0)))))));
    const int q = ((int)k) & 3; double cs, sn;
    if (q == 0) { cs = c; sn = s; } else if (q == 1) { cs = -s; sn = c; } else if (q == 2) { cs = -c; sn = -s; } else { cs = s; sn = -c; }
    float* rp = (float*)(F.ws + WS_ROPE); rp[idx] = (float)cs; rp[2048 + idx] = (float)sn;
}
__device__ __forceinline__ void p0_prologue(Frame& F) {
#ifndef P0M
#define P0M 15
#endif
    if (P0M & 1) for (int it = F.bx; it < DEPTH * 64; it += F.G) p0_ada_item(F, it);
    const int gw = F.bx * NWAVES + F.wave, NGW = F.G * NWAVES;
    if (P0M & 2) for (int it = gw; it < DEPTH * (SEQ + CTXL); it += NGW) p0_hd2_row(F, it / (SEQ + CTXL), it % (SEQ + CTXL));
    if (P0M & 4) if (F.bx == F.G - 1) for (int i = F.tid; i < 2048; i += NWAVES * 64) p0_rope_entry(F, i);
}
__device__ __forceinline__ void p0_convert_all(Frame& F) {
    const int gw = F.bx * NWAVES + F.wave, NGW = F.G * NWAVES;
    LAS float* scr = (LAS float*)(F.lds + RING_OFF + F.wave * 16384);
    for (int it = gw; it < DEPTH * CV_LAYER; it += NGW) p0_convert_item(F, it, scr);
}

__device__ __forceinline__ void p1_filter_item(Frame& F, int it) {
    const int cb = it & 63, Lsel = (it >> 6) & 1, l = it >> 7;
    const int L = Lsel ? CTXL : SEQ;
    LAS float* W3s = (LAS float*)(F.lds + RING_OFF);
    LAS float* red = W3s + 64 * 32;
    for (int i = F.tid; i < 64 * 32; i += NWAVES * 64) { const int j = i >> 5, lc = i & 31; const int o = lc >> 4, dir = (lc >> 3) & 1, ci = lc & 7;
        W3s[i] = F.in[I_HW3][((size_t)l * 64 + j) * 2048 + o * 1024 + dir * 512 + cb * 8 + ci]; }
    __syncthreads();
    float asum[16];
#pragma unroll
    for (int i = 0; i < 16; ++i) asum[i] = 0.f;
    const float* hd2 = (const float*)(F.ws + WS_HD2) + ((size_t)l * (SEQ + CTXL) + (Lsel ? SEQ : 0)) * 64;
    float* kf = Lsel ? (float*)(F.ws + WS_KFC) + ((size_t)l * 512 + cb * 8) * 2 * 512 : (float*)(F.ws + WS_KFL) + ((size_t)l * 512 + cb * 8) * 2 * 8192;
    const int N2 = 2 * L;
    const int ngrp = Lsel ? 1 : 4;
    for (int grp = 0; grp < ngrp; ++grp) {
        const int tb = F.tid + 1024 * grp;
        if (!Lsel || F.tid < 128) {
            const int tstep = Lsel ? 128 : 512;
            float acc[2][32];
#pragma unroll
            for (int k = 0; k < 2; ++k)
#pragma unroll
                for (int i = 0; i < 32; ++i) acc[k][i] = 0.f;
#pragma unroll 2
            for (int j4 = 0; j4 < 16; ++j4) {
                f32x4 hv[2];
#pragma unroll
                for (int k = 0; k < 2; ++k) hv[k] = *(const f32x4*)(hd2 + (size_t)(tb + tstep * k) * 64 + 4 * j4);
#pragma unroll
                for (int jj = 0; jj < 4; ++jj) { const LAS f32x4* wr = (const LAS f32x4*)(W3s + (j4 * 4 + jj) * 32);
#pragma unroll
                    for (int q = 0; q < 8; ++q) { const f32x4 w = wr[q];
#pragma unroll
                        for (int k = 0; k < 2; ++k) { const float h = hv[k][jj]; acc[k][4 * q + 0] += h * w[0]; acc[k][4 * q + 1] += h * w[1]; acc[k][4 * q + 2] += h * w[2]; acc[k][4 * q + 3] += h * w[3]; } } }
            }
#pragma unroll
            for (int k = 0; k < 2; ++k) { int t = tb + tstep * k; asm volatile("" : "+v"(t));
                const float tn = (float)t / (float)(L - 1);
                typedef __attribute__((address_space(1))) float gfl; gfl* kfb = (gfl*)kf;
                const unsigned of = (unsigned)t, ob = (unsigned)(N2 - t);
#pragma unroll
                for (int ci = 0; ci < 8; ++ci) { const int c = cb * 8 + ci;
                    const float delta = 15.350567286626973f - (float)c * ((15.350567286626973f - 3.0701134573253945f) / 511.0f);
                    const float dec = __expf(-tn * delta);
#pragma unroll
                    for (int o = 0; o < 2; ++o) { const float vf = acc[k][o * 16 + ci] * dec, vb = acc[k][o * 16 + 8 + ci] * dec;
                        asum[o * 8 + ci] += fabsf(vf) + fabsf(vb);
                        const unsigned base = (unsigned)(ci * 2 + o) * (unsigned)N2;
                        if (t == 0) { kfb[base] = vf + vb; kfb[base + (unsigned)L] = 0.f; } else { __builtin_nontemporal_store(vf, kfb + base + of); __builtin_nontemporal_store(vb, kfb + base + ob); } } } }
        }
    }
#pragma unroll
    for (int i = 0; i < 16; ++i) { const float s = wave_sum(asum[i]); if (F.lane == 0) red[F.wave * 16 + i] = s; }
    __syncthreads();
    if (F.tid < 16) { float s = 0.f;
#pragma unroll
        for (int w = 0; w < 8; ++w) s += red[w * 16 + F.tid];
        const int o = F.tid >> 3, ci = F.tid & 7;
        ((float*)(F.ws + WS_KFS))[(((size_t)l * 2 + Lsel) * 2 + o) * 512 + cb * 8 + ci] = 1.0f / (s + 1e-6f); }
    __syncthreads();
}

struct X24 { v4u h[4]; unsigned lo[4]; };
__device__ __forceinline__ void x24_load(const unsigned char* ws, int row, int lane, X24& p) {
    const GAS v4u* hp = (const GAS v4u*)(ws + WS_X + (size_t)row * (2 * DM)) + lane; const GAS unsigned* lp = (const GAS unsigned*)(ws + WS_XLO + (size_t)row * (DM / 2)) + lane;
#pragma unroll
    for (int q = 0; q < 4; ++q) { p.h[q] = __builtin_nontemporal_load(hp + 64 * q); p.lo[q] = __builtin_nontemporal_load(lp + 64 * q); }
}
__device__ __forceinline__ f32x4 x24_un(unsigned h0, unsigned h1, unsigned L) {
    f32x4 r; r.x = __uint_as_float((h0 << 16) | ((L & 0xfu) << 12)); r.y = __uint_as_float((h0 & 0xffff0000u) | ((L & 0xf0u) << 8));
    r.z = __uint_as_float((h1 << 16) | ((L & 0xf00u) << 4)); r.w = __uint_as_float((h1 & 0xffff0000u) | (L & 0xf000u)); return r;
}
__device__ __forceinline__ void x24_unpack(const X24& p, f32x4 (&xv)[8]) {
#pragma unroll
    for (int q = 0; q < 4; ++q) { xv[2 * q] = x24_un(p.h[q].x, p.h[q].y, p.lo[q]); xv[2 * q + 1] = x24_un(p.h[q].z, p.h[q].w, p.lo[q] >> 16); }
}
__device__ __forceinline__ void x24_pk(const f32x4 v, unsigned& h0, unsigned& h1, unsigned& L) {
    const unsigned a = __float_as_uint(v.x) + 0x800u, b = __float_as_uint(v.y) + 0x800u, c = __float_as_uint(v.z) + 0x800u, d = __float_as_uint(v.w) + 0x800u;
    h0 = (a >> 16) | (b & 0xffff0000u); h1 = (c >> 16) | (d & 0xffff0000u);
    L = ((a >> 12) & 0xfu) | ((b >> 8) & 0xf0u) | ((c >> 4) & 0xf00u) | (d & 0xf000u);
}
__device__ __forceinline__ void x24_store(unsigned char* ws, int row, int lane, const f32x4 (&xv)[8]) {
    GAS v4u* hp = (GAS v4u*)(ws + WS_X + (size_t)row * (2 * DM)) + lane; GAS unsigned* lp = (GAS unsigned*)(ws + WS_XLO + (size_t)row * (DM / 2)) + lane;
#pragma unroll
    for (int q = 0; q < 4; ++q) { unsigned h0, h1, h2, h3, l0, l1; x24_pk(xv[2 * q], h0, h1, l0); x24_pk(xv[2 * q + 1], h2, h3, l1); const v4u h = {h0, h1, h2, h3};
        __builtin_nontemporal_store(h, hp + 64 * q); __builtin_nontemporal_store(l0 | (l1 << 16), lp + 64 * q); }
}
template <int N> __device__ __forceinline__ void slab_sum(const bf16* yrow, int s, f32x4 (&yv)[8]) {
    u32x2 t[N][8];
#pragma unroll
    for (int i = 0; i < N; ++i)
#pragma unroll
        for (int j = 0; j < 8; ++j) t[i][j] = __builtin_nontemporal_load((const GAS u32x2*)(yrow + (size_t)(s + i) * (512 * DM) + 256 * j));
#pragma unroll
    for (int i = 0; i < N; ++i)
#pragma unroll
        for (int j = 0; j < 8; ++j) { const u32x2 w = t[i][j]; yv[j] += (f32x4){bf_lo(w.x), bf_hi(w.x), bf_lo(w.y), bf_hi(w.y)}; }
}
template <bool HAS_Y, bool HAS_NEXT, bool FINAL, bool LAT>
__device__ __forceinline__ void thin_row(Frame& F, int row, int l, int k, float coef, int ln, int kn, int S) {
    const int r = LAT ? (row >> 12) : 2;
    int lane_ = F.lane; asm volatile("" : "+v"(lane_)); const int lane = lane_;
    f32x4 xv[8]; X24 px;
    if (HAS_Y) x24_load(F.ws, row, lane, px);
    else { const float* xsrc = LAT ? F.in[I_X] + (size_t)row * DM : F.in[I_CTX] + (size_t)(row - ML) * DM;
#pragma unroll
        for (int j = 0; j < 8; ++j) xv[j] = __builtin_nontemporal_load((const GAS f32x4*)(xsrc + 4 * lane + 256 * j)); }
    if (HAS_Y) {
        const float* gate = (const float*)(F.ws + WS_MOD) + ((size_t)l * 3 + r) * (NMOD * DM) + (3 * k + 2) * DM;
        const float* gp = F.in[I_NORMG] + ((size_t)l * 6 + 2 * k + 1) * DM;
        f32x4 yv[8]; float ss = 0.f;
        if (LAT) {
            const bf16* yrow = (const bf16*)(F.ws + WS_Y) + (size_t)row * DM;
#pragma unroll
            for (int j = 0; j < 8; ++j) { const u32x2 w = __builtin_nontemporal_load((const GAS u32x2*)(yrow + 4 * lane + 256 * j)); yv[j] = (f32x4){bf_lo(w.x), bf_hi(w.x), bf_lo(w.y), bf_hi(w.y)}; }
        } else {
            const bf16* yrow = (const bf16*)(F.ws + WS_YS) + (size_t)(row - ML) * DM + 4 * lane;
#pragma unroll
            for (int j = 0; j < 8; ++j) yv[j] = (f32x4){0.f, 0.f, 0.f, 0.f};
            int s = 0;
            for (; s + 6 <= S; s += 6) slab_sum<6>(yrow, s, yv);
            const int rem = S - s;
            if (rem == 5) slab_sum<5>(yrow, s, yv); else if (rem == 4) slab_sum<4>(yrow, s, yv); else if (rem == 3) slab_sum<3>(yrow, s, yv); else if (rem == 2) slab_sum<2>(yrow, s, yv); else if (rem == 1) slab_sum<1>(yrow, s, yv);
        }
#pragma unroll
        for (int j = 0; j < 8; ++j) { ss += (yv[j].x * yv[j].x + yv[j].y * yv[j].y) + (yv[j].z * yv[j].z + yv[j].w * yv[j].w); }
        const float rstd = coef * rsqrtf(wave_sum(ss) * (1.0f / DM) + NORM_EPS);
        x24_unpack(px, xv);
#pragma unroll
        for (int j = 0; j < 8; ++j) { const f32x4 g = *(const f32x4*)(gate + 4 * lane + 256 * j), q = *(const f32x4*)(gp + 4 * lane + 256 * j); xv[j] += (yv[j] * rstd) * (g * q); }
    }
    if (FINAL) { if (LAT) {
#pragma unroll
        for (int j = 0; j < 8; ++j) *(GAS f32x4*)(F.out + (size_t)row * DM + 4 * lane + 256 * j) = xv[j]; }
    } else x24_store(F.ws, row, lane, xv);
    if (HAS_NEXT) {
        float ss = 0.f;
#pragma unroll
        for (int j = 0; j < 8; ++j) ss += (xv[j].x * xv[j].x + xv[j].y * xv[j].y) + (xv[j].z * xv[j].z + xv[j].w * xv[j].w);
        const float rstd = rsqrtf(wave_sum(ss) * (1.0f / DM) + NORM_EPS);
        const float* mod = (const float*)(F.ws + WS_MOD) + ((size_t)ln * 3 + r) * (NMOD * DM) + (3 * kn) * DM;
        const float* gq = F.in[I_NORMG] + ((size_t)ln * 6 + 2 * kn) * DM;
        bf16* xn = (bf16*)(F.ws + WS_XN) + (size_t)row * DM;
#pragma unroll
        for (int j = 0; j < 8; ++j) { const f32x4 g = *(const f32x4*)(gq + 4 * lane + 256 * j), sc = *(const f32x4*)(mod + 4 * lane + 256 * j), sh = *(const f32x4*)(mod + DM + 4 * lane + 256 * j);
            const f32x4 o = (xv[j] * rstd) * g * (sc + 1.0f) + sh;
            u32x2 w; w.x = cvtpk(o.x, o.y); w.y = cvtpk(o.z, o.w); *(GAS u32x2*)(xn + 4 * lane + 256 * j) = w; }
    }
}
template <bool HAS_Y, bool HAS_NEXT, bool FINAL>
__device__ __forceinline__ void thin_rows2(Frame& F, int rA, int rB, int l, int k, float coef, int ln, int kn) {
    const int r = rA >> 12; int lane_ = F.lane; asm volatile("" : "+v"(lane_)); const int lane = lane_;
    f32x4 xv[2][8]; X24 px[2];
    if (HAS_Y) { x24_load(F.ws, rA, lane, px[0]); x24_load(F.ws, rB, lane, px[1]); }
    else {
#pragma unroll
        for (int p = 0; p < 2; ++p)
#pragma unroll
            for (int j = 0; j < 8; ++j) xv[p][j] = __builtin_nontemporal_load((const GAS f32x4*)(F.in[I_X] + (size_t)(p ? rB : rA) * DM + 4 * lane + 256 * j));
    }
    if (HAS_Y) {
        const float* gate = (const float*)(F.ws + WS_MOD) + ((size_t)l * 3 + r) * (NMOD * DM) + (3 * k + 2) * DM;
        const float* gp = F.in[I_NORMG] + ((size_t)l * 6 + 2 * k + 1) * DM;
        u32x2 yw[2][8];
#pragma unroll
        for (int p = 0; p < 2; ++p) { const bf16* yrow = (const bf16*)(F.ws + WS_Y) + (size_t)(p ? rB : rA) * DM;
#pragma unroll
            for (int j = 0; j < 8; ++j) yw[p][j] = __builtin_nontemporal_load((const GAS u32x2*)(yrow + 4 * lane + 256 * j)); }
        f32x4 gg[8];
#pragma unroll
        for (int j = 0; j < 8; ++j) gg[j] = *(const f32x4*)(gate + 4 * lane + 256 * j) * *(const f32x4*)(gp + 4 * lane + 256 * j);
#pragma unroll
        for (int p = 0; p < 2; ++p) { float ss = 0.f; f32x4 yv[8];
#pragma unroll
            for (int j = 0; j < 8; ++j) { const u32x2 w = yw[p][j]; yv[j] = (f32x4){bf_lo(w.x), bf_hi(w.x), bf_lo(w.y), bf_hi(w.y)}; ss += (yv[j].x * yv[j].x + yv[j].y * yv[j].y) + (yv[j].z * yv[j].z + yv[j].w * yv[j].w); }
            const float rstd = coef * rsqrtf(wave_sum(ss) * (1.0f / DM) + NORM_EPS);
            x24_unpack(px[p], xv[p]);
#pragma unroll
            for (int j = 0; j < 8; ++j) xv[p][j] += (yv[j] * rstd) * gg[j]; }
    }
#pragma unroll
    for (int p = 0; p < 2; ++p) { const int row = p ? rB : rA;
        if (FINAL) {
#pragma unroll
            for (int j = 0; j < 8; ++j) *(GAS f32x4*)(F.out + (size_t)row * DM + 4 * lane + 256 * j) = xv[p][j];
        } else x24_store(F.ws, row, lane, xv[p]); }
    if (HAS_NEXT) {
        const float* mod = (const float*)(F.ws + WS_MOD) + ((size_t)ln * 3 + r) * (NMOD * DM) + (3 * kn) * DM;
        const float* gq = F.in[I_NORMG] + ((size_t)ln * 6 + 2 * kn) * DM;
        float rstd[2];
#pragma unroll
        for (int p = 0; p < 2; ++p) { float ss = 0.f;
#pragma unroll
            for (int j = 0; j < 8; ++j) ss += (xv[p][j].x * xv[p][j].x + xv[p][j].y * xv[p][j].y) + (xv[p][j].z * xv[p][j].z + xv[p][j].w * xv[p][j].w);
            rstd[p] = rsqrtf(wave_sum(ss) * (1.0f / DM) + NORM_EPS); }
#pragma unroll
        for (int j = 0; j < 8; ++j) { const f32x4 g = *(const f32x4*)(gq + 4 * lane + 256 * j), sc = *(const f32x4*)(mod + 4 * lane + 256 * j), sh = *(const f32x4*)(mod + DM + 4 * lane + 256 * j);
            const f32x4 gs = g * (sc + 1.0f);
#pragma unroll
            for (int p = 0; p < 2; ++p) { const f32x4 o = (xv[p][j] * rstd[p]) * gs + sh; bf16* xn = (bf16*)(F.ws + WS_XN) + (size_t)(p ? rB : rA) * DM;
                u32x2 w; w.x = cvtpk(o.x, o.y); w.y = cvtpk(o.z, o.w); *(GAS u32x2*)(xn + 4 * lane + 256 * j) = w; } }
    }
}
template <bool HAS_NEXT, bool FINAL>
__device__ __forceinline__ void thin_rows4(Frame& F, int gw, int NGW, float coef, const LAS float* prm) {
    int lane_ = F.lane; asm volatile("" : "+v"(lane_)); const int lane = lane_;
    X24 px[4]; u32x2 yw[4][8];
#define THIN_LD(i) do { const int row_ = gw + NGW * (i); x24_load(F.ws, row_, lane, px[i]); const bf16* yrow = (const bf16*)(F.ws + WS_Y) + (size_t)row_ * DM; \
        _Pragma("unroll") for (int j = 0; j < 8; ++j) yw[i][j] = __builtin_nontemporal_load((const GAS u32x2*)(yrow + 4 * lane + 256 * j)); } while (0)
    THIN_LD(0); THIN_LD(1); THIN_LD(2);
#pragma unroll
    for (int i = 0; i < 4; ++i) { const int row = gw + NGW * i; const int r = row >> 12;
        f32x4 xv[8], yv[8]; float ss = 0.f;
#pragma unroll
        for (int j = 0; j < 8; ++j) { const u32x2 w = yw[i][j]; yv[j] = (f32x4){bf_lo(w.x), bf_hi(w.x), bf_lo(w.y), bf_hi(w.y)}; ss += (yv[j].x * yv[j].x + yv[j].y * yv[j].y) + (yv[j].z * yv[j].z + yv[j].w * yv[j].w); }
        x24_unpack(px[i], xv);
        if (i == 0) THIN_LD(3);
        const float rstd = coef * rsqrtf(wave_sum(ss) * (1.0f / DM) + NORM_EPS);
#pragma unroll
        for (int j = 0; j < 8; ++j) { const f32x4 gg = *(const LAS f32x4*)(prm + (0 * 2 + r) * DM + 4 * lane + 256 * j); xv[j] += (yv[j] * rstd) * gg; }
        if (FINAL) {
#pragma unroll
            for (int j = 0; j < 8; ++j) *(GAS f32x4*)(F.out + (size_t)row * DM + 4 * lane + 256 * j) = xv[j];
        } else x24_store(F.ws, row, lane, xv);
        if (HAS_NEXT) { float s2 = 0.f;
#pragma unroll
            for (int j = 0; j < 8; ++j) s2 += (xv[j].x * xv[j].x + xv[j].y * xv[j].y) + (xv[j].z * xv[j].z + xv[j].w * xv[j].w);
            const float rstd2 = rsqrtf(wave_sum(s2) * (1.0f / DM) + NORM_EPS);
            bf16* xn = (bf16*)(F.ws + WS_XN) + (size_t)row * DM;
#pragma unroll
            for (int j = 0; j < 8; ++j) { const f32x4 gs = *(const LAS f32x4*)(prm + (1 * 2 + r) * DM + 4 * lane + 256 * j), sh = *(const LAS f32x4*)(prm + (2 * 2 + r) * DM + 4 * lane + 256 * j);
                const f32x4 o = (xv[j] * rstd2) * gs + sh;
                u32x2 w; w.x = cvtpk(o.x, o.y); w.y = cvtpk(o.z, o.w); *(GAS u32x2*)(xn + 4 * lane + 256 * j) = w; } }
    }
}
template <bool HAS_Y, bool HAS_NEXT, bool FINAL>
__device__ __forceinline__ void thin_phase(Frame& F, int l, int k, float coef, int ln, int kn, int S) {
    const int gw = F.bx * NWAVES + F.wave, NGW = F.G * NWAVES;
    LAS float* prm = (LAS float*)(F.lds + RING_OFF);
    const bool four = HAS_Y && !FINAL && 4 * NGW == ML;
    if (four) {
        const int t4 = 4 * F.tid;
#pragma unroll
        for (int r = 0; r < 2; ++r) {
            const float* gate = (const float*)(F.ws + WS_MOD) + ((size_t)l * 3 + r) * (NMOD * DM) + (3 * k + 2) * DM; const float* gp = F.in[I_NORMG] + ((size_t)l * 6 + 2 * k + 1) * DM;
            *(LAS f32x4*)(prm + (0 * 2 + r) * DM + t4) = *(const f32x4*)(gate + t4) * *(const f32x4*)(gp + t4);
            if (HAS_NEXT) { const float* mod = (const float*)(F.ws + WS_MOD) + ((size_t)ln * 3 + r) * (NMOD * DM) + (3 * kn) * DM; const float* gq = F.in[I_NORMG] + ((size_t)ln * 6 + 2 * kn) * DM;
                *(LAS f32x4*)(prm + (1 * 2 + r) * DM + t4) = *(const f32x4*)(gq + t4) * (*(const f32x4*)(mod + t4) + 1.0f); *(LAS f32x4*)(prm + (2 * 2 + r) * DM + t4) = *(const f32x4*)(mod + DM + t4); } }
        __syncthreads();
    }
    if (!FINAL && S >= 0) { if (F.G * 2 >= MC) { if (F.wave < 2) { const int rc = F.bx * 2 + F.wave; if (rc < MC) thin_row<HAS_Y, HAS_NEXT, FINAL, false>(F, ML + rc, l, k, coef, ln, kn, S); } }
                            else for (int row = ML + gw; row < MA; row += NGW) thin_row<HAS_Y, HAS_NEXT, FINAL, false>(F, row, l, k, coef, ln, kn, S); }
    if (four) thin_rows4<HAS_NEXT, FINAL>(F, gw, NGW, coef, prm);
    else if (2 * NGW == SEQ) { for (int row = gw; row < ML; row += 2 * NGW) thin_rows2<HAS_Y, HAS_NEXT, FINAL>(F, row, row + NGW, l, k, coef, ln, kn); }
    else for (int row = gw; row < ML; row += NGW) thin_row<HAS_Y, HAS_NEXT, FINAL, true>(F, row, l, k, coef, ln, kn, S);
}
typedef float cpx __attribute__((ext_vector_type(2)));
__device__ __forceinline__ float fadd_(float a, float b) { float r; asm("v_add_f32 %0, %1, %2" : "=v"(r) : "v"(a), "v"(b)); return r; }
__device__ __forceinline__ float fsub_(float a, float b) { float r; asm("v_sub_f32 %0, %1, %2" : "=v"(r) : "v"(a), "v"(b)); return r; }
__device__ __forceinline__ float fmul_(float a, float b) { float r; asm("v_mul_f32 %0, %1, %2" : "=v"(r) : "v"(a), "v"(b)); return r; }
__device__ __forceinline__ float ffma_(float a, float b, float c) { float r; asm("v_fma_f32 %0, %1, %2, %3" : "=v"(r) : "v"(a), "v"(b), "v"(c)); return r; }
__device__ __forceinline__ float ffnma_(float a, float b, float c) { float r; asm("v_fma_f32 %0, -%1, %2, %3" : "=v"(r) : "v"(a), "v"(b), "v"(c)); return r; }
__device__ __forceinline__ cpx cmul(cpx a, cpx b) { return cpx{ffnma_(a.y, b.y, fmul_(a.x, b.x)), ffma_(a.y, b.x, fmul_(a.x, b.y))}; }
__device__ __forceinline__ cpx cadd(cpx a, cpx b) { return cpx{fadd_(a.x, b.x), fadd_(a.y, b.y)}; }
__device__ __forceinline__ cpx csub(cpx a, cpx b) { return cpx{fsub_(a.x, b.x), fsub_(a.y, b.y)}; }
template <bool INV> __device__ __forceinline__ cpx mul_mi(cpx a) { return INV ? cpx{-a.y, a.x} : cpx{a.y, -a.x}; }
template <bool INV> __device__ __forceinline__ cpx twid(float frac) { float c = __builtin_amdgcn_cosf(frac), s = __builtin_amdgcn_sinf(frac); asm volatile("s_nop 1" : "+v"(c), "+v"(s)); return cpx{c, INV ? s : -s}; }
template <bool INV> __device__ __forceinline__ void dft4(cpx& a0, cpx& a1, cpx& a2, cpx& a3) {
    const cpx s0 = cadd(a0, a2), s1 = csub(a0, a2), s2 = cadd(a1, a3), d = csub(a1, a3);
    a0 = cadd(s0, s2); a2 = csub(s0, s2);
    if (INV) { a1 = cpx{fsub_(s1.x, d.y), fadd_(s1.y, d.x)}; a3 = cpx{fadd_(s1.x, d.y), fsub_(s1.y, d.x)}; }
    else     { a1 = cpx{fadd_(s1.x, d.y), fsub_(s1.y, d.x)}; a3 = cpx{fsub_(s1.x, d.y), fadd_(s1.y, d.x)}; }
}
template <bool INV> __device__ __forceinline__ void dft16(cpx (&v)[16]) {
    constexpr float C1 = 0.9238795325112867f, S1 = 0.3826834323650898f, R = 0.7071067811865476f;
    cpx t[4][4];
#pragma unroll
    for (int j = 0; j < 4; ++j) { cpx a0 = v[j], a1 = v[j + 4], a2 = v[j + 8], a3 = v[j + 12]; dft4<INV>(a0, a1, a2, a3); t[0][j] = a0; t[1][j] = a1; t[2][j] = a2; t[3][j] = a3; }
    const float sg = INV ? 1.0f : -1.0f;
    t[1][1] = cmul(t[1][1], cpx{C1, sg * S1}); t[1][2] = cmul(t[1][2], cpx{R, sg * R});   t[1][3] = cmul(t[1][3], cpx{S1, sg * C1});
    t[2][1] = cmul(t[2][1], cpx{R, sg * R});   t[2][2] = mul_mi<INV>(t[2][2]);             t[2][3] = cmul(t[2][3], cpx{-R, sg * R});
    t[3][1] = cmul(t[3][1], cpx{S1, sg * C1}); t[3][2] = cmul(t[3][2], cpx{-R, sg * R});  t[3][3] = cmul(t[3][3], cpx{-C1, -sg * S1});
#pragma unroll
    for (int q = 0; q < 4; ++q) { cpx a0 = t[q][0], a1 = t[q][1], a2 = t[q][2], a3 = t[q][3]; dft4<INV>(a0, a1, a2, a3); v[q] = a0; v[4 + q] = a1; v[8 + q] = a2; v[12 + q] = a3; }
}
constexpr int FFT_HALF_STRIDE = 4096 + 256;
__device__ __forceinline__ int fpos(int e) { return e + (e >> 4); }
template <bool INV> __device__ __forceinline__ void fft_pass_rt(LAS cpx* reg, int tid, int logn) {
    asm volatile("" : "+v"(tid));
    const int st = 1 << (logn - 4); const int u = tid & 255; LAS cpx* base = reg + (tid >> 8) * FFT_HALF_STRIDE;
    const int j = u & (st - 1), b0 = (u >> (logn - 4)) << logn;
    const int p0 = fpos(b0 + j), sp = st + (st >> 4);
    cpx v[16];
#pragma unroll
    for (int q = 0; q < 16; ++q) v[q] = base[p0 + q * sp];
    const int nm = (1 << logn) - 1; const float rn = __int_as_float((127 - logn) << 23);
    if (INV) {
        if (logn > 4) {
            cpx wq[16]; wq[1] = twid<true>((float)j * rn); wq[2] = cmul(wq[1], wq[1]); wq[3] = cmul(wq[2], wq[1]); wq[4] = cmul(wq[2], wq[2]);
#pragma unroll
            for (int q = 5; q < 8; ++q) wq[q] = cmul(wq[4], wq[q - 4]);
            wq[8] = cmul(wq[4], wq[4]);
#pragma unroll
            for (int q = 9; q < 16; ++q) wq[q] = cmul(wq[8], wq[q - 8]);
#pragma unroll
            for (int q = 1; q < 16; ++q) v[q] = cmul(v[q], wq[q]);
        }
        dft16<true>(v);
    } else {
        dft16<false>(v);
        if (logn > 4) {
            cpx wq[16]; wq[1] = twid<false>((float)j * rn); wq[2] = cmul(wq[1], wq[1]); wq[3] = cmul(wq[2], wq[1]); wq[4] = cmul(wq[2], wq[2]);
#pragma unroll
            for (int q = 5; q < 8; ++q) wq[q] = cmul(wq[4], wq[q - 4]);
            wq[8] = cmul(wq[4], wq[4]);
#pragma unroll
            for (int q = 9; q < 16; ++q) wq[q] = cmul(wq[8], wq[q - 8]);
#pragma unroll
            for (int q = 1; q < 16; ++q) v[q] = cmul(v[q], wq[q]);
        }
    }
#pragma unroll
    for (int q = 0; q < 16; ++q) base[p0 + q * sp] = v[q];
}
__device__ __forceinline__ float short_conv(const float* z, int t, int L, float w0, float w1, float w2, float b) {
    const float zm = t > 0 ? z[t - 1] : 0.f, z0 = z[t], zp = t < L - 1 ? z[t + 1] : 0.f;
    return zm * w0 + z0 * w1 + zp * w2 + b;
}
__device__ __forceinline__ void hyena_lat_item(Frame& F, int l, int c) {
    LAS cpx* RA = (LAS cpx*)(F.lds + RING_OFF); LAS cpx* RB = RA + 2 * FFT_HALF_STRIDE;
    const float* hz0 = (const float*)(F.ws + WS_HZL); const float* hz1 = hz0 + (size_t)1536 * 4096;
    const float* cw = F.in[I_HCW] + (size_t)l * 3 * 1536; const float* cbv = F.in[I_HCB] + (size_t)l * 1536;
    const float* kfl = (const float*)(F.ws + WS_KFL) + ((size_t)l * 512 + c) * 2 * 8192;
    const float* kfs = (const float*)(F.ws + WS_KFS) + ((size_t)l * 2 + 0) * 2 * 512;
    const int tid = F.tid;
    int t0_ = 8 * tid; asm volatile("" : "+v"(t0_)); const int t0 = t0_;
    float a0[8], a1[8], g0[2][8], g1[2][8];
#pragma unroll
    for (int part = 0; part < 3; ++part) { const int cc = part * 512 + c; const float w0 = cw[cc], w1 = cw[1536 + cc], w2 = cw[3072 + cc], bb = cbv[cc];
#pragma unroll
        for (int bt = 0; bt < 2; ++bt) { const float* z = (bt ? hz1 : hz0) + (size_t)cc * 4096 + t0;
            const f32x4 za = *(const GAS f32x4*)z, zb = *(const GAS f32x4*)(z + 4);
            float zm = z[t0 > 0 ? -1 : 0], zp = z[t0 + 8 < 4096 ? 8 : 7]; zm = t0 > 0 ? zm : 0.f; zp = t0 + 8 < 4096 ? zp : 0.f;
            const float zz[10] = {zm, za[0], za[1], za[2], za[3], zb[0], zb[1], zb[2], zb[3], zp};
#pragma unroll
            for (int i = 0; i < 8; ++i) { const float s = zz[i] * w0 + zz[i + 1] * w1 + zz[i + 2] * w2 + bb;
                if (part == 0) { if (bt) a1[i] = s; else a0[i] = s; } else { if (bt) g1[part - 1][i] = s; else g0[part - 1][i] = s; } } } }
    float kq[2][16];
#pragma unroll
    for (int o = 0; o < 2; ++o) { const float sc = kfs[o * 512 + c]; const float* kf = kfl + o * 8192 + t0;
        const f32x4 ka = __builtin_nontemporal_load((const GAS f32x4*)kf), kb = __builtin_nontemporal_load((const GAS f32x4*)(kf + 4)), kc = __builtin_nontemporal_load((const GAS f32x4*)(kf + 4096)), kd = __builtin_nontemporal_load((const GAS f32x4*)(kf + 4100));
#pragma unroll
        for (int i = 0; i < 4; ++i) { kq[o][2 * i] = ka[i] * sc; kq[o][2 * i + 1] = kc[i] * sc; kq[o][2 * (i + 4)] = kb[i] * sc; kq[o][2 * (i + 4) + 1] = kd[i] * sc; } }
    const float frb = (float)t0 * (1.0f / 8192.0f); float wbc = __builtin_amdgcn_cosf(frb), wbs = __builtin_amdgcn_sinf(frb); asm volatile("s_nop 1" : "+v"(wbc), "+v"(wbs)); const cpx wb = cpx{wbc, -wbs};
    constexpr float WC[8] = {1.0f, 0.99999970586288223f, 0.99999882345170188f, 0.99999735276697821f, 0.99999529380957619f, 0.99999264658070719f, 0.99998941108192840f, 0.99998558731514291f};
    constexpr float WS[8] = {0.0f, 0.00076699031874270453f, 0.0015339801862847655f, 0.0023009691514258030f, 0.0030679567629659761f, 0.0038349425697062270f, 0.0046019261204485705f, 0.0053689069639963418f};
#pragma unroll 1
    for (int o = 0; o < 2; ++o) {
        { int tq = t0; float wbx = wb.x, wby = wb.y; asm volatile("" : "+v"(tq), "+v"(wbx), "+v"(wby)); const cpx wbl = cpx{wbx, wby};
#pragma unroll
          for (int i = 0; i < 8; ++i) { const int j = tq + i; const float k0 = o ? kq[1][2 * i] : kq[0][2 * i], k1 = o ? kq[1][2 * i + 1] : kq[0][2 * i + 1]; const float d = k0 - k1;
              const cpx w = i ? cmul(wbl, cpx{WC[i], -WS[i]}) : wbl;
              RB[fpos(j)] = cpx{k0 + k1, 0.f}; RB[FFT_HALF_STRIDE + fpos(j)] = cpx{d * w.x, d * w.y};
              const cpx z = cpx{a0[i], a1[i]}; RA[fpos(j)] = z; RA[FFT_HALF_STRIDE + fpos(j)] = cmul(z, w); } }
        __syncthreads();
#pragma unroll 1
        for (int p = 0; p < 2; ++p) {
#pragma unroll 1
            for (int r = 0; r < 2; ++r) fft_pass_rt<false>(r ? RB : RA, tid, 12 - 4 * p);
            __syncthreads();
        }
        { int tq = tid; asm volatile("" : "+v"(tq)); const int u = tq & 255; LAS cpx* bA = RA + (tq >> 8) * FFT_HALF_STRIDE + 17 * u; LAS cpx* bB = bA + 2 * FFT_HALF_STRIDE;
          cpx v[16], f[16];
#pragma unroll
          for (int q = 0; q < 16; ++q) { v[q] = bA[q]; f[q] = bB[q]; }
          dft16<false>(v); dft16<false>(f);
#pragma unroll
          for (int q = 0; q < 16; ++q) v[q] = cmul(v[q], f[q]);
          dft16<true>(v);
#pragma unroll
          for (int q = 0; q < 16; ++q) bA[q] = v[q]; }
        __syncthreads();
#pragma unroll 1
        for (int p = 1; p < 3; ++p) { fft_pass_rt<true>(RA, tid, 4 + 4 * p); __syncthreads(); }
        { const float sk = F.in[I_HSKIP][((size_t)l * 2 + o) * 512 + c]; int tq = t0; float wbx = wb.x, wby = wb.y; asm volatile("" : "+v"(tq), "+v"(wbx), "+v"(wby)); const cpx wbl = cpx{wbx, wby};
#pragma unroll
          for (int i = 0; i < 8; ++i) { const int j = tq + i; const cpx wf = i ? cmul(wbl, cpx{WC[i], -WS[i]}) : wbl; const cpx wc = cpx{wf.x, -wf.y};
              const cpx lo = RA[fpos(j)], up = cmul(RA[FFT_HALF_STRIDE + fpos(j)], wc);
              const float y0 = (lo.x + up.x) * (1.0f / 8192.0f), y1 = (lo.y + up.y) * (1.0f / 8192.0f);
              const float x0 = o ? g0[1][i] : g0[0][i], x1 = o ? g1[1][i] : g1[0][i];
              a0[i] = x0 * (y0 + a0[i] * sk); a1[i] = x1 * (y1 + a1[i] * sk); } }
    }
    __syncthreads();
    { bf16* cot = (bf16*)(F.ws + WS_COTL) + (size_t)c * 4096 + t0;
      const v4u w0 = {cvtpk(a0[0], a0[1]), cvtpk(a0[2], a0[3]), cvtpk(a0[4], a0[5]), cvtpk(a0[6], a0[7])}, w1 = {cvtpk(a1[0], a1[1]), cvtpk(a1[2], a1[3]), cvtpk(a1[4], a1[5]), cvtpk(a1[6], a1[7])};
      *(GAS v4u*)cot = w0; *(GAS v4u*)(cot + (size_t)512 * 4096) = w1; }
}
__device__ __forceinline__ void hyena_ctx_item(Frame& F, int l, int it) {
    const int cq = F.tid >> 7, r = F.tid & 127, b = r >> 6, tq = r & 63, c = 4 * it + cq, t0 = 4 * tq;
    LAS float* K0 = (LAS float*)(F.lds + RING_OFF) + cq * 1536; LAS float* K1 = K0 + 512; LAS float* U = K1 + 512;
    const float* kfc = (const float*)(F.ws + WS_KFC) + ((size_t)l * 512 + c) * 2 * 512;
    const float* kfs = (const float*)(F.ws + WS_KFS) + ((size_t)l * 2 + 1) * 2 * 512;
    const float* cw = F.in[I_HCW] + (size_t)l * 3 * 1536; const float* cbv = F.in[I_HCB] + (size_t)l * 1536;
    const float sk0 = F.in[I_HSKIP][((size_t)l * 2 + 0) * 512 + c], sk1 = F.in[I_HSKIP][((size_t)l * 2 + 1) * 512 + c];
    const float* hz = (const float*)(F.ws + WS_HZC) + (size_t)b * 1536 * 256;
    const f32x4 k0v = *(const GAS f32x4*)(kfc + 4 * r) * kfs[c], k1v = *(const GAS f32x4*)(kfc + 512 + 4 * r) * kfs[512 + c];
    float xs[3][4];
#pragma unroll
    for (int part = 0; part < 3; ++part) { const int cc = part * 512 + c; const float* z = hz + (size_t)cc * 256 + t0; const float w0 = cw[cc], w1 = cw[1536 + cc], w2 = cw[3072 + cc], bb = cbv[cc];
        const f32x4 zc = *(const GAS f32x4*)z; const float zm = t0 > 0 ? z[-1] : 0.f, zp = t0 + 4 < 256 ? z[4] : 0.f;
        xs[part][0] = zm * w0 + zc[0] * w1 + zc[1] * w2 + bb; xs[part][1] = zc[0] * w0 + zc[1] * w1 + zc[2] * w2 + bb;
        xs[part][2] = zc[1] * w0 + zc[2] * w1 + zc[3] * w2 + bb; xs[part][3] = zc[2] * w0 + zc[3] * w1 + zp * w2 + bb; }
    *(LAS f32x4*)(K0 + 4 * r) = k0v; *(LAS f32x4*)(K1 + 4 * r) = k1v;
    *(LAS f32x4*)(U + b * 256 + t0) = (f32x4){xs[0][0], xs[0][1], xs[0][2], xs[0][3]};
    float cur[4] = {xs[0][0], xs[0][1], xs[0][2], xs[0][3]};
#pragma unroll 1
    for (int o = 0; o < 2; ++o) {
        __syncthreads();
        const LAS float* K = o ? K1 : K0; const LAS float* Ub = U + b * 256;
        float y[4] = {0.f, 0.f, 0.f, 0.f};
        f32x4 ghi = *(const LAS f32x4*)(K + (t0 & 511)), glo = *(const LAS f32x4*)(K + ((t0 - 4) & 511));
#pragma unroll 4
        for (int s = 0; s < 256; s += 4) {
            const f32x4 u = *(const LAS f32x4*)(Ub + s);
            const float kk[8] = {glo[0], glo[1], glo[2], glo[3], ghi[0], ghi[1], ghi[2], ghi[3]};
#pragma unroll
            for (int k = 0; k < 4; ++k)
#pragma unroll
                for (int j = 0; j < 4; ++j) y[k] += u[j] * kk[4 + k - j];
            ghi = glo; glo = *(const LAS f32x4*)(K + ((t0 - s - 8) & 511));
        }
        const float sk = o ? sk1 : sk0;
#pragma unroll
        for (int k = 0; k < 4; ++k) cur[k] = (o ? xs[2][k] : xs[1][k]) * (y[k] + cur[k] * sk);
        __syncthreads();
        if (o == 0) *(LAS f32x4*)(U + b * 256 + t0) = (f32x4){cur[0], cur[1], cur[2], cur[3]};
    }
    u32x2 w; w.x = cvtpk(cur[0], cur[1]); w.y = cvtpk(cur[2], cur[3]);
    *(GAS u32x2*)((bf16*)(F.ws + WS_COTC) + ((size_t)b * 512 + c) * 256 + t0) = w;
    __syncthreads();
}
__device__ __forceinline__ void hy_transpose_item(Frame& F, int it) {
    LAS bf16* T = (LAS bf16*)(F.lds + RING_OFF);
    const bool lat = it < 256; const int x = lat ? it : it - 256;
    const int tt = lat ? (x & 15) : 0, ct = lat ? ((x >> 4) & 7) : (x & 7), b = lat ? (x >> 7) : (x >> 3);
    const int L = lat ? 4096 : 256;
    const bf16* src = (lat ? (const bf16*)(F.ws + WS_COTL) : (const bf16*)(F.ws + WS_COTC)) + ((size_t)b * 512 + ct * 64) * L + tt * 256;
    v4u d[4];
#pragma unroll
    for (int i = 0; i < 4; ++i) { const int id = F.tid + 512 * i, ch = id >> 5, k = id & 31; d[i] = __builtin_nontemporal_load((const GAS v4u*)(src + (size_t)ch * L + 8 * k)); }
#pragma unroll
    for (int i = 0; i < 4; ++i) { const int id = F.tid + 512 * i, ch = id >> 5, k = id & 31; LAS unsigned* tp = (LAS unsigned*)(T + ch * 264 + 8 * k); tp[0] = d[i].x; tp[1] = d[i].y; tp[2] = d[i].z; tp[3] = d[i].w; }
    __syncthreads();
#pragma unroll
    for (int i = 0; i < 4; ++i) { const int id = F.tid + 512 * i, t = id >> 3, cc = id & 7; unsigned w[4];
#pragma unroll
        for (int k = 0; k < 4; ++k) w[k] = (unsigned)T[(8 * cc + 2 * k) * 264 + t] | ((unsigned)T[(8 * cc + 2 * k + 1) * 264 + t] << 16);
        const size_t row = (size_t)(lat ? b * SEQ : ML + b * CTXL) + tt * 256 + t;
        *(GAS v4u*)((bf16*)(F.ws + WS_MIX) + row * DMIX + 1536 + ct * 64 + 8 * cc) = (v4u){w[0], w[1], w[2], w[3]}; }
    __syncthreads();
}
constexpr int KT_STRIDE = 272, VT_STRIDE = 264;
constexpr int KT_BYTES = 128 * KT_STRIDE;
__device__ __forceinline__ f32x16 mfma32(bf16x8 a, bf16x8 b, f32x16 c) { return __builtin_amdgcn_mfma_f32_32x32x16_bf16(a, b, c, 0, 0, 0); }
__device__ __forceinline__ void attn_item(Frame& F, int l, int it) {
    const bool lat = it < 256; int nblk, pair, kh, b;
    if (lat) { nblk = it & 31; pair = (it >> 5) & 1; kh = (it >> 6) & 1; b = it >> 7; } else { const int x = it - 256; nblk = x & 1; pair = (x >> 1) & 1; kh = (x >> 2) & 1; b = x >> 3; }
    int lane_ = F.lane; asm volatile("" : "+v"(lane_));
    const int w = F.wave, lane = lane_, h = lane >> 5, ql = lane & 31;
    const int hq = 4 * kh + 2 * pair + (w >> 2);
    const int qi = 32 * (w & 3) + ql;
    const size_t qrow = (size_t)(lat ? b * SEQ : ML + b * CTXL) + 128 * nblk + qi;
    const bf16* QBp = (const bf16*)(F.ws + WS_QB); const bf16* KBp = (const bf16*)(F.ws + WS_KB);
    const bf16* VTl = (const bf16*)(F.ws + WS_VTL); const bf16* VTc = (const bf16*)(F.ws + WS_VTC);
    LAS unsigned char* Kt = F.lds + RING_OFF; LAS unsigned char* Vt = Kt + KT_BYTES;
    LAS unsigned char* Ost = F.lds + RING_OFF + 69632 + w * 8704;
    const size_t wrow = qrow - ql;
    { v4u qd[8];
#pragma unroll
      for (int i = 0; i < 8; ++i) { const int id = lane + 64 * i; qd[i] = *(const GAS v4u*)(QBp + (wrow + (id >> 4)) * 1024 + hq * 128 + 8 * (id & 15)); }
#pragma unroll
      for (int i = 0; i < 8; ++i) { const int id = lane + 64 * i; *(LAS v4u*)(Ost + (id >> 4) * 272 + (id & 15) * 16) = qd[i]; } }
    bf16x8 qf[8];
#pragma unroll
    for (int s = 0; s < 8; ++s) qf[s] = *(const LAS bf16x8*)(Ost + ql * 272 + (16 * s + 8 * h) * 2);
    float m = F.in[I_SINK][l * 8 + hq] * LOG2E; float lsum = h == 0 ? 1.0f : 0.0f;
    f32x16 O[4];
#pragma unroll
    for (int dt = 0; dt < 4; ++dt)
#pragma unroll
        for (int r = 0; r < 16; ++r) O[dt][r] = 0.f;
    const int ntiles = lat ? 5 : 2;
#define ATT_TILE(t, ksrc, vsrc, vld) do { if ((t) < 2) { ksrc = KBp + (size_t)(ML + b * CTXL + 128 * (t)) * 256 + kh * 128; vsrc = VTc + (size_t)((b * 2 + kh) * 128) * 256 + 128 * (t); vld = 256; } \
        else { const int kb_ = nblk + (t) - 3; ksrc = KBp + (size_t)(b * SEQ + 128 * kb_) * 256 + kh * 128; vsrc = VTl + (size_t)((b * 2 + kh) * 128) * 4096 + 128 * kb_; vld = 4096; } } while (0)
#define ATT_LOAD(ksrc, vsrc, vld) do { _Pragma("unroll") for (int i = 0; i < 4; ++i) { const int id = F.tid + 512 * i, row = id >> 4, ch = id & 15; \
        kd[i] = *(const GAS v4u*)(ksrc + (size_t)row * 256 + ch * 8); vd[i] = *(const GAS v4u*)(vsrc + (size_t)row * vld + ch * 8); } } while (0)
    v4u kd[4], vd[4];
    int ti = 0;
    { const bf16* ksrc; const bf16* vsrc; int vld; ATT_TILE(0, ksrc, vsrc, vld); ATT_LOAD(ksrc, vsrc, vld); }
    while (ti < ntiles) {
        const int type = ti < 2 ? 0 : (ti == 2 ? 1 : (ti == 3 ? 0 : 2));
        __syncthreads();
#pragma unroll
        for (int i = 0; i < 4; ++i) { const int id = F.tid + 512 * i, row = id >> 4, ch = id & 15;
            *(LAS v4u*)(Kt + row * KT_STRIDE + ch * 16) = kd[i];
            *(LAS u32x2*)(Vt + row * VT_STRIDE + ch * 16) = (u32x2){vd[i].x, vd[i].y}; *(LAS u32x2*)(Vt + row * VT_STRIDE + ch * 16 + 8) = (u32x2){vd[i].z, vd[i].w}; }
        __syncthreads();
        int tn = ti + 1; if (tn == 2 && nblk == 0) tn = 3; if (tn == 4 && nblk == 31) tn = 5;
        if (tn < ntiles) { const bf16* ksrc; const bf16* vsrc; int vld; ATT_TILE(tn, ksrc, vsrc, vld); ATT_LOAD(ksrc, vsrc, vld); }
#pragma unroll 1
        for (int hs = 0; hs < 2; ++hs) {
            f32x16 S[2];
#pragma unroll
            for (int sb = 0; sb < 2; ++sb) {
#pragma unroll
                for (int r = 0; r < 16; ++r) S[sb][r] = 0.f;
#pragma unroll
                for (int s = 0; s < 8; ++s) { const bf16x8 a = *(const LAS bf16x8*)(Kt + (32 * (2 * hs + sb) + ql) * KT_STRIDE + (16 * s + 8 * h) * 2); S[sb] = mfma32(a, qf[s], S[sb]); }
            }
            if (type != 0) {
                int qv = type == 1 ? qi - 4 * h - 64 * hs : -(qi - 4 * h - 64 * hs); asm volatile("" : "+v"(qv));
#pragma unroll
                for (int sb = 0; sb < 2; ++sb)
#pragma unroll
                    for (int r = 0; r < 16; ++r) { const int j0 = 32 * sb + (r & 3) + 8 * (r >> 2); const int jv = type == 1 ? j0 : -j0; if (jv < qv) S[sb][r] = -1e30f; }
            }
            float mx = m;
#pragma unroll
            for (int sb = 0; sb < 2; ++sb)
#pragma unroll
                for (int r = 0; r < 16; ++r) mx = fmaxf(mx, S[sb][r]);
            mx = fmaxf(mx, __shfl_xor(mx, 32));
            const float alpha = __builtin_amdgcn_exp2f(m - mx); m = mx; lsum *= alpha;
#pragma unroll
            for (int dt = 0; dt < 4; ++dt)
#pragma unroll
                for (int r = 0; r < 16; ++r) O[dt][r] *= alpha;
            float ps = 0.f;
#pragma unroll
            for (int sb = 0; sb < 2; ++sb)
#pragma unroll
                for (int r = 0; r < 16; ++r) { const float p = __builtin_amdgcn_exp2f(S[sb][r] - mx); S[sb][r] = p; ps += p; }
            lsum += ps;
#pragma unroll
            for (int sb = 0; sb < 2; ++sb)
#pragma unroll
                for (int s2 = 0; s2 < 2; ++s2) {
                    v4u pw; pw.x = cvtpk(S[sb][8 * s2 + 0], S[sb][8 * s2 + 1]); pw.y = cvtpk(S[sb][8 * s2 + 2], S[sb][8 * s2 + 3]); pw.z = cvtpk(S[sb][8 * s2 + 4], S[sb][8 * s2 + 5]); pw.w = cvtpk(S[sb][8 * s2 + 6], S[sb][8 * s2 + 7]);
                    const bf16x8 pf = __builtin_bit_cast(bf16x8, pw);
#pragma unroll
                    for (int dt = 0; dt < 4; ++dt) { LAS unsigned char* vb = Vt + (32 * dt + ql) * VT_STRIDE + (32 * (2 * hs + sb) + 16 * s2 + 4 * h) * 2;
                        const u32x2 lo = *(const LAS u32x2*)vb, hi = *(const LAS u32x2*)(vb + 16);
                        const bf16x8 a = __builtin_bit_cast(bf16x8, (v4u){lo.x, lo.y, hi.x, hi.y});
                        O[dt] = mfma32(a, pf, O[dt]); }
                    asm volatile("" ::: "memory");
                }
        }
        ti = tn;
    }
#undef ATT_TILE
#undef ATT_LOAD
    const float lt = lsum + __shfl_xor(lsum, 32); const float inv = 1.0f / lt;
    { int lq = lane; asm volatile("" : "+v"(lq));
      const int ql2 = lq & 31, h2 = lq >> 5;
#pragma unroll
      for (int dt = 0; dt < 4; ++dt)
#pragma unroll
          for (int g = 0; g < 4; ++g) { u32x2 wv; wv.x = cvtpk(O[dt][4 * g + 0] * inv, O[dt][4 * g + 1] * inv); wv.y = cvtpk(O[dt][4 * g + 2] * inv, O[dt][4 * g + 3] * inv);
              *(LAS u32x2*)(Ost + ql2 * 272 + (32 * dt + 8 * g + 4 * h2) * 2) = wv; }
      bf16* op = (bf16*)(F.ws + WS_MIX) + ((size_t)(lat ? b * SEQ : ML + b * CTXL) + 128 * nblk + 32 * (w & 3)) * DMIX + 512 + hq * 128;
#pragma unroll
      for (int i = 0; i < 8; ++i) { const int id = lq + 64 * i; *(GAS v4u*)(op + (size_t)(id >> 4) * DMIX + 8 * (id & 15)) = *(const LAS v4u*)(Ost + (id >> 4) * 272 + (id & 15) * 16); } }
    __syncthreads();
}
__device__ __forceinline__ void sgu_item(Frame& F, int l, int it) {
    const int n = it >> 2, g = it & 3; const int row0 = 128 * n;
    int lane_ = F.lane; asm volatile("" : "+v"(lane_));
    const int w = F.wave, lane = lane_, h = lane >> 5, ql = lane & 31;
    LAS unsigned char* VnT = F.lds + RING_OFF;
    const bf16* AU = (const bf16*)(F.ws + WS_AU);
    const int ct = w & 3, qt0 = 2 * (w >> 2);
    const float* Ws = F.in[I_SGUW] + ((size_t)l * 4 + g) * 128 * 128;
    bf16* MIXp = (bf16*)(F.ws + WS_MIX);
    float gam[8];
#pragma unroll
    for (int k = 0; k < 8; ++k) gam[k] = F.in[I_SGUG][l * 512 + 8 * lane + k];
    v4u dd[16];
#pragma unroll
    for (int rr = 0; rr < 16; ++rr) dd[rr] = *(const GAS v4u*)(AU + (size_t)(row0 + 16 * w + rr) * 1024 + 512 + 8 * lane);
    v4u bfr[2][8]; float bs[2];
    LAS unsigned char* Ut = VnT + 128 * 272;
    v4u ud[4];
#pragma unroll
    for (int i = 0; i < 4; ++i) { const int id = (w * 64 + lane) + 512 * i; ud[i] = *(const GAS v4u*)(AU + ((size_t)row0 + (id >> 4)) * 1024 + 128 * g + 8 * (id & 15)); }
#pragma unroll
    for (int qq = 0; qq < 2; ++qq) { const int q = 32 * (qt0 + qq) + ql; const GAS float* wp = (const GAS float*)(Ws + (size_t)q * 128 + 8 * h);
        f32x4 w0[8], w1[8];
#pragma unroll
        for (int s = 0; s < 8; ++s) { w0[s] = *(const GAS f32x4*)(wp + 16 * s); w1[s] = *(const GAS f32x4*)(wp + 16 * s + 4); }
        bs[qq] = F.in[I_SGUB][((size_t)l * 4 + g) * 128 + q];
#pragma unroll
        for (int s = 0; s < 8; ++s) bfr[qq][s] = (v4u){cvtpk(w0[s][0], w0[s][1]), cvtpk(w0[s][2], w0[s][3]), cvtpk(w1[s][0], w1[s][1]), cvtpk(w1[s][2], w1[s][3])}; }
#pragma unroll
    for (int rr = 0; rr < 16; ++rr) {
        const int p = 16 * w + rr; const v4u d = dd[rr];
        float x[8] = {bf_lo(d.x), bf_hi(d.x), bf_lo(d.y), bf_hi(d.y), bf_lo(d.z), bf_hi(d.z), bf_lo(d.w), bf_hi(d.w)};
        float s = 0.f;
#pragma unroll
        for (int k = 0; k < 8; ++k) s += x[k];
        const float mean = wave_sum(s) * (1.0f / 512.0f); float q = 0.f;
#pragma unroll
        for (int k = 0; k < 8; ++k) { x[k] -= mean; q += x[k] * x[k]; }
        const float rstd = rsqrtf(wave_sum(q) * (1.0f / 512.0f) + NORM_EPS);
        if ((lane >> 4) == g) {
#pragma unroll
            for (int k = 0; k < 8; ++k) { const int cl = 8 * (lane & 15) + k; *(LAS bf16*)(VnT + cl * 272 + ((((p >> 3) ^ (lane & 15)) << 4) | ((p & 7) << 1))) = (bf16)f2bf(x[k] * rstd * gam[k]); }
        }
    }
#pragma unroll
    for (int i = 0; i < 4; ++i) { const int id = (w * 64 + lane) + 512 * i; *(LAS v4u*)(Ut + (id >> 4) * 272 + (id & 15) * 16) = ud[i]; }
    __syncthreads();
    bf16x8 af[8];
#pragma unroll
    for (int s = 0; s < 8; ++s) af[s] = *(const LAS bf16x8*)(VnT + (32 * ct + ql) * 272 + (((2 * s + h) ^ (((32 * ct + ql) >> 3) & 15)) << 4));
#pragma unroll
    for (int qq = 0; qq < 2; ++qq) {
        const int q = 32 * (qt0 + qq) + ql;
        f32x16 D;
#pragma unroll
        for (int r = 0; r < 16; ++r) D[r] = 0.f;
#pragma unroll
        for (int s = 0; s < 8; ++s) D = mfma32(af[s], __builtin_bit_cast(bf16x8, bfr[qq][s]), D);
        const size_t row = (size_t)row0 + q;
#pragma unroll
        for (int gi = 0; gi < 4; ++gi) { LAS u32x2* up = (LAS u32x2*)(Ut + q * 272 + (32 * ct + 8 * gi + 4 * h) * 2); const u32x2 u2 = *up;
            u32x2 o; o.x = cvtpk(bf_lo(u2.x) * (D[4 * gi + 0] + bs[qq]), bf_hi(u2.x) * (D[4 * gi + 1] + bs[qq])); o.y = cvtpk(bf_lo(u2.y) * (D[4 * gi + 2] + bs[qq]), bf_hi(u2.y) * (D[4 * gi + 3] + bs[qq]));
            *up = o; }
    }
    __syncthreads();
#pragma unroll
    for (int i = 0; i < 4; ++i) { const int id = (w * 64 + lane) + 512 * i; *(GAS v4u*)(MIXp + ((size_t)row0 + (id >> 4)) * DMIX + 128 * g + 8 * (id & 15)) = *(const LAS v4u*)(Ut + (id >> 4) * 272 + (id & 15) * 16); }
    __syncthreads();
}
#ifndef PHM
#define PHM 0xffffffffu
#endif
#define PON(b) ((PHM >> (b)) & 1u)
__device__ __forceinline__ int grab(Frame& F, int qidx) {
    __syncthreads();
    if (F.tid == 0) F.MISC[16] = __hip_atomic_fetch_add(F.ctl + CW_Q + qidx * 64, 1u, __ATOMIC_RELAXED, __HIP_MEMORY_SCOPE_AGENT);
    __syncthreads();
    return (int)F.MISC[16];
}
#ifndef PROBE_DUP
#define PROBE_DUP 0
#endif
__device__ __forceinline__ Frame phase_frame(const Frame& F);
__device__ __forceinline__ void mixer_phase(Frame& F, int lq) {
    const int l = lq & 3;
    for (int rep = 0; rep < (PROBE_DUP == 12 ? 2 : 1); ++rep)
    if (PON(12)) { Frame P = phase_frame(F);
        const bool remap = P.G == 256;
        for (int it0 = P.bx; it0 < (remap ? 512 : 272); it0 += P.G) { int it = it0; if (remap && it0 >= 256) { const int x = it0 - 256; it = (x >= 128 && x < 144) ? 128 + x : 1 << 20; } if (it < 272) attn_item(P, l, it); } }
    for (int rep = 0; rep < (PROBE_DUP == 13 ? 2 : 1); ++rep)
    if (PON(13)) { Frame P = phase_frame(F); for (int it = P.bx; it < 512; it += P.G) hyena_lat_item(P, l, it); }
    for (int rep = 0; rep < (PROBE_DUP == 14 ? 2 : 1); ++rep)
    if (PON(14)) { Frame P = phase_frame(F); for (int it = P.G - 1 - P.bx; it < 272; it += P.G) sgu_item(P, l, it); }
    for (int rep = 0; rep < (PROBE_DUP == 15 ? 2 : 1); ++rep)
    if (PON(15)) { Frame P = phase_frame(F); for (int it = P.bx; it < 128; it += P.G) hyena_ctx_item(P, l, it); }
}

__device__ __forceinline__ void win_fixup(Frame& F) {
    for (int it = F.bx; it < 256; it += F.G) {
        const int tile = it >> 3, ai = (it >> 2) & 1, m = it & 3;
        const int pm = 32 + (tile & 1), pn = tile >> 1;
        const int wid = F.wave, lane = F.lane, wr = wid >> 2, wc = wid & 3, fr = lane & 15, fq = lane >> 4;
        const bf16* zs = (const bf16*)(F.ws + WS_ZS) + ((size_t)(pm - 32) * 256 + ai * 128 + m * 16 + wr * 64 + fr) * 4096 + pn * 256 + wc * 32 + 8 * fq;
        v4u part[S_IN][2];
#pragma unroll
        for (int s = 0; s < S_IN; ++s)
#pragma unroll
            for (int bj = 0; bj < 2; ++bj) part[s][bj] = __builtin_nontemporal_load((const GAS v4u*)(zs + (size_t)s * 512 * 4096 + bj * 128));
        pg8::f32x4 acc[1][2][1][2];
#pragma unroll
        for (int bj = 0; bj < 2; ++bj) { pg8::f32x4 v0 = {0.f, 0.f, 0.f, 0.f}, v1 = v0;
#pragma unroll
            for (int s = 0; s < S_IN; ++s) { const v4u w = part[s][bj]; v0 += (pg8::f32x4){bf_lo(w.x), bf_hi(w.x), bf_lo(w.y), bf_hi(w.y)}; v1 += (pg8::f32x4){bf_lo(w.z), bf_hi(w.z), bf_lo(w.w), bf_hi(w.w)}; }
            acc[0][bj][0][0] = v0; acc[0][bj][0][1] = v1; }
        pg8::EpiWin E{F.ws, QSCALE};
        E.finish<1, 1>(acc, pm * 256 + ai * 128 + m * 16, pm, pn, wr, wc, fr, fq);
    }
}
__device__ __forceinline__ Frame phase_frame(const Frame& F) {
    Frame P = F;
    unsigned long long w = (unsigned long long)P.ws; int gg = P.G, bx = P.bx; asm volatile("" : "+s"(w), "+s"(gg), "+s"(bx)); P.ws = (unsigned char*)w; P.G = gg; P.bx = bx;
    P.ctl = (gu32*)(P.ws + WS_CTL);
    int ln; asm volatile("v_mbcnt_lo_u32_b32 %0, -1, 0\n\tv_mbcnt_hi_u32_b32 %0, -1, %0" : "=v"(ln)); P.lane = ln; P.tid = P.wave * 64 + ln;
    return P;
}
struct Args { const float* in[28]; float* out; unsigned char* ws; int ph_lo, ph_hi; };
constexpr int NPH = 2 + 12 * DEPTH;
__global__ void __launch_bounds__(NWAVES * 64, 2) hymba_fwd(Args args) {
    extern __shared__ __attribute__((aligned(16))) unsigned char lds[];
    Frame F;
    F.lds = (LAS unsigned char*)lds;
    F.MISC = (volatile LAS unsigned*)(F.lds + MISC_OFF);
    F.tid = threadIdx.x; F.lane = F.tid & 63; F.wave = __builtin_amdgcn_readfirstlane(F.tid >> 6);
    F.G = gridDim.x; F.bx = blockIdx.x;
    F.in = args.in;
    F.out = args.out; F.ws = args.ws;
    F.ctl = (gu32*)(args.ws + WS_CTL);
    for (int u = F.tid; u < (LDS_BYTES - LDSCTL_OFF) / 4; u += NWAVES * 64) ((LAS unsigned*)(F.lds + LDSCTL_OFF))[u] = 0u;
    __syncthreads();
    XcdBarrier bar; bar.bar = (unsigned*)(F.ctl + CW_BAR); bar.x = 0; bar.st = nullptr;
    if (!MK_MULTI) bar = xcd_barrier_post((unsigned*)(F.ctl + CW_BAR), F.MISC + 8);
    const int lo = args.ph_lo, hi = args.ph_hi;
#ifndef STAMP_LNB
#define STAMP_LNB 0.1823215568f
#endif
#ifndef STAMP_OFS
#define STAMP_OFS 0.0f
#endif
#ifndef STAMP_SEL
#define STAMP_SEL -1
#endif
#define tsb ((unsigned long long*)(args.ws + WS_CTL + 512 * 1024))
#define STAMP(p) do { if (STAMP_SEL >= 0 && blockIdx.x == 0 && threadIdx.x == 0) tsb[p] = __builtin_amdgcn_s_memrealtime(); } while (0)
#ifndef PHM
#define PHM 0xffffffffu
#endif
#define PON(b) ((PHM >> (b)) & 1u)
#define IN(k) (lo <= (k) && (k) < hi)
#define SEAM(k) do { if (!MK_MULTI && (k) + 1 < hi) xcd_barrier(bar); } while (0)

#ifndef PROBE_DUP
#define PROBE_DUP 0
#endif
    STAMP(0);
    if (IN(0)) { if (PON(0)) { Frame P = phase_frame(F); p0_prologue(P); } SEAM(0); }
    if (PROBE_DUP == 1) { { Frame P = phase_frame(F); p0_prologue(P); } xcd_barrier(bar); }
    STAMP(1);
    if (IN(1)) {
        Frame P = phase_frame(F);
        const bool conv_first = ((P.bx >> 3) & 1) != 0;
        if (conv_first) { p0_convert_all(P); __syncthreads(); }
        if (PON(1)) for (int it = P.bx; it < DEPTH * 2 * 64; it += P.G) p1_filter_item(P, it);
        if (!conv_first) { __syncthreads(); p0_convert_all(P); }
        if (PON(2)) thin_phase<false, true, false>(P, 0, 0, 0.f, 0, 0, 0);
        SEAM(1);
    }
    for (int l = 0; l < DEPTH; ++l) {
        const int pb = 2 + 12 * l;
        STAMP(pb + 0);
        if (IN(pb + 0) && PON(3)) {
            Frame P = phase_frame(F); unsigned char* wl = P.ws + WS_W + (size_t)l * WL_STRIDE;
            pg8::Gemm g{(const pg8::bf16_t*)(P.ws + WS_XN), (const pg8::bf16_t*)(wl + WL_GU1), MA, 2 * FF, DM}; pg8::MixedOrder S; S.init(2 * FF, DM, 1, P.G, P.bx);
            pg8::EpiSwiGLU E{(pg8::bf16_t*)(P.ws + WS_H), FF};
            pg8::gemm_phase<pg8::EpiSwiGLU, pg8::MixedOrder, true, true>(P.lds + RING_OFF, g, S, E, P.tid);
            if (PROBE_DUP == 5) { xcd_barrier(bar); pg8::gemm_phase<pg8::EpiSwiGLU, pg8::MixedOrder, true, true>(P.lds + RING_OFF, g, S, E, P.tid); }
            if (PROBE_DUP == 7) { xcd_barrier(bar); pg8::EpiNone EN; pg8::gemm_phase<pg8::EpiNone, pg8::MixedOrder, true, true>(P.lds + RING_OFF, g, S, EN, P.tid); }
        }
        if (IN(pb + 0)) SEAM(pb + 0);
        if (PROBE_DUP == 20) { for (int rep = 0; rep < 8; ++rep) xcd_barrier(bar); }
        STAMP(pb + 1);
        if (IN(pb + 1) && PON(4)) {
            Frame P = phase_frame(F); unsigned char* wl = P.ws + WS_W + (size_t)l * WL_STRIDE;
            pg8::Gemm g{(const pg8::bf16_t*)(P.ws + WS_H), (const pg8::bf16_t*)(wl + WL_D1), MA, DM, FF}; pg8::MixedOrder S; S.init(DM, FF, S_DOWN, P.G, P.bx);
            pg8::EpiF32 E{(pg8::bf16_t*)(P.ws + WS_Y), DM, (pg8::bf16_t*)(P.ws + WS_YS)};
            pg8::gemm_phase<pg8::EpiF32, pg8::MixedOrder, true, true>(P.lds + RING_OFF, g, S, E, P.tid);
            if (PROBE_DUP == 4) { xcd_barrier(bar); pg8::gemm_phase<pg8::EpiF32, pg8::MixedOrder, true, true>(P.lds + RING_OFF, g, S, E, P.tid); }
        }
        if (IN(pb + 1)) SEAM(pb + 1);
        STAMP(pb + 2);
        if (IN(pb + 2)) { if (PON(5)) { Frame P = phase_frame(F); thin_phase<true, true, false>(P, l, 0, 0.5f, l, 1, S_DOWN); } SEAM(pb + 2); }
        STAMP(pb + 3);
        if (IN(pb + 3) && PON(6)) {
            Frame P = phase_frame(F); unsigned char* wl = P.ws + WS_W + (size_t)l * WL_STRIDE;
            pg8::Gemm g{(const pg8::bf16_t*)(P.ws + WS_XN), (const pg8::bf16_t*)(wl + WL_IN), MA, INC, DM}; pg8::MixedOrder S; S.init(INC, DM, S_IN, P.G, P.bx);
            pg8::EpiWin E{P.ws, QSCALE};
            pg8::gemm_phase<pg8::EpiWin, pg8::MixedOrder, true, true>(P.lds + RING_OFF, g, S, E, P.tid);
        }
        if (IN(pb + 3)) SEAM(pb + 3);
        STAMP(pb + 4);
        if (IN(pb + 4)) { if (PON(6)) { Frame P = phase_frame(F); win_fixup(P); } SEAM(pb + 4); }
        STAMP(pb + 5);
        if (IN(pb + 5)) { { Frame P = phase_frame(F); mixer_phase(P, l); } SEAM(pb + 5); }
        STAMP(pb + 6);
        if (IN(pb + 6)) { { Frame P = phase_frame(F); for (int it = P.bx; it < 272; it += P.G) hy_transpose_item(P, it); } SEAM(pb + 6); }
        STAMP(pb + 7);
        if (PROBE_DUP == 3) { { Frame P = phase_frame(F); mixer_phase(P, l + 4); } xcd_barrier(bar); }
        if (PROBE_DUP == 6) { { Frame P = phase_frame(F); win_fixup(P); } xcd_barrier(bar);
            { Frame P = phase_frame(F); for (int it = P.bx; it < 272; it += P.G) hy_transpose_item(P, it); } xcd_barrier(bar); }
        if (IN(pb + 7) && PON(7)) {
            Frame P = phase_frame(F); unsigned char* wl = P.ws + WS_W + (size_t)l * WL_STRIDE;
            pg8::Gemm g{(const pg8::bf16_t*)(P.ws + WS_MIX), (const pg8::bf16_t*)(wl + WL_OUT), MA, DM, DMIX}; pg8::MixedOrder S; S.init(DM, DMIX, S_OUT, P.G, P.bx, l != DEPTH - 1);
            pg8::EpiF32 E{(pg8::bf16_t*)(P.ws + WS_Y), DM, (pg8::bf16_t*)(P.ws + WS_YS)};
            pg8::gemm_phase<pg8::EpiF32, pg8::MixedOrder, true, true>(P.lds + RING_OFF, g, S, E, P.tid);
        }
        if (IN(pb + 7)) SEAM(pb + 7);
        STAMP(pb + 8);
        if (IN(pb + 8)) { if (PON(8)) { Frame P = phase_frame(F); thin_phase<true, true, false>(P, l, 1, 1.0f, l, 2, l == DEPTH - 1 ? -1 : S_OUT); } SEAM(pb + 8); }
        STAMP(pb + 9);
        if (IN(pb + 9) && PON(9)) {
            Frame P = phase_frame(F); unsigned char* wl = P.ws + WS_W + (size_t)l * WL_STRIDE;
            pg8::Gemm g{(const pg8::bf16_t*)(P.ws + WS_XN), (const pg8::bf16_t*)(wl + WL_GU2), MA, 2 * FF, DM}; pg8::MixedOrder S; S.init(2 * FF, DM, 1, P.G, P.bx, l != DEPTH - 1);
            pg8::EpiSwiGLU E{(pg8::bf16_t*)(P.ws + WS_H), FF};
            pg8::gemm_phase<pg8::EpiSwiGLU, pg8::MixedOrder, true, true>(P.lds + RING_OFF, g, S, E, P.tid);
        }
        if (IN(pb + 9)) SEAM(pb + 9);
        STAMP(pb + 10);
        if (IN(pb + 10) && PON(10)) {
            Frame P = phase_frame(F); unsigned char* wl = P.ws + WS_W + (size_t)l * WL_STRIDE;
            pg8::Gemm g{(const pg8::bf16_t*)(P.ws + WS_H), (const pg8::bf16_t*)(wl + WL_D2), MA, DM, FF}; pg8::MixedOrder S; S.init(DM, FF, S_DOWN, P.G, P.bx, l != DEPTH - 1);
            pg8::EpiF32 E{(pg8::bf16_t*)(P.ws + WS_Y), DM, (pg8::bf16_t*)(P.ws + WS_YS)};
            pg8::gemm_phase<pg8::EpiF32, pg8::MixedOrder, true, true>(P.lds + RING_OFF, g, S, E, P.tid);
        }
        if (IN(pb + 10)) SEAM(pb + 10);
        STAMP(pb + 11);
        if (IN(pb + 11)) {
            if (PON(11)) { Frame P = phase_frame(F);
                if (l == DEPTH - 1) thin_phase<true, false, true>(P, l, 2, 0.5f, 0, 0, S_DOWN);
                else thin_phase<true, true, false>(P, l, 2, 0.5f, l + 1, 0, S_DOWN); }
            SEAM(pb + 11);
        }
    }
    if (STAMP_SEL >= 0) {
        STAMP(NPH);
        xcd_barrier(bar);
        if (blockIdx.x == 0 && threadIdx.x == 0) { unsigned long long tot = 0;
            if (STAMP_SEL < 2) tot = tsb[STAMP_SEL + 1] - tsb[STAMP_SEL];
            else for (int l = 0; l < DEPTH; ++l) tot += tsb[2 + 12 * l + (STAMP_SEL - 2) + 1] - tsb[2 + 12 * l + (STAMP_SEL - 2)];
            const float us = (float)tot * 0.01f; const float k = floorf(__logf(us) * (1.0f / STAMP_LNB) + STAMP_OFS);
            args.out[0] = 1000.0f * k; }
    }
#undef IN
#undef SEAM
}

extern "C" void kernel_launch(void* const* d_in, const int* in_sizes, int n_in, void* d_out, int out_size, void* d_ws, size_t ws_size, hipStream_t stream) {
    static int grid = 0;
    if (grid == 0) {
        if (n_in != 28 || in_sizes[0] != ML * DM || out_size != ML * DM || ws_size < WS_END) { fprintf(stderr, "kernel_launch: unexpected shapes (n_in %d, in0 %d, out %d, ws %zu < %zu); nothing launched\n", n_in, n_in > 0 ? in_sizes[0] : -1, out_size, ws_size, (size_t)WS_END); grid = -1; return; }
        int dev = 0, cus = 0, per_cu = 0;
        if (hipGetDevice(&dev) != hipSuccess || hipDeviceGetAttribute(&cus, hipDeviceAttributeMultiprocessorCount, dev) != hipSuccess) { grid = -1; return; }
        if (hipFuncSetAttribute((const void*)hymba_fwd, hipFuncAttributeMaxDynamicSharedMemorySize, LDS_BYTES) != hipSuccess) { fprintf(stderr, "kernel_launch: hipFuncSetAttribute failed\n"); grid = -1; return; }
        if (hipOccupancyMaxActiveBlocksPerMultiprocessor(&per_cu, (const void*)hymba_fwd, NWAVES * 64, LDS_BYTES) != hipSuccess || per_cu < 1)
            fprintf(stderr, "kernel_launch: note: occupancy query reports %d workgroups per CU\n", per_cu);
        (void)hipGetLastError();
        grid = cus;
    }
    if (grid < 0) return;
    if (hipMemsetAsync((char*)d_ws + WS_CTL, 0, CTL_ZERO_BYTES, stream) != hipSuccess) { fprintf(stderr, "kernel_launch: hipMemsetAsync failed\n"); return; }
    Args a{};
    for (int i = 0; i < 28; ++i) a.in[i] = (const float*)d_in[i];
    a.out = (float*)d_out; a.ws = (unsigned char*)d_ws;
#if MK_MULTI
    for (int p = 0; p < NPH; ++p) { a.ph_lo = p; a.ph_hi = p + 1; hipLaunchKernelGGL(hymba_fwd, dim3(grid), dim3(NWAVES * 64), LDS_BYTES, stream, a); }
#else
    a.ph_lo = 0; a.ph_hi = NPH;
    hipLaunchKernelGGL(hymba_fwd, dim3(grid), dim3(NWAVES * 64), LDS_BYTES, stream, a);
#endif
    const hipError_t le = hipPeekAtLastError();
    if (le != hipSuccess) fprintf(stderr, "kernel_launch: launch failed: %s\n", hipGetErrorName(le));
}
```

```cpp
#include <hip/hip_runtime.h>
#include <cstdio>
#include <cstdint>
namespace pg8 {
#define PG8_LAS __attribute__((address_space(3)))
typedef unsigned short bf16_t;
typedef short bf16x8 __attribute__((ext_vector_type(8)));
typedef float f32x4 __attribute__((ext_vector_type(4)));
typedef unsigned u32x4 __attribute__((ext_vector_type(4)));
constexpr int BM = 256, BK = 64, HALF = 128, HTB = HALF * BK * 2  , STAGE_BYTES = 8 * HTB, NXCD = 8, WGM = 8;

__host__ __device__ __forceinline__ int lds_byte(int r, int c) { const int st = (r >> 4) * 2 + (c >> 5), rr = r & 15, cc = c & 31, ob = rr * 64 + cc * 2; return st * 1024 + (ob ^ (((ob >> 9) & 1) << 5)); }
__host__ __device__ __forceinline__ void stage_rc(int b, int& R, int& C) { const int st = b / 1024, sb = b % 1024, swz = sb ^ (((sb >> 9) & 1) << 5); R = (st >> 1) * 16 + swz / 64; C = (st & 1) * 32 + (swz % 64) / 2; }
__host__ __device__ __forceinline__ int perm32(int rho) { const int n = rho >> 4, i = rho & 15; return 8 * (i >> 2) + 4 * n + (i & 3); }

struct Unit { int pm, pn, kt0, nt, slab; };
struct Gemm { const bf16_t* A; const bf16_t* Bt; int M, N, K; };

struct StaticOrder {
    int nM, nN, nwg, G, c, ntK;
    __host__ __device__ void init(int M, int N, int K, int G_, int c_) { nM = M / BM; nN = N / BM; nwg = nM * nN; G = G_; c = c_; ntK = K / BK; }
    __host__ __device__ bool next(int i, Unit& u) const {
        const long L = (long)i * G + c; if (L >= nwg) return false;
        int wgid = (int)L; { const int q = nwg / NXCD, r = nwg % NXCD, xcd = wgid % NXCD, off = wgid / NXCD; wgid = (xcd < r ? xcd * (q + 1) : r * (q + 1) + (xcd - r) * q) + off; }
        const int nig = WGM * nN, gid = wgid / nig, fm = gid * WGM, gsz = (nM - fm) < WGM ? (nM - fm) : WGM;
        u.pm = fm + ((wgid % nig) % gsz); u.pn = (wgid % nig) / gsz; u.kt0 = 0; u.nt = ntK; u.slab = -1; return true;
    }
    __device__ __forceinline__ void a_ready(const Unit&) const {}
    __device__ __forceinline__ void done(const Unit&) const {}
};

struct MixedOrder {
    StaticOrder so; int nLat, nCtx, S, ntS;
    __host__ __device__ void init(int N, int K, int S_, int G_, int c_, bool ctx_on = true) { so.init(32 * BM, N, K, G_, c_); nLat = so.nwg; S = S_; nCtx = ctx_on ? 2 * so.nN * S_ : 0; ntS = K / BK / S_; }
    __host__ __device__ bool next(int i, Unit& u) const {
        if (so.next(i, u)) return true;
        const long j = (long)i * so.G + so.c - nLat; if (j >= nCtx) return false;
        const int s = (int)j % S, rest = (int)j / S; u.pm = 32 + (rest & 1); u.pn = rest >> 1; u.kt0 = s * ntS; u.nt = ntS; u.slab = S > 1 ? s : -1; return true;
    }
    __device__ __forceinline__ void a_ready(const Unit&) const {}
    __device__ __forceinline__ void done(const Unit&) const {}
};

__device__ __forceinline__ unsigned cvt_pk_bf16(float lo, float hi) { unsigned r; asm volatile("s_nop 0\n\tv_cvt_pk_bf16_f32 %0, %1, %2" : "=v"(r) : "v"(lo), "v"(hi)); return r; }
typedef float f32x2 __attribute__((ext_vector_type(2)));
__device__ __forceinline__ f32x2 gelu_pk(f32x2 v) {
    const f32x2 av = __builtin_elementwise_abs(v), d = av * 0.2316418882f + 1.0f;
    f32x2 t; t.x = __builtin_amdgcn_rcpf(d.x); t.y = __builtin_amdgcn_rcpf(d.y);
    f32x2 q = t * 0.5307027145f + (-0.7265760135f); q = q * t + 0.7107068705f; q = q * t + (-0.142248368f); q = q * t + 0.127414796f; q = q * t;
    const f32x2 s = (v * v) * (-0.72134752044f);
    f32x2 e; e.x = __builtin_amdgcn_exp2f(s.x); e.y = __builtin_amdgcn_exp2f(s.y);
    const f32x2 m = v * (q * e), r = v - m;
    f32x2 o; o.x = v.x < 0.f ? m.x : r.x; o.y = v.y < 0.f ? m.y : r.y; return o;
}

__device__ __forceinline__ float fast_silu(float g) { return g * __builtin_amdgcn_rcpf(1.0f + __builtin_amdgcn_exp2f(-1.4426950408889634f * g)); }
struct EpiNone { static constexpr bool PERM = true, AFTER_DRAIN = false;
    __device__ __forceinline__ void operator()(const f32x4 (&acc)[2][2][4][2], const Unit& u, int wr, int wc, int fr, int fq) const { asm volatile("" :: "v"(acc[0][0][0][0][0]), "v"(acc[1][1][3][1][3])); } };
struct EpiSwiGLU {
    static constexpr bool PERM = true, AFTER_DRAIN = false;
    bf16_t* O; int ldh;
    __device__ __forceinline__ void operator()(const f32x4 (&acc)[2][2][4][2], const Unit& u, int wr, int wc, int fr, int fq) const {
        const int row0 = u.pm * BM + wr * 64 + fr, col0 = u.pn * HALF + wc * 32 + 8 * fq;
#pragma unroll
        for (int ai = 0; ai < 2; ++ai)
#pragma unroll
            for (int m = 0; m < 4; ++m) {
                bf16_t* rowp = O + (size_t)(row0 + ai * HALF + m * 16) * ldh + col0;
                const f32x4 g0 = acc[ai][0][m][0], g1 = acc[ai][0][m][1], u0 = acc[ai][1][m][0], u1 = acc[ai][1][m][1];
                u32x4 w;
                w.x = cvt_pk_bf16(fast_silu(g0[0]) * u0[0], fast_silu(g0[1]) * u0[1]); w.y = cvt_pk_bf16(fast_silu(g0[2]) * u0[2], fast_silu(g0[3]) * u0[3]);
                w.z = cvt_pk_bf16(fast_silu(g1[0]) * u1[0], fast_silu(g1[1]) * u1[1]); w.w = cvt_pk_bf16(fast_silu(g1[2]) * u1[2], fast_silu(g1[3]) * u1[3]);
                *(u32x4*)rowp = w;
            }
    }
};
struct EpiF32 {
    static constexpr bool PERM = true, AFTER_DRAIN = false;
    bf16_t* O; int ldc; bf16_t* slabs;
    __device__ __forceinline__ void operator()(const f32x4 (&acc)[2][2][4][2], const Unit& u, int wr, int wc, int fr, int fq) const {
        int pm_ = u.pm, pn_ = u.pn, sl_ = u.slab; asm volatile("" : "+s"(pm_), "+s"(pn_), "+s"(sl_));
        const int col0 = pn_ * BM + wc * 32 + 8 * fq;
        bf16_t* rb = (sl_ >= 0 ? slabs + (size_t)((pm_ - 32 + 2 * sl_) * BM) * ldc : O + (size_t)(pm_ * BM) * ldc) + (size_t)(wr * 64 + fr) * ldc + col0;
#pragma unroll
        for (int ai = 0; ai < 2; ++ai)
#pragma unroll
            for (int m = 0; m < 4; ++m) { bf16_t* rowp = rb + (size_t)(ai * HALF + m * 16) * ldc;
#pragma unroll
                for (int bj = 0; bj < 2; ++bj) { const f32x4 v0 = acc[ai][bj][m][0], v1 = acc[ai][bj][m][1];
                    u32x4 w; w.x = cvt_pk_bf16(v0[0], v0[1]); w.y = cvt_pk_bf16(v0[2], v0[3]); w.z = cvt_pk_bf16(v1[0], v1[1]); w.w = cvt_pk_bf16(v1[2], v1[3]);
                    *(u32x4*)(rowp + bj * HALF) = w; } }
    }
};
constexpr size_t WSO_MiB = 1u << 20, WSO_ZS = 1209 * WSO_MiB, WSO_ROPE = 2 * WSO_MiB, WSO_AU = 408 * WSO_MiB, WSO_QB = 425 * WSO_MiB, WSO_KB = 442 * WSO_MiB, WSO_VTL = 447 * WSO_MiB, WSO_VTC = 451 * WSO_MiB, WSO_HZL = 452 * WSO_MiB, WSO_HZC = 500 * WSO_MiB;
struct EpiWin {
    static constexpr bool PERM = true, AFTER_DRAIN = false;
    unsigned char* ws; float qscale;
    __device__ __forceinline__ void store_slab(const f32x4 (&acc)[2][2][4][2], int pm, int pn, int slab, int wr, int wc, int fr, int fq) const {
        bf16_t* zs = (bf16_t*)(ws + WSO_ZS) + ((size_t)slab * 512 + (pm - 32) * BM + wr * 64 + fr) * 4096 + pn * BM + wc * 32 + 8 * fq;
#pragma unroll
        for (int ai = 0; ai < 2; ++ai)
#pragma unroll
            for (int m = 0; m < 4; ++m) { bf16_t* rowp = zs + (size_t)(ai * HALF + m * 16) * 4096;
#pragma unroll
                for (int bj = 0; bj < 2; ++bj) { const f32x4 v0 = acc[ai][bj][m][0], v1 = acc[ai][bj][m][1];
                    u32x4 w; w.x = cvt_pk_bf16(v0[0], v0[1]); w.y = cvt_pk_bf16(v0[2], v0[3]); w.z = cvt_pk_bf16(v1[0], v1[1]); w.w = cvt_pk_bf16(v1[2], v1[3]);
                    *(u32x4*)(rowp + bj * HALF) = w; } }
    }
    __device__ __forceinline__ void operator()(const f32x4 (&acc)[2][2][4][2], const Unit& u, int wr, int wc, int fr, int fq) const {
        int pm_ = u.pm, pn_ = u.pn, sl_ = u.slab; asm volatile("" : "+s"(pm_), "+s"(pn_), "+s"(sl_));
        if (sl_ >= 0) { store_slab(acc, pm_, pn_, sl_, wr, wc, fr, fq); return; }
        finish<2, 4>(acc, pm_ * BM, pm_, pn_, wr, wc, fr, fq);
    }
    template <int NAI, int NM> __device__ __forceinline__ void finish(const f32x4 (&acc)[NAI][2][NM][2], int rbase, int pm_, int pn_, int wr, int wc, int fr_in, int fq_in) const {
        int fr = fr_in, fq = fq_in; asm volatile("" : "+v"(fr), "+v"(fq));
        const int row0 = rbase + wr * 64 + fr; const int pn = pn_; const bool lat = pm_ < 32;
        bf16_t* AU = (bf16_t*)(ws + WSO_AU); bf16_t* QB = (bf16_t*)(ws + WSO_QB); bf16_t* KB = (bf16_t*)(ws + WSO_KB); bf16_t* VTl = (bf16_t*)(ws + WSO_VTL); bf16_t* VTc = (bf16_t*)(ws + WSO_VTC);
        float* HZl = (float*)(ws + WSO_HZL); float* HZc = (float*)(ws + WSO_HZC); const float* ropeC = (const float*)(ws + WSO_ROPE); const float* ropeS = ropeC + 2048;
#ifndef EWM
#define EWM 15
#endif
        if (pn < 4) { if (EWM & 1) {
            const int col0 = pn * BM + wc * 32 + 8 * fq;
#pragma unroll
            for (int ai = 0; ai < NAI; ++ai)
#pragma unroll
                for (int m = 0; m < NM; ++m) { bf16_t* rowp = AU + (size_t)(row0 + ai * HALF + m * 16) * 1024 + col0;
#pragma unroll
                    for (int bj = 0; bj < 2; ++bj) { const f32x4 v0 = acc[ai][bj][m][0], v1 = acc[ai][bj][m][1];
                        const f32x2 a = gelu_pk((f32x2){v0[0], v0[1]}), b = gelu_pk((f32x2){v0[2], v0[3]}), c = gelu_pk((f32x2){v1[0], v1[1]}), d = gelu_pk((f32x2){v1[2], v1[3]});
                        u32x4 w; w.x = cvt_pk_bf16(a.x, a.y); w.y = cvt_pk_bf16(b.x, b.y); w.z = cvt_pk_bf16(c.x, c.y); w.w = cvt_pk_bf16(d.x, d.y);
                        *(u32x4*)(rowp + bj * HALF) = w; } } }
        } else if (pn < 9) { if (EWM & 2) {
            const bool isq = pn < 8; const int head = isq ? 2 * (pn - 4) + (wc >> 1) : (wc >> 1); const int e0 = 32 * (wc & 1) + 8 * fq; const int fi = 8 * fq;
            bf16_t* base = isq ? QB : KB; const int ld = isq ? 1024 : 256; const float sc = isq ? qscale : 1.0f;
#pragma unroll
            for (int ai = 0; ai < NAI; ++ai)
#pragma unroll
                for (int m = 0; m < NM; ++m) { const int r = row0 + ai * HALF + m * 16; bf16_t* rowp = base + (size_t)r * ld + head * 128 + e0;
                    f32x4 x1a = acc[ai][0][m][0], x1b = acc[ai][0][m][1], x2a = acc[ai][1][m][0], x2b = acc[ai][1][m][1];
                    if (lat) { const int pos = r & 4095; const int a = (wc & 1) ? (pos & 63) : (pos >> 6);
                        const f32x4 c0 = *(const f32x4*)(ropeC + a * 32 + fi), c1 = *(const f32x4*)(ropeC + a * 32 + fi + 4), s0 = *(const f32x4*)(ropeS + a * 32 + fi), s1 = *(const f32x4*)(ropeS + a * 32 + fi + 4);
                        const f32x4 o1a = x1a * c0 - x2a * s0, o2a = x2a * c0 + x1a * s0, o1b = x1b * c1 - x2b * s1, o2b = x2b * c1 + x1b * s1;
                        x1a = o1a; x2a = o2a; x1b = o1b; x2b = o2b; }
                    x1a = x1a * sc; x1b = x1b * sc; x2a = x2a * sc; x2b = x2b * sc;
                    u32x4 w1, w2; w1.x = cvt_pk_bf16(x1a[0], x1a[1]); w1.y = cvt_pk_bf16(x1a[2], x1a[3]); w1.z = cvt_pk_bf16(x1b[0], x1b[1]); w1.w = cvt_pk_bf16(x1b[2], x1b[3]);
                    w2.x = cvt_pk_bf16(x2a[0], x2a[1]); w2.y = cvt_pk_bf16(x2a[2], x2a[3]); w2.z = cvt_pk_bf16(x2b[0], x2b[1]); w2.w = cvt_pk_bf16(x2b[2], x2b[3]);
                    *(u32x4*)rowp = w1; *(u32x4*)(rowp + 64) = w2; asm volatile("" ::: "memory"); } }
        } else if (pn == 9) { if (EWM & 4) {
            typedef __attribute__((address_space(1))) bf16_t gbf;
            gbf* vb = (gbf*)(lat ? VTl : VTc); const unsigned ldp = lat ? 4096u : 256u;
#pragma unroll
            for (int ai = 0; ai < NAI; ++ai)
#pragma unroll
                for (int m = 0; m < NM; ++m) { const int r = row0 + ai * HALF + m * 16;
                    const unsigned rb = lat ? (unsigned)(r >> 12) * (256u * 4096u) + (unsigned)(r & 4095) : (unsigned)((r - 8192) >> 8) * (256u * 256u) + (unsigned)((r - 8192) & 255);
#pragma unroll
                    for (int bj = 0; bj < 2; ++bj)
#pragma unroll
                        for (int n = 0; n < 2; ++n) { const f32x4 v = acc[ai][bj][m][n]; const unsigned d0 = (unsigned)(bj * 128 + wc * 32 + 8 * fq + 4 * n);
                            const unsigned p0 = cvt_pk_bf16(v[0], v[1]), p1 = cvt_pk_bf16(v[2], v[3]); const unsigned o = rb + d0 * ldp;
                            vb[o] = (bf16_t)(p0 & 0xffffu); vb[o + ldp] = (bf16_t)(p0 >> 16); vb[o + 2u * ldp] = (bf16_t)(p1 & 0xffffu); vb[o + 3u * ldp] = (bf16_t)(p1 >> 16);
                            asm volatile("" ::: "memory"); } }
        } }
        else { if (EWM & 8) {
            typedef __attribute__((address_space(1))) float gfl;
            gfl* hb = (gfl*)(lat ? HZl : HZc); const unsigned ldp = lat ? 4096u : 256u;
            const unsigned cc0 = (unsigned)((pn - 10) * BM + wc * 32 + 8 * fq);
#pragma unroll
            for (int ai = 0; ai < NAI; ++ai)
#pragma unroll
                for (int m = 0; m < NM; ++m) { const int r = row0 + ai * HALF + m * 16;
                    const unsigned rb = lat ? (unsigned)(r >> 12) * (1536u * 4096u) + (unsigned)(r & 4095) : (unsigned)((r - 8192) >> 8) * (1536u * 256u) + (unsigned)((r - 8192) & 255);
#pragma unroll
                    for (int bj = 0; bj < 2; ++bj)
#pragma unroll
                        for (int n = 0; n < 2; ++n) { const f32x4 v = acc[ai][bj][m][n]; const unsigned o = rb + (cc0 + (unsigned)(bj * 128 + 4 * n)) * ldp;
                            hb[o] = v[0]; hb[o + ldp] = v[1]; hb[o + 2u * ldp] = v[2]; hb[o + 3u * ldp] = v[3];
                            asm volatile("" ::: "memory"); } }
        } }
    }
};
template <class Epi, class Sched, bool ALIGN_EPI = false, bool SP2 = false>
__device__ __forceinline__ void gemm_phase(PG8_LAS unsigned char* lds, const Gemm g, const Sched& S, const Epi& E, const int tid) {
    const int wid = __builtin_amdgcn_readfirstlane(tid >> 6), lane = tid & 63, wr = wid >> 2, wc = wid & 3, fr = lane & 15, fq = lane >> 4;
    const int K = g.K;
    unsigned voffA[2], voffB[2];
#pragma unroll
    for (int i = 0; i < 2; ++i) { int R, C; stage_rc(tid * 16 + i * 8192, R, C); const int Rb = Epi::PERM ? ((R & ~31) + perm32(R & 31)) : R;
        voffA[i] = (unsigned)(R * K + C) * 2u; voffB[i] = (unsigned)(Rb * K + C) * 2u; }
    const size_t kstep = (size_t)(BK * 2);
    const size_t hstep = (size_t)HALF * K * 2;
    const size_t tstep = 2 * hstep;
    const unsigned ldsw = (unsigned)wid * 1024u;
    const int aoff = lds_byte(wr * 64 + fr, fq * 8), boff = lds_byte(wc * 32 + fr, fq * 8);
#define PG8_SA(b, h) (((b) * 2 + (h)) * HTB)
#define PG8_SB(b, h) ((4 + (b) * 2 + (h)) * HTB)
#define PG8_STAGE(bufoff, gbase, voff) do { _Pragma("unroll") for (int _i = 0; _i < 2; ++_i) \
        __builtin_amdgcn_global_load_lds((const unsigned*)((const char*)(gbase) + (voff)[_i]), (PG8_LAS unsigned*)(lds + (bufoff) + ldsw + _i * 8192), 16, 0, 0); } while (0)
#define PG8_LDA(dst, b, h) do { _Pragma("unroll") for (int m = 0; m < 4; ++m) _Pragma("unroll") for (int k = 0; k < 2; ++k) dst[m][k] = *(const PG8_LAS bf16x8*)(lds + PG8_SA(b, h) + aoff + m * 2048 + k * 1024); } while (0)
#define PG8_LDB(dst, b, h) do { _Pragma("unroll") for (int n = 0; n < 2; ++n) _Pragma("unroll") for (int k = 0; k < 2; ++k) dst[n][k] = *(const PG8_LAS bf16x8*)(lds + PG8_SB(b, h) + boff + n * 2048 + k * 1024); } while (0)
#define PG8_MMA(ai, bj, At, Bt) do { __builtin_amdgcn_s_setprio(1); _Pragma("unroll") for (int m = 0; m < 4; ++m) _Pragma("unroll") for (int n = 0; n < 2; ++n) _Pragma("unroll") for (int k = 0; k < 2; ++k) \
        acc[ai][bj][m][n] = __builtin_amdgcn_mfma_f32_16x16x32_bf16(Bt[n][k], At[m][k], acc[ai][bj][m][n], 0, 0, 0); __builtin_amdgcn_s_setprio(0); } while (0)
#define PG8_WAIT_V(n) asm volatile("s_waitcnt vmcnt(" #n ")" ::: "memory")
#define PG8_WAIT_L(n) asm volatile("s_waitcnt lgkmcnt(" #n ")" ::: "memory")
#define PG8_BAR __builtin_amdgcn_s_barrier()
#define PG8_SCHED __builtin_amdgcn_sched_barrier(0)
    Unit cur, nxt; int ui = 0;
    if (!S.next(0, cur)) return;
    f32x4 acc[2][2][4][2];
#pragma unroll
    for (int a = 0; a < 2; ++a)
#pragma unroll
        for (int b = 0; b < 2; ++b)
#pragma unroll
            for (int m = 0; m < 4; ++m)
#pragma unroll
                for (int n = 0; n < 2; ++n) acc[a][b][m][n] = (f32x4){0.f, 0.f, 0.f, 0.f};
    bf16x8 At[4][2], B0[2][2], B1[2][2];
    const char* cA = (const char*)g.A + (size_t)cur.pm * tstep + (size_t)cur.kt0 * kstep; const char* cB = (const char*)g.Bt + (size_t)cur.pn * tstep + (size_t)cur.kt0 * kstep;
    S.a_ready(cur);
    if constexpr (SP2) {
        PG8_STAGE(PG8_SB(0, 0), cB, voffB); PG8_STAGE(PG8_SB(0, 1), cB + hstep, voffB); PG8_STAGE(PG8_SA(0, 0), cA, voffA); PG8_STAGE(PG8_SA(0, 1), cA + hstep, voffA);
        if (wr == 1) PG8_BAR;
        PG8_WAIT_V(2); PG8_BAR;
        PG8_STAGE(PG8_SB(1, 0), cB + kstep, voffB); PG8_STAGE(PG8_SA(1, 0), cA + kstep, voffA); PG8_STAGE(PG8_SB(1, 1), cB + hstep + kstep, voffB);
        PG8_WAIT_V(6); PG8_BAR;
    } else {
        PG8_STAGE(PG8_SB(0, 0), cB, voffB); PG8_STAGE(PG8_SA(0, 0), cA, voffA); PG8_STAGE(PG8_SB(0, 1), cB + hstep, voffB); PG8_STAGE(PG8_SA(0, 1), cA + hstep, voffA);
        if (wr == 1) PG8_BAR;
        PG8_WAIT_V(4); PG8_BAR;
        PG8_STAGE(PG8_SB(1, 0), cB + kstep, voffB); PG8_STAGE(PG8_SA(1, 0), cA + kstep, voffA); PG8_STAGE(PG8_SB(1, 1), cB + hstep + kstep, voffB);
        PG8_WAIT_V(6); PG8_BAR;
    }
    for (;;) {
        const bool has_next = S.next(ui + 1, nxt);
        const char* nA = has_next ? (const char*)g.A + (size_t)nxt.pm * tstep + (size_t)nxt.kt0 * kstep : cA; const char* nB = has_next ? (const char*)g.Bt + (size_t)nxt.pn * tstep + (size_t)nxt.kt0 * kstep : cB;
        const int nt = cur.nt;
        for (int t = 0; t < nt; t += 2) {
            const bool last = (t == nt - 2);
            const char* a1 = cA + (size_t)(t + 1) * kstep;
            const char* a2 = last ? nA : cA + (size_t)(t + 2) * kstep; const char* b2 = last ? nB : cB + (size_t)(t + 2) * kstep;
            const char* a3 = a2 + kstep; const char* b3 = b2 + kstep;
            if (last && has_next) S.a_ready(nxt);
            if constexpr (SP2) {
            PG8_LDB(B0, 0, 0); PG8_LDB(B1, 0, 1); PG8_SCHED; PG8_LDA(At, 0, 0); PG8_STAGE(PG8_SA(1, 1), a1 + hstep, voffA);
            PG8_WAIT_V(8); PG8_WAIT_L(0); PG8_BAR; PG8_MMA(0, 0, At, B0); PG8_MMA(0, 1, At, B1); PG8_BAR; PG8_SCHED;
            PG8_LDA(At, 0, 1); PG8_STAGE(PG8_SB(0, 0), b2, voffB); PG8_STAGE(PG8_SB(0, 1), b2 + hstep, voffB); PG8_STAGE(PG8_SA(0, 0), a2, voffA);
            PG8_WAIT_V(8); PG8_WAIT_L(0); PG8_BAR; PG8_MMA(1, 0, At, B0); PG8_MMA(1, 1, At, B1); PG8_BAR; PG8_SCHED;
            PG8_LDB(B0, 1, 0); PG8_LDB(B1, 1, 1); PG8_SCHED; PG8_LDA(At, 1, 0); PG8_STAGE(PG8_SA(0, 1), a2 + hstep, voffA);
            PG8_WAIT_V(8); PG8_WAIT_L(0); PG8_BAR; PG8_MMA(0, 0, At, B0); PG8_MMA(0, 1, At, B1); PG8_BAR; PG8_SCHED;
            PG8_LDA(At, 1, 1); PG8_STAGE(PG8_SB(1, 0), b3, voffB); PG8_STAGE(PG8_SB(1, 1), b3 + hstep, voffB); PG8_STAGE(PG8_SA(1, 0), a3, voffA);
            PG8_WAIT_V(8); PG8_WAIT_L(0); PG8_BAR; PG8_MMA(1, 0, At, B0); PG8_MMA(1, 1, At, B1); PG8_BAR; PG8_SCHED;
            } else {
            PG8_LDB(B0, 0, 0); PG8_SCHED; PG8_LDA(At, 0, 0); PG8_STAGE(PG8_SA(1, 1), a1 + hstep, voffA);
            PG8_WAIT_L(8); PG8_BAR; PG8_WAIT_L(0); PG8_MMA(0, 0, At, B0); PG8_BAR; PG8_SCHED;
            PG8_LDB(B1, 0, 1); PG8_STAGE(PG8_SB(0, 0), b2, voffB);
            PG8_BAR; PG8_WAIT_L(0); PG8_MMA(0, 1, At, B1); PG8_BAR;
            PG8_LDA(At, 0, 1); PG8_STAGE(PG8_SA(0, 0), a2, voffA);
            PG8_BAR; PG8_WAIT_L(0); PG8_MMA(1, 0, At, B0); PG8_BAR; PG8_SCHED;
            PG8_STAGE(PG8_SB(0, 1), b2 + hstep, voffB);
            PG8_WAIT_V(6); PG8_BAR; PG8_MMA(1, 1, At, B1); PG8_BAR;
            PG8_LDB(B0, 1, 0); PG8_SCHED; PG8_LDA(At, 1, 0); PG8_STAGE(PG8_SA(0, 1), a2 + hstep, voffA);
            PG8_WAIT_L(8); PG8_BAR; PG8_WAIT_L(0); PG8_MMA(0, 0, At, B0); PG8_BAR; PG8_SCHED;
            PG8_LDB(B1, 1, 1); PG8_STAGE(PG8_SB(1, 0), b3, voffB);
            PG8_BAR; PG8_WAIT_L(0); PG8_MMA(0, 1, At, B1); PG8_BAR;
            PG8_LDA(At, 1, 1); PG8_STAGE(PG8_SA(1, 0), a3, voffA);
            PG8_BAR; PG8_WAIT_L(0); PG8_MMA(1, 0, At, B0); PG8_BAR; PG8_SCHED;
            PG8_STAGE(PG8_SB(1, 1), b3 + hstep, voffB);
            PG8_WAIT_V(6); PG8_BAR; PG8_MMA(1, 1, At, B1); PG8_BAR;
            }
        }
        if constexpr (ALIGN_EPI) { if (wr == 0) PG8_BAR; }
        if constexpr (!Epi::AFTER_DRAIN) { E(acc, cur, wr, wc, fr, fq); S.done(cur); }
        if (!has_next) break;
#pragma unroll
        for (int a = 0; a < 2; ++a)
#pragma unroll
            for (int b = 0; b < 2; ++b)
#pragma unroll
                for (int m = 0; m < 4; ++m)
#pragma unroll
                    for (int n = 0; n < 2; ++n) acc[a][b][m][n] = (f32x4){0.f, 0.f, 0.f, 0.f};
        cur = nxt; cA = nA; cB = nB; ++ui;
        if constexpr (ALIGN_EPI) { if (wr == 1) PG8_BAR; }
    }
    PG8_WAIT_V(0);
    if constexpr (!ALIGN_EPI) { if (wr == 0) PG8_BAR; }
    PG8_BAR;
    if constexpr (Epi::AFTER_DRAIN) { E.fused(acc, cur, wr, wc, fr, fq, lds, wid, lane); S.done(cur); }
#undef PG8_SA
#undef PG8_SB
#undef PG8_STAGE
#undef PG8_LDA
#undef PG8_LDB
#undef PG8_MMA
#undef PG8_WAIT_V
#undef PG8_WAIT_L
#undef PG8_BAR
#undef PG8_SCHED
}
}
constexpr int NWAVES = 8;
constexpr int DM = 2048, BATCH = 2, SEQ = 4096, DEPTH = 4, CTXL = 256, FF = 5632, HD = 128, NMOD = 9;
constexpr int ML = BATCH * SEQ, MC = BATCH * CTXL, MA = ML + MC;
constexpr int INC = 4096, DMIX = 2048, SGW = 512, HYW = 512;
constexpr int A_END = 1024, Q_END = 2048, K_END = 2304, V_END = 2560;
constexpr float NORM_EPS = 1e-6f;
constexpr float QSCALE = 0.08838834764831845f * 1.4426950408889634f;
constexpr float LOG2E = 1.4426950408889634f;
#ifndef MK_MULTI
#define MK_MULTI 0
#endif

constexpr size_t MiB = 1u << 20;
constexpr size_t WS_CTL = 0, CTL_ZERO_BYTES = 1 * MiB;
constexpr size_t WS_MOD = 1 * MiB;
constexpr size_t WS_ROPE = 2 * MiB;
constexpr size_t WS_KFS = 2 * MiB + 65536;
constexpr size_t WS_HD2 = 3 * MiB;
constexpr size_t WS_KFL = 8 * MiB;
constexpr size_t WS_KFC = 136 * MiB;
constexpr size_t WS_X = 144 * MiB;
constexpr size_t WS_XLO = WS_X + 36 * MiB;
constexpr size_t WS_XN = 212 * MiB;
constexpr size_t WS_H = 246 * MiB;
constexpr size_t WS_Y = 340 * MiB;
constexpr size_t WS_AU = 408 * MiB;
constexpr size_t WS_QB = 425 * MiB;
constexpr size_t WS_KB = 442 * MiB;
constexpr size_t WS_VTL = 447 * MiB;
constexpr size_t WS_VTC = 451 * MiB;
constexpr size_t WS_HZL = 452 * MiB;
constexpr size_t WS_HZC = 500 * MiB;
constexpr size_t WS_MIX = 503 * MiB;
constexpr size_t WS_W = 537 * MiB;
constexpr size_t WL_GU1 = 0, WL_D1 = 44 * MiB, WL_IN = 66 * MiB, WL_OUT = 82 * MiB, WL_GU2 = 90 * MiB, WL_D2 = 134 * MiB, WL_STRIDE = 156 * MiB;
constexpr size_t WS_YS = WS_W + DEPTH * WL_STRIDE;
constexpr size_t WS_ZS = WS_YS + 48 * MiB;
constexpr size_t WS_COTL = WS_ZS + 64 * MiB;
constexpr size_t WS_COTC = WS_COTL + 8 * MiB;
constexpr size_t WS_END = WS_COTC + 1 * MiB;
constexpr int S_DOWN = 11, S_OUT = 4, S_IN = 4;
constexpr int CW_TMO = 0, CW_CODE = 1;
constexpr int CW_BAR = 4096;
constexpr int CW_Q = 16384;
static_assert((CW_Q + 32 * 64) * 4 <= (int)CTL_ZERO_BYTES, "CTL words inside the memset region");

constexpr int RING_OFF = 0, RING_BYTES = 139264;
constexpr int LDSCTL_OFF = RING_BYTES, MISC_OFF = LDSCTL_OFF + 320;
constexpr int LDS_BYTES = 147456;
static_assert(MISC_OFF + 128 <= LDS_BYTES, "LDS map");
static_assert(WS_ROPE == pg8::WSO_ROPE && WS_AU == pg8::WSO_AU && WS_QB == pg8::WSO_QB && WS_KB == pg8::WSO_KB && WS_VTL == pg8::WSO_VTL && WS_VTC == pg8::WSO_VTC && WS_HZL == pg8::WSO_HZL && WS_HZC == pg8::WSO_HZC && WS_ZS == pg8::WSO_ZS, "EpiWin offsets");
#define GAS __attribute__((address_space(1)))
#define LAS __attribute__((address_space(3)))
typedef unsigned short bf16;
typedef unsigned v4u __attribute__((ext_vector_type(4)));
typedef float f32x4 __attribute__((ext_vector_type(4)));
typedef short bf16x8 __attribute__((ext_vector_type(8)));
typedef GAS unsigned gu32;
typedef GAS unsigned long long gu64;
#define RLX_AGENT __ATOMIC_RELAXED, __HIP_MEMORY_SCOPE_AGENT
#define LDS_WAIT() asm volatile("s_waitcnt lgkmcnt(0)" ::: "memory")
#define VM_WAIT() asm volatile("s_waitcnt vmcnt(0)" ::: "memory")
__device__ __forceinline__ unsigned long long rt() { return __builtin_amdgcn_s_memrealtime(); }
__device__ __forceinline__ unsigned f2bf(float f) { unsigned u = __builtin_bit_cast(unsigned, f); return (u + 0x7fffu + ((u >> 16) & 1u)) >> 16; }
__device__ __forceinline__ unsigned pk2(float lo, float hi) { return f2bf(lo) | (f2bf(hi) << 16); }

#define XB_TMO      128
#define XB_XCNT(j)  (256  + 64 * (j))
#define XB_XSUB(j)  (1280 + 64 * (j))
#define XB_XGEN(j)  (2304 + 64 * (j))
#define XB_TOP      3328
#define XB_TOPGEN   3392
#define XCD_BAR_WORDS 3456
#define XB_SPIN_CAP (1u << 18)

__device__ __forceinline__ unsigned xb_ld(unsigned* p)              { return __hip_atomic_load(p, __ATOMIC_RELAXED, __HIP_MEMORY_SCOPE_AGENT); }
__device__ __forceinline__ unsigned xb_add(unsigned* p, unsigned v) { return __hip_atomic_fetch_add(p, v, __ATOMIC_RELAXED, __HIP_MEMORY_SCOPE_AGENT); }
__device__ __forceinline__ unsigned xb_xcc_id() { return (unsigned)__builtin_amdgcn_s_getreg((3 << 11) | 20) & 0xFu; }
#define XB_SPIN(cond, bar) do { unsigned _sp = 0; while (cond) { __builtin_amdgcn_s_sleep(1); \
    if ((++_sp & 255u) == 0u) { if (xb_ld(&(bar)[XB_TMO])) break; if (_sp > XB_SPIN_CAP) { atomicAdd(&(bar)[XB_TMO], 1u); break; } } } } while (0)

struct XcdBarrier {
    unsigned* bar; unsigned x;
    volatile LAS unsigned* st;
};

__device__ __forceinline__ XcdBarrier xcd_barrier_post(unsigned* bar, volatile LAS unsigned* st) {
    XcdBarrier b; b.bar = bar; b.x = xb_xcc_id(); b.st = st;
    if (threadIdx.x == 0) (void)xb_add(&bar[XB_XCNT(b.x)], 1u);
    return b;
}
__device__ __forceinline__ void xcd_barrier_complete(unsigned* bar, unsigned x, unsigned& nloc, unsigned& nx) {
    const unsigned G = gridDim.x * gridDim.y * gridDim.z;
    unsigned sum, cnt, mine, sp = 0u;
    for (;;) {
        sum = 0u; cnt = 0u; mine = 0u;
#pragma unroll
        for (unsigned j = 0; j < 16; ++j) { const unsigned c = xb_ld(&bar[XB_XCNT(j)]); sum += c; cnt += (c > 0u) ? 1u : 0u; mine = (j == x) ? c : mine; }
        if (sum == G) break;
        __builtin_amdgcn_s_sleep(1);
        if ((++sp & 255u) == 0u) { if (xb_ld(&bar[XB_TMO])) break; if (sp > XB_SPIN_CAP) { atomicAdd(&bar[XB_TMO], 1u); break; } }
    }
    nloc = mine > 0u ? mine : 1u; nx = cnt > 0u ? cnt : 1u;
}

__device__ __forceinline__ void xcd_barrier(const XcdBarrier& b) {
    asm volatile("s_waitcnt vmcnt(0)" ::: "memory");
    __syncthreads();
    if (threadIdx.x == 0) {
        unsigned* bar = b.bar;
        __builtin_amdgcn_s_waitcnt(0);
        unsigned nloc = b.st[0], nx = b.st[1];
        if (nloc == 0u) { xcd_barrier_complete(bar, b.x, nloc, nx); b.st[0] = nloc; b.st[1] = nx; }
        const unsigned old = xb_add(&bar[XB_XSUB(b.x)], 1u);
        const unsigned gen = old / nloc;
        if (old + 1u == (gen + 1u) * nloc) {
            __builtin_amdgcn_fence(__ATOMIC_RELEASE, "agent");
            asm volatile("s_waitcnt vmcnt(0)" ::: "memory");
            const unsigned og = xb_add(&bar[XB_TOP], 1u);
            const unsigned tg = og / nx;
            if (og + 1u == (tg + 1u) * nx) xb_add(&bar[XB_TOPGEN], 1u);
            else XB_SPIN(xb_ld(&bar[XB_TOPGEN]) == tg, bar);
            __builtin_amdgcn_fence(__ATOMIC_ACQUIRE, "agent");
            xb_add(&bar[XB_XGEN(b.x)], 1u);
            asm volatile("s_waitcnt vmcnt(0)" ::: "memory");
        } else {
            XB_SPIN(xb_ld(&bar[XB_XGEN(b.x)]) == gen, bar);
            __builtin_amdgcn_fence(__ATOMIC_ACQUIRE, "agent");
            asm volatile("s_waitcnt vmcnt(0)" ::: "memory");
        }
    }
    __syncthreads();
}

typedef float f32x2 __attribute__((ext_vector_type(2)));
typedef float f32x16 __attribute__((ext_vector_type(16)));
typedef unsigned u32x2 __attribute__((ext_vector_type(2)));
struct Frame {
    LAS unsigned char* lds;
    volatile LAS unsigned* MISC;
    gu32* ctl;
    int tid, lane, wave, G, bx;
    const float* const* in;
    float* out;
    unsigned char* ws;
};
enum InIdx { I_X = 0, I_C, I_CTX, I_CCTX, I_WADA, I_BADA, I_NORMG, I_F1G, I_F1U, I_F1D, I_WIN, I_SGUG, I_SGUW, I_SGUB, I_SINK, I_HCW, I_HCB, I_HW1, I_HB1, I_HW2, I_HB2, I_HW3, I_HFREQ, I_HSKIP, I_WOUT, I_F2G, I_F2U, I_F2D };

__device__ __forceinline__ float dpp_add(float v, float src_unused, int) { return v; }
#define WS_DPP(v, ctrl) ((v) + __builtin_bit_cast(float, __builtin_amdgcn_update_dpp(0, __builtin_bit_cast(int, (v)), (ctrl), 0xF, 0xF, true)))
__device__ __forceinline__ float wave_sum(float v) {
    v = WS_DPP(v, 0xB1);
    v = WS_DPP(v, 0x4E);
    v = WS_DPP(v, 0x124);
    v = WS_DPP(v, 0x128);
    v += __shfl_xor(v, 16); v += __shfl_xor(v, 32);
    return v;
}
__device__ __forceinline__ unsigned cvtpk(float lo, float hi) { return pg8::cvt_pk_bf16(lo, hi); }
__device__ __forceinline__ float bf_lo(unsigned w) { return __uint_as_float(w << 16); }
__device__ __forceinline__ float bf_hi(unsigned w) { return __uint_as_float(w & 0xffff0000u); }
__device__ __forceinline__ float sin_rev(float r) { r -= rintf(r); return __builtin_amdgcn_sinf(r); }
__device__ __forceinline__ float cos_rev(float r) { r -= rintf(r); return __builtin_amdgcn_cosf(r); }
__device__ __forceinline__ float sin_rad(float x) { return sin_rev(x * 0.15915494309189535f); }

__device__ __forceinline__ void p0_transpose_tile(const float* W, int K, int N, bf16* WT, int k0, int n0, int drow0, LAS float* scr, int lane) {
#pragma unroll 8
    for (int i = 0; i < 32; ++i) { const int kk = 2 * i + (lane >> 5); scr[kk * 33 + (lane & 31)] = __builtin_nontemporal_load((const GAS float*)W + (size_t)(k0 + kk) * N + n0 + (lane & 31)); }
    LDS_WAIT(); asm volatile("" ::: "memory");
    const int c = lane & 7;
#pragma unroll
    for (int j = 0; j < 4; ++j) { const int n = (lane >> 3) + 8 * j; const LAS float* s = scr + (8 * c) * 33 + n;
        v4u o; o.x = pk2(s[0 * 33], s[1 * 33]); o.y = pk2(s[2 * 33], s[3 * 33]); o.z = pk2(s[4 * 33], s[5 * 33]); o.w = pk2(s[6 * 33], s[7 * 33]);
        __builtin_nontemporal_store(o, (GAS v4u*)(WT + (size_t)(drow0 + n) * K + k0 + 8 * c)); }
    LDS_WAIT(); asm volatile("" ::: "memory");
}
__device__ __forceinline__ int win_drow(int n0) {
    if (n0 < A_END || n0 >= K_END) return n0;
    const bool isq = n0 < Q_END; const int qc = n0 - (isq ? A_END : Q_END);
    const int head = qc >> 7, qd = (qc >> 5) & 3;
    const int pn = isq ? 4 + (head >> 1) : 8;
    return pn * 256 + 128 * (qd & 1) + 64 * (head & 1) + 32 * (qd >> 1);
}
constexpr int CV_FF = (DM / 64) * (FF / 32);
constexpr int CV_IN = (DM / 64) * (INC / 32);
constexpr int CV_OUT = (DM / 64) * (DMIX / 32);
constexpr int CV_LAYER = 6 * CV_FF + CV_IN + CV_OUT;
__device__ __forceinline__ void p0_convert_item(Frame& F, int it, LAS float* scr) {
    const int l = it / CV_LAYER; int r = it % CV_LAYER;
    unsigned char* wl = F.ws + WS_W + (size_t)l * WL_STRIDE;
    const size_t ffo = (size_t)l * DM * FF;
    if (r < 4 * CV_FF) {
        const int which = r / CV_FF; r -= which * CV_FF;
        const float* W = (which == 0 ? F.in[I_F1G] : which == 1 ? F.in[I_F1U] : which == 2 ? F.in[I_F2G] : F.in[I_F2U]) + ffo;
        bf16* WT = (bf16*)(wl + (which < 2 ? WL_GU1 : WL_GU2));
        const int nblk = FF / 32, kb = r / nblk, nb = r % nblk, n0 = 32 * nb;
        const int drow0 = 256 * (n0 >> 7) + 128 * (which & 1) + (n0 & 127);
        p0_transpose_tile(W, DM, FF, WT, 64 * kb, n0, drow0, scr, F.lane); return; }
    r -= 4 * CV_FF;
    if (r < 2 * CV_FF) {
        const int which = r / CV_FF; r -= which * CV_FF;
        const float* W = (which == 0 ? F.in[I_F1D] : F.in[I_F2D]) + ffo;
        bf16* WT = (bf16*)(wl + (which == 0 ? WL_D1 : WL_D2));
        const int nblk = DM / 32, kb = r / nblk, nb = r % nblk;
        p0_transpose_tile(W, FF, DM, WT, 64 * kb, 32 * nb, 32 * nb, scr, F.lane); return; }
    r -= 2 * CV_FF;
    if (r < CV_IN) { const float* W = F.in[I_WIN] + (size_t)l * DM * INC; const int nblk = INC / 32, kb = r / nblk, nb = r % nblk;
        p0_transpose_tile(W, DM, INC, (bf16*)(wl + WL_IN), 64 * kb, 32 * nb, win_drow(32 * nb), scr, F.lane); return; }
    r -= CV_IN;
    { const float* W = F.in[I_WOUT] + (size_t)l * DMIX * DM; const int nblk = DM / 32, kb = r / nblk, nb = r % nblk;
        p0_transpose_tile(W, DMIX, DM, (bf16*)(wl + WL_OUT), 64 * kb, 32 * nb, 32 * nb, scr, F.lane); }
}
__device__ __forceinline__ void p0_ada_item(Frame& F, int it) {
    LAS float* sv = (LAS float*)(F.lds + RING_OFF);
    LAS float* red = sv + 3 * DM;
    const int l = it >> 6, nb = it & 63;
    for (int i = F.tid; i < 3 * DM; i += NWAVES * 64) { const int r = i / DM, k = i % DM; const float c = r < 2 ? F.in[I_C][r * DM + k] : F.in[I_CCTX][k]; sv[i] = c / (1.0f + __expf(-c)); }
    __syncthreads();
    const float* W = F.in[I_WADA] + (size_t)l * DM * (NMOD * DM) + nb * 288 + 4 * F.lane;
    const bool ex = F.lane < 8;
    f32x4 a0 = {0.f, 0.f, 0.f, 0.f}, a1 = a0, a2 = a0, e0 = a0, e1 = a0, e2 = a0;
    const int kb = F.wave * 256;
#pragma unroll 4
    for (int k = 0; k < 256; ++k) { const float* wr = W + (size_t)(kb + k) * (NMOD * DM);
        const f32x4 w = __builtin_nontemporal_load((const GAS f32x4*)wr); f32x4 we = {0.f, 0.f, 0.f, 0.f}; if (ex) we = __builtin_nontemporal_load((const GAS f32x4*)(wr + 256));
        const float s0 = sv[kb + k], s1 = sv[DM + kb + k], s2 = sv[2 * DM + kb + k];
        a0 += w * s0; a1 += w * s1; a2 += w * s2; e0 += we * s0; e1 += we * s1; e2 += we * s2; }
    *(LAS f32x4*)(red + (F.wave * 3 + 0) * 288 + 4 * F.lane) = a0; *(LAS f32x4*)(red + (F.wave * 3 + 1) * 288 + 4 * F.lane) = a1; *(LAS f32x4*)(red + (F.wave * 3 + 2) * 288 + 4 * F.lane) = a2;
    if (ex) { *(LAS f32x4*)(red + (F.wave * 3 + 0) * 288 + 256 + 4 * F.lane) = e0; *(LAS f32x4*)(red + (F.wave * 3 + 1) * 288 + 256 + 4 * F.lane) = e1; *(LAS f32x4*)(red + (F.wave * 3 + 2) * 288 + 256 + 4 * F.lane) = e2; }
    __syncthreads();
    for (int i = F.tid; i < 3 * 288; i += NWAVES * 64) { const int r = i / 288, n = i % 288; float s = 0.f;
#pragma unroll
        for (int w = 0; w < 8; ++w) s += red[(w * 3 + r) * 288 + n];
        const int col = nb * 288 + n;
        ((float*)(F.ws + WS_MOD))[((size_t)l * 3 + r) * (NMOD * DM) + col] = s + F.in[I_BADA][(size_t)l * (NMOD * DM) + col]; }
    __syncthreads();
}
__device__ __forceinline__ void p0_hd2_row(Frame& F, int l, int tp) {
    const bool ctx = tp >= SEQ; const int L = ctx ? CTXL : SEQ; const int t = ctx ? tp - SEQ : tp; const int lane = F.lane;
    float feat = 0.f;
    if (lane == 0) feat = (float)t / (float)(L - 1);
    else if (lane < 33) { const int j = (lane - 1) & 15; const double band = 1e-4 + (double)j * ((15.0 - 1e-4) / 15.0); const double rev = band * (double)t / (double)L; const float fr = (float)(rev - floor(rev));
        feat = lane < 17 ? __builtin_amdgcn_cosf(fr) : -__builtin_amdgcn_sinf(fr); }
    const float* w1 = F.in[I_HW1] + (size_t)l * 33 * 64; const float* w2 = F.in[I_HW2] + (size_t)l * 64 * 64;
    const float fq = F.in[I_HFREQ][l * 64 + lane];
    float a = F.in[I_HB1][l * 64 + lane];
#pragma unroll
    for (int i = 0; i < 33; ++i) a += __shfl(feat, i) * w1[i * 64 + lane];
    const float h1 = sin_rad(fq * a);
    float b = F.in[I_HB2][l * 64 + lane];
#pragma unroll 16
    for (int i = 0; i < 64; ++i) b += __shfl(h1, i) * w2[i * 64 + lane];
    ((float*)(F.ws + WS_HD2))[((size_t)l * (SEQ + CTXL) + tp) * 64 + lane] = sin_rad(fq * b);
}
__device__ __forceinline__ void p0_rope_entry(Frame& F, int idx) {
    const int a = idx >> 5, i = idx & 31;
    const double inv = exp2(-(double)i * (13.287712379549449 / 32.0));
    double x = (double)a * inv; const double k = rint(x * 0.6366197723675814);
    x = x - k * 1.5707963267948966 - k * 6.123233995736766e-17;
    const double x2 = x * x;
    double s = x * (1.0 + x2 * (-1.0 / 6 + x2 * (1.0 / 120 + x2 * (-1.0 / 5040 + x2 * (1.0 / 362880 + x2 * (-1.0 / 39916800 + x2 * (1.0 / 6227020800.0)))))));
    double c = 1.0 + x2 * (-0.5 + x2 * (1.0 / 24 + x2 * (-1.0 / 720 + x2 * (1.0 / 40320 + x2 * (-1.0 / 3628800 + x2 * (1.0 / 479001600.0 + x2 * (-1.0 / 87178291200.0)))))));
    const int q = ((int)k) & 3; double cs, sn;
    if (q == 0) { cs = c; sn = s; } else if (q == 1) { cs = -s; sn = c; } else if (q == 2) { cs = -c; sn = -s; } else { cs = s; sn = -c; }
    float* rp = (float*)(F.ws + WS_ROPE); rp[idx] = (float)cs; rp[2048 + idx] = (float)sn;
}
__device__ __forceinline__ void p0_prologue(Frame& F) {
#ifndef P0M
#define P0M 15
#endif
    if (P0M & 1) for (int it = F.bx; it < DEPTH * 64; it += F.G) p0_ada_item(F, it);
    const int gw = F.bx * NWAVES + F.wave, NGW = F.G * NWAVES;
    if (P0M & 2) for (int it = gw; it < DEPTH * (SEQ + CTXL); it += NGW) p0_hd2_row(F, it / (SEQ + CTXL), it % (SEQ + CTXL));
    if (P0M & 4) if (F.bx == F.G - 1) for (int i = F.tid; i < 2048; i += NWAVES * 64) p0_rope_entry(F, i);
}
__device__ __forceinline__ void p0_convert_all(Frame& F) {
    const int gw = F.bx * NWAVES + F.wave, NGW = F.G * NWAVES;
    LAS float* scr = (LAS float*)(F.lds + RING_OFF + F.wave * 16384);
    for (int it = gw; it < DEPTH * CV_LAYER; it += NGW) p0_convert_item(F, it, scr);
}

__device__ __forceinline__ void p1_filter_item(Frame& F, int it) {
    const int cb = it & 63, Lsel = (it >> 6) & 1, l = it >> 7;
    const int L = Lsel ? CTXL : SEQ;
    LAS float* W3s = (LAS float*)(F.lds + RING_OFF);
    LAS float* red = W3s + 64 * 32;
    for (int i = F.tid; i < 64 * 32; i += NWAVES * 64) { const int j = i >> 5, lc = i & 31; const int o = lc >> 4, dir = (lc >> 3) & 1, ci = lc & 7;
        W3s[i] = F.in[I_HW3][((size_t)l * 64 + j) * 2048 + o * 1024 + dir * 512 + cb * 8 + ci]; }
    __syncthreads();
    float asum[16];
#pragma unroll
    for (int i = 0; i < 16; ++i) asum[i] = 0.f;
    const float* hd2 = (const float*)(F.ws + WS_HD2) + ((size_t)l * (SEQ + CTXL) + (Lsel ? SEQ : 0)) * 64;
    float* kf = Lsel ? (float*)(F.ws + WS_KFC) + ((size_t)l * 512 + cb * 8) * 2 * 512 : (float*)(F.ws + WS_KFL) + ((size_t)l * 512 + cb * 8) * 2 * 8192;
    const int N2 = 2 * L;
    const int ngrp = Lsel ? 1 : 4;
    for (int grp = 0; grp < ngrp; ++grp) {
        const int tb = F.tid + 1024 * grp;
        if (!Lsel || F.tid < 128) {
            const int tstep = Lsel ? 128 : 512;
            float acc[2][32];
#pragma unroll
            for (int k = 0; k < 2; ++k)
#pragma unroll
                for (int i = 0; i < 32; ++i) acc[k][i] = 0.f;
#pragma unroll 2
            for (int j4 = 0; j4 < 16; ++j4) {
                f32x4 hv[2];
#pragma unroll
                for (int k = 0; k < 2; ++k) hv[k] = *(const f32x4*)(hd2 + (size_t)(tb + tstep * k) * 64 + 4 * j4);
#pragma unroll
                for (int jj = 0; jj < 4; ++jj) { const LAS f32x4* wr = (const LAS f32x4*)(W3s + (j4 * 4 + jj) * 32);
#pragma unroll
                    for (int q = 0; q < 8; ++q) { const f32x4 w = wr[q];
#pragma unroll
                        for (int k = 0; k < 2; ++k) { const float h = hv[k][jj]; acc[k][4 * q + 0] += h * w[0]; acc[k][4 * q + 1] += h * w[1]; acc[k][4 * q + 2] += h * w[2]; acc[k][4 * q + 3] += h * w[3]; } } }
            }
#pragma unroll
            for (int k = 0; k < 2; ++k) { int t = tb + tstep * k; asm volatile("" : "+v"(t));
                const float tn = (float)t / (float)(L - 1);
                typedef __attribute__((address_space(1))) float gfl; gfl* kfb = (gfl*)kf;
                const unsigned of = (unsigned)t, ob = (unsigned)(N2 - t);
#pragma unroll
                for (int ci = 0; ci < 8; ++ci) { const int c = cb * 8 + ci;
                    const float delta = 15.350567286626973f - (float)c * ((15.350567286626973f - 3.0701134573253945f) / 511.0f);
                    const float dec = __expf(-tn * delta);
#pragma unroll
                    for (int o = 0; o < 2; ++o) { const float vf = acc[k][o * 16 + ci] * dec, vb = acc[k][o * 16 + 8 + ci] * dec;
                        asum[o * 8 + ci] += fabsf(vf) + fabsf(vb);
                        const unsigned base = (unsigned)(ci * 2 + o) * (unsigned)N2;
                        if (t == 0) { kfb[base] = vf + vb; kfb[base + (unsigned)L] = 0.f; } else { __builtin_nontemporal_store(vf, kfb + base + of); __builtin_nontemporal_store(vb, kfb + base + ob); } } } }
        }
    }
#pragma unroll
    for (int i = 0; i < 16; ++i) { const float s = wave_sum(asum[i]); if (F.lane == 0) red[F.wave * 16 + i] = s; }
    __syncthreads();
    if (F.tid < 16) { float s = 0.f;
#pragma unroll
        for (int w = 0; w < 8; ++w) s += red[w * 16 + F.tid];
        const int o = F.tid >> 3, ci = F.tid & 7;
        ((float*)(F.ws + WS_KFS))[(((size_t)l * 2 + Lsel) * 2 + o) * 512 + cb * 8 + ci] = 1.0f / (s + 1e-6f); }
    __syncthreads();
}

struct X24 { v4u h[4]; unsigned lo[4]; };
__device__ __forceinline__ void x24_load(const unsigned char* ws, int row, int lane, X24& p) {
    const GAS v4u* hp = (const GAS v4u*)(ws + WS_X + (size_t)row * (2 * DM)) + lane; const GAS unsigned* lp = (const GAS unsigned*)(ws + WS_XLO + (size_t)row * (DM / 2)) + lane;
#pragma unroll
    for (int q = 0; q < 4; ++q) { p.h[q] = __builtin_nontemporal_load(hp + 64 * q); p.lo[q] = __builtin_nontemporal_load(lp + 64 * q); }
}
__device__ __forceinline__ f32x4 x24_un(unsigned h0, unsigned h1, unsigned L) {
    f32x4 r; r.x = __uint_as_float((h0 << 16) | ((L & 0xfu) << 12)); r.y = __uint_as_float((h0 & 0xffff0000u) | ((L & 0xf0u) << 8));
    r.z = __uint_as_float((h1 << 16) | ((L & 0xf00u) << 4)); r.w = __uint_as_float((h1 & 0xffff0000u) | (L & 0xf000u)); return r;
}
__device__ __forceinline__ void x24_unpack(const X24& p, f32x4 (&xv)[8]) {
#pragma unroll
    for (int q = 0; q < 4; ++q) { xv[2 * q] = x24_un(p.h[q].x, p.h[q].y, p.lo[q]); xv[2 * q + 1] = x24_un(p.h[q].z, p.h[q].w, p.lo[q] >> 16); }
}
__device__ __forceinline__ void x24_pk(const f32x4 v, unsigned& h0, unsigned& h1, unsigned& L) {
    const unsigned a = __float_as_uint(v.x) + 0x800u, b = __float_as_uint(v.y) + 0x800u, c = __float_as_uint(v.z) + 0x800u, d = __float_as_uint(v.w) + 0x800u;
    h0 = (a >> 16) | (b & 0xffff0000u); h1 = (c >> 16) | (d & 0xffff0000u);
    L = ((a >> 12) & 0xfu) | ((b >> 8) & 0xf0u) | ((c >> 4) & 0xf00u) | (d & 0xf000u);
}
__device__ __forceinline__ void x24_store(unsigned char* ws, int row, int lane, const f32x4 (&xv)[8]) {
    GAS v4u* hp = (GAS v4u*)(ws + WS_X + (size_t)row * (2 * DM)) + lane; GAS unsigned* lp = (GAS unsigned*)(ws + WS_XLO + (size_t)row * (DM / 2)) + lane;
#pragma unroll
    for (int q = 0; q < 4; ++q) { unsigned h0, h1, h2, h3, l0, l1; x24_pk(xv[2 * q], h0, h1, l0); x24_pk(xv[2 * q + 1], h2, h3, l1); const v4u h = {h0, h1, h2, h3};
        __builtin_nontemporal_store(h, hp + 64 * q); __builtin_nontemporal_store(l0 | (l1 << 16), lp + 64 * q); }
}
template <int N> __device__ __forceinline__ void slab_sum(const bf16* yrow, int s, f32x4 (&yv)[8]) {
    u32x2 t[N][8];
#pragma unroll
    for (int i = 0; i < N; ++i)
#pragma unroll
        for (int j = 0; j < 8; ++j) t[i][j] = __builtin_nontemporal_load((const GAS u32x2*)(yrow + (size_t)(s + i) * (512 * DM) + 256 * j));
#pragma unroll
    for (int i = 0; i < N; ++i)
#pragma unroll
        for (int j = 0; j < 8; ++j) { const u32x2 w = t[i][j]; yv[j] += (f32x4){bf_lo(w.x), bf_hi(w.x), bf_lo(w.y), bf_hi(w.y)}; }
}
template <bool HAS_Y, bool HAS_NEXT, bool FINAL, bool LAT>
__device__ __forceinline__ void thin_row(Frame& F, int row, int l, int k, float coef, int ln, int kn, int S) {
    const int r = LAT ? (row >> 12) : 2;
    int lane_ = F.lane; asm volatile("" : "+v"(lane_)); const int lane = lane_;
    f32x4 xv[8]; X24 px;
    if (HAS_Y) x24_load(F.ws, row, lane, px);
    else { const float* xsrc = LAT ? F.in[I_X] + (size_t)row * DM : F.in[I_CTX] + (size_t)(row - ML) * DM;
#pragma unroll
        for (int j = 0; j < 8; ++j) xv[j] = __builtin_nontemporal_load((const GAS f32x4*)(xsrc + 4 * lane + 256 * j)); }
    if (HAS_Y) {
        const float* gate = (const float*)(F.ws + WS_MOD) + ((size_t)l * 3 + r) * (NMOD * DM) + (3 * k + 2) * DM;
        const float* gp = F.in[I_NORMG] + ((size_t)l * 6 + 2 * k + 1) * DM;
        f32x4 yv[8]; float ss = 0.f;
        if (LAT) {
            const bf16* yrow = (const bf16*)(F.ws + WS_Y) + (size_t)row * DM;
#pragma unroll
            for (int j = 0; j < 8; ++j) { const u32x2 w = __builtin_nontemporal_load((const GAS u32x2*)(yrow + 4 * lane + 256 * j)); yv[j] = (f32x4){bf_lo(w.x), bf_hi(w.x), bf_lo(w.y), bf_hi(w.y)}; }
        } else {
            const bf16* yrow = (const bf16*)(F.ws + WS_YS) + (size_t)(row - ML) * DM + 4 * lane;
#pragma unroll
            for (int j = 0; j < 8; ++j) yv[j] = (f32x4){0.f, 0.f, 0.f, 0.f};
            int s = 0;
            for (; s + 6 <= S; s += 6) slab_sum<6>(yrow, s, yv);
            const int rem = S - s;
            if (rem == 5) slab_sum<5>(yrow, s, yv); else if (rem == 4) slab_sum<4>(yrow, s, yv); else if (rem == 3) slab_sum<3>(yrow, s, yv); else if (rem == 2) slab_sum<2>(yrow, s, yv); else if (rem == 1) slab_sum<1>(yrow, s, yv);
        }
#pragma unroll
        for (int j = 0; j < 8; ++j) { ss += (yv[j].x * yv[j].x + yv[j].y * yv[j].y) + (yv[j].z * yv[j].z + yv[j].w * yv[j].w); }
        const float rstd = coef * rsqrtf(wave_sum(ss) * (1.0f / DM) + NORM_EPS);
        x24_unpack(px, xv);
#pragma unroll
        for (int j = 0; j < 8; ++j) { const f32x4 g = *(const f32x4*)(gate + 4 * lane + 256 * j), q = *(const f32x4*)(gp + 4 * lane + 256 * j); xv[j] += (yv[j] * rstd) * (g * q); }
    }
    if (FINAL) { if (LAT) {
#pragma unroll
        for (int j = 0; j < 8; ++j) *(GAS f32x4*)(F.out + (size_t)row * DM + 4 * lane + 256 * j) = xv[j]; }
    } else x24_store(F.ws, row, lane, xv);
    if (HAS_NEXT) {
        float ss = 0.f;
#pragma unroll
        for (int j = 0; j < 8; ++j) ss += (xv[j].x * xv[j].x + xv[j].y * xv[j].y) + (xv[j].z * xv[j].z + xv[j].w * xv[j].w);
        const float rstd = rsqrtf(wave_sum(ss) * (1.0f / DM) + NORM_EPS);
        const float* mod = (const float*)(F.ws + WS_MOD) + ((size_t)ln * 3 + r) * (NMOD * DM) + (3 * kn) * DM;
        const float* gq = F.in[I_NORMG] + ((size_t)ln * 6 + 2 * kn) * DM;
        bf16* xn = (bf16*)(F.ws + WS_XN) + (size_t)row * DM;
#pragma unroll
        for (int j = 0; j < 8; ++j) { const f32x4 g = *(const f32x4*)(gq + 4 * lane + 256 * j), sc = *(const f32x4*)(mod + 4 * lane + 256 * j), sh = *(const f32x4*)(mod + DM + 4 * lane + 256 * j);
            const f32x4 o = (xv[j] * rstd) * g * (sc + 1.0f) + sh;
            u32x2 w; w.x = cvtpk(o.x, o.y); w.y = cvtpk(o.z, o.w); *(GAS u32x2*)(xn + 4 * lane + 256 * j) = w; }
    }
}
template <bool HAS_Y, bool HAS_NEXT, bool FINAL>
__device__ __forceinline__ void thin_rows2(Frame& F, int rA, int rB, int l, int k, float coef, int ln, int kn) {
    const int r = rA >> 12; int lane_ = F.lane; asm volatile("" : "+v"(lane_)); const int lane = lane_;
    f32x4 xv[2][8]; X24 px[2];
    if (HAS_Y) { x24_load(F.ws, rA, lane, px[0]); x24_load(F.ws, rB, lane, px[1]); }
    else {
#pragma unroll
        for (int p = 0; p < 2; ++p)
#pragma unroll
            for (int j = 0; j < 8; ++j) xv[p][j] = __builtin_nontemporal_load((const GAS f32x4*)(F.in[I_X] + (size_t)(p ? rB : rA) * DM + 4 * lane + 256 * j));
    }
    if (HAS_Y) {
        const float* gate = (const float*)(F.ws + WS_MOD) + ((size_t)l * 3 + r) * (NMOD * DM) + (3 * k + 2) * DM;
        const float* gp = F.in[I_NORMG] + ((size_t)l * 6 + 2 * k + 1) * DM;
        u32x2 yw[2][8];
#pragma unroll
        for (int p = 0; p < 2; ++p) { const bf16* yrow = (const bf16*)(F.ws + WS_Y) + (size_t)(p ? rB : rA) * DM;
#pragma unroll
            for (int j = 0; j < 8; ++j) yw[p][j] = __builtin_nontemporal_load((const GAS u32x2*)(yrow + 4 * lane + 256 * j)); }
        f32x4 gg[8];
#pragma unroll
        for (int j = 0; j < 8; ++j) gg[j] = *(const f32x4*)(gate + 4 * lane + 256 * j) * *(const f32x4*)(gp + 4 * lane + 256 * j);
#pragma unroll
        for (int p = 0; p < 2; ++p) { float ss = 0.f; f32x4 yv[8];
#pragma unroll
            for (int j = 0; j < 8; ++j) { const u32x2 w = yw[p][j]; yv[j] = (f32x4){bf_lo(w.x), bf_hi(w.x), bf_lo(w.y), bf_hi(w.y)}; ss += (yv[j].x * yv[j].x + yv[j].y * yv[j].y) + (yv[j].z * yv[j].z + yv[j].w * yv[j].w); }
            const float rstd = coef * rsqrtf(wave_sum(ss) * (1.0f / DM) + NORM_EPS);
            x24_unpack(px[p], xv[p]);
#pragma unroll
            for (int j = 0; j < 8; ++j) xv[p][j] += (yv[j] * rstd) * gg[j]; }
    }
#pragma unroll
    for (int p = 0; p < 2; ++p) { const int row = p ? rB : rA;
        if (FINAL) {
#pragma unroll
            for (int j = 0; j < 8; ++j) *(GAS f32x4*)(F.out + (size_t)row * DM + 4 * lane + 256 * j) = xv[p][j];
        } else x24_store(F.ws, row, lane, xv[p]); }
    if (HAS_NEXT) {
        const float* mod = (const float*)(F.ws + WS_MOD) + ((size_t)ln * 3 + r) * (NMOD * DM) + (3 * kn) * DM;
        const float* gq = F.in[I_NORMG] + ((size_t)ln * 6 + 2 * kn) * DM;
        float rstd[2];
#pragma unroll
        for (int p = 0; p < 2; ++p) { float ss = 0.f;
#pragma unroll
            for (int j = 0; j < 8; ++j) ss += (xv[p][j].x * xv[p][j].x + xv[p][j].y * xv[p][j].y) + (xv[p][j].z * xv[p][j].z + xv[p][j].w * xv[p][j].w);
            rstd[p] = rsqrtf(wave_sum(ss) * (1.0f / DM) + NORM_EPS); }
#pragma unroll
        for (int j = 0; j < 8; ++j) { const f32x4 g = *(const f32x4*)(gq + 4 * lane + 256 * j), sc = *(const f32x4*)(mod + 4 * lane + 256 * j), sh = *(const f32x4*)(mod + DM + 4 * lane + 256 * j);
            const f32x4 gs = g * (sc + 1.0f);
#pragma unroll
            for (int p = 0; p < 2; ++p) { const f32x4 o = (xv[p][j] * rstd[p]) * gs + sh; bf16* xn = (bf16*)(F.ws + WS_XN) + (size_t)(p ? rB : rA) * DM;
                u32x2 w; w.x = cvtpk(o.x, o.y); w.y = cvtpk(o.z, o.w); *(GAS u32x2*)(xn + 4 * lane + 256 * j) = w; } }
    }
}
template <bool HAS_NEXT, bool FINAL>
__device__ __forceinline__ void thin_rows4(Frame& F, int gw, int NGW, float coef, const LAS float* prm) {
    int lane_ = F.lane; asm volatile("" : "+v"(lane_)); const int lane = lane_;
    X24 px[4]; u32x2 yw[4][8];
#define THIN_LD(i) do { const int row_ = gw + NGW * (i); x24_load(F.ws, row_, lane, px[i]); const bf16* yrow = (const bf16*)(F.ws + WS_Y) + (size_t)row_ * DM; \
        _Pragma("unroll") for (int j = 0; j < 8; ++j) yw[i][j] = __builtin_nontemporal_load((const GAS u32x2*)(yrow + 4 * lane + 256 * j)); } while (0)
    THIN_LD(0); THIN_LD(1); THIN_LD(2);
#pragma unroll
    for (int i = 0; i < 4; ++i) { const int row = gw + NGW * i; const int r = row >> 12;
        f32x4 xv[8], yv[8]; float ss = 0.f;
#pragma unroll
        for (int j = 0; j < 8; ++j) { const u32x2 w = yw[i][j]; yv[j] = (f32x4){bf_lo(w.x), bf_hi(w.x), bf_lo(w.y), bf_hi(w.y)}; ss += (yv[j].x * yv[j].x + yv[j].y * yv[j].y) + (yv[j].z * yv[j].z + yv[j].w * yv[j].w); }
        x24_unpack(px[i], xv);
        if (i == 0) THIN_LD(3);
        const float rstd = coef * rsqrtf(wave_sum(ss) * (1.0f / DM) + NORM_EPS);
#pragma unroll
        for (int j = 0; j < 8; ++j) { const f32x4 gg = *(const LAS f32x4*)(prm + (0 * 2 + r) * DM + 4 * lane + 256 * j); xv[j] += (yv[j] * rstd) * gg; }
        if (FINAL) {
#pragma unroll
            for (int j = 0; j < 8; ++j) *(GAS f32x4*)(F.out + (size_t)row * DM + 4 * lane + 256 * j) = xv[j];
        } else x24_store(F.ws, row, lane, xv);
        if (HAS_NEXT) { float s2 = 0.f;
#pragma unroll
            for (int j = 0; j < 8; ++j) s2 += (xv[j].x * xv[j].x + xv[j].y * xv[j].y) + (xv[j].z * xv[j].z + xv[j].w * xv[j].w);
            const float rstd2 = rsqrtf(wave_sum(s2) * (1.0f / DM) + NORM_EPS);
            bf16* xn = (bf16*)(F.ws + WS_XN) + (size_t)row * DM;
#pragma unroll
            for (int j = 0; j < 8; ++j) { const f32x4 gs = *(const LAS f32x4*)(prm + (1 * 2 + r) * DM + 4 * lane + 256 * j), sh = *(const LAS f32x4*)(prm + (2 * 2 + r) * DM + 4 * lane + 256 * j);
                const f32x4 o = (xv[j] * rstd2) * gs + sh;
                u32x2 w; w.x = cvtpk(o.x, o.y); w.y = cvtpk(o.z, o.w); *(GAS u32x2*)(xn + 4 * lane + 256 * j) = w; } }
    }
}
template <bool HAS_Y, bool HAS_NEXT, bool FINAL>
__device__ __forceinline__ void thin_phase(Frame& F, int l, int k, float coef, int ln, int kn, int S) {
    const int gw = F.bx * NWAVES + F.wave, NGW = F.G * NWAVES;
    LAS float* prm = (LAS float*)(F.lds + RING_OFF);
    const bool four = HAS_Y && !FINAL && 4 * NGW == ML;
    if (four) {
        const int t4 = 4 * F.tid;
#pragma unroll
        for (int r = 0; r < 2; ++r) {
            const float* gate = (const float*)(F.ws + WS_MOD) + ((size_t)l * 3 + r) * (NMOD * DM) + (3 * k + 2) * DM; const float* gp = F.in[I_NORMG] + ((size_t)l * 6 + 2 * k + 1) * DM;
            *(LAS f32x4*)(prm + (0 * 2 + r) * DM + t4) = *(const f32x4*)(gate + t4) * *(const f32x4*)(gp + t4);
            if (HAS_NEXT) { const float* mod = (const float*)(F.ws + WS_MOD) + ((size_t)ln * 3 + r) * (NMOD * DM) + (3 * kn) * DM; const float* gq = F.in[I_NORMG] + ((size_t)ln * 6 + 2 * kn) * DM;
                *(LAS f32x4*)(prm + (1 * 2 + r) * DM + t4) = *(const f32x4*)(gq + t4) * (*(const f32x4*)(mod + t4) + 1.0f); *(LAS f32x4*)(prm + (2 * 2 + r) * DM + t4) = *(const f32x4*)(mod + DM + t4); } }
        __syncthreads();
    }
    if (!FINAL && S >= 0) { if (F.G * 2 >= MC) { if (F.wave < 2) { const int rc = F.bx * 2 + F.wave; if (rc < MC) thin_row<HAS_Y, HAS_NEXT, FINAL, false>(F, ML + rc, l, k, coef, ln, kn, S); } }
                            else for (int row = ML + gw; row < MA; row += NGW) thin_row<HAS_Y, HAS_NEXT, FINAL, false>(F, row, l, k, coef, ln, kn, S); }
    if (four) thin_rows4<HAS_NEXT, FINAL>(F, gw, NGW, coef, prm);
    else if (2 * NGW == SEQ) { for (int row = gw; row < ML; row += 2 * NGW) thin_rows2<HAS_Y, HAS_NEXT, FINAL>(F, row, row + NGW, l, k, coef, ln, kn); }
    else for (int row = gw; row < ML; row += NGW) thin_row<HAS_Y, HAS_NEXT, FINAL, true>(F, row, l, k, coef, ln, kn, S);
}
typedef float cpx __attribute__((ext_vector_type(2)));
__device__ __forceinline__ float fadd_(float a, float b) { float r; asm("v_add_f32 %0, %1, %2" : "=v"(r) : "v"(a), "v"(b)); return r; }
__device__ __forceinline__ float fsub_(float a, float b) { float r; asm("v_sub_f32 %0, %1, %2" : "=v"(r) : "v"(a), "v"(b)); return r; }
__device__ __forceinline__ float fmul_(float a, float b) { float r; asm("v_mul_f32 %0, %1, %2" : "=v"(r) : "v"(a), "v"(b)); return r; }
__device__ __forceinline__ float ffma_(float a, float b, float c) { float r; asm("v_fma_f32 %0, %1, %2, %3" : "=v"(r) : "v"(a), "v"(b), "v"(c)); return r; }
__device__ __forceinline__ float ffnma_(float a, float b, float c) { float r; asm("v_fma_f32 %0, -%1, %2, %3" : "=v"(r) : "v"(a), "v"(b), "v"(c)); return r; }
__device__ __forceinline__ cpx cmul(cpx a, cpx b) { return cpx{ffnma_(a.y, b.y, fmul_(a.x, b.x)), ffma_(a.y, b.x, fmul_(a.x, b.y))}; }
__device__ __forceinline__ cpx cadd(cpx a, cpx b) { return cpx{fadd_(a.x, b.x), fadd_(a.y, b.y)}; }
__device__ __forceinline__ cpx csub(cpx a, cpx b) { return cpx{fsub_(a.x, b.x), fsub_(a.y, b.y)}; }
template <bool INV> __device__ __forceinline__ cpx mul_mi(cpx a) { return INV ? cpx{-a.y, a.x} : cpx{a.y, -a.x}; }
template <bool INV> __device__ __forceinline__ cpx twid(float frac) { float c = __builtin_amdgcn_cosf(frac), s = __builtin_amdgcn_sinf(frac); asm volatile("s_nop 1" : "+v"(c), "+v"(s)); return cpx{c, INV ? s : -s}; }
template <bool INV> __device__ __forceinline__ void dft4(cpx& a0, cpx& a1, cpx& a2, cpx& a3) {
    const cpx s0 = cadd(a0, a2), s1 = csub(a0, a2), s2 = cadd(a1, a3), d = csub(a1, a3);
    a0 = cadd(s0, s2); a2 = csub(s0, s2);
    if (INV) { a1 = cpx{fsub_(s1.x, d.y), fadd_(s1.y, d.x)}; a3 = cpx{fadd_(s1.x, d.y), fsub_(s1.y, d.x)}; }
    else     { a1 = cpx{fadd_(s1.x, d.y), fsub_(s1.y, d.x)}; a3 = cpx{fsub_(s1.x, d.y), fadd_(s1.y, d.x)}; }
}
template <bool INV> __device__ __forceinline__ void dft16(cpx (&v)[16]) {
    constexpr float C1 = 0.9238795325112867f, S1 = 0.3826834323650898f, R = 0.7071067811865476f;
    cpx t[4][4];
#pragma unroll
    for (int j = 0; j < 4; ++j) { cpx a0 = v[j], a1 = v[j + 4], a2 = v[j + 8], a3 = v[j + 12]; dft4<INV>(a0, a1, a2, a3); t[0][j] = a0; t[1][j] = a1; t[2][j] = a2; t[3][j] = a3; }
    const float sg = INV ? 1.0f : -1.0f;
    t[1][1] = cmul(t[1][1], cpx{C1, sg * S1}); t[1][2] = cmul(t[1][2], cpx{R, sg * R});   t[1][3] = cmul(t[1][3], cpx{S1, sg * C1});
    t[2][1] = cmul(t[2][1], cpx{R, sg * R});   t[2][2] = mul_mi<INV>(t[2][2]);             t[2][3] = cmul(t[2][3], cpx{-R, sg * R});
    t[3][1] = cmul(t[3][1], cpx{S1, sg * C1}); t[3][2] = cmul(t[3][2], cpx{-R, sg * R});  t[3][3] = cmul(t[3][3], cpx{-C1, -sg * S1});
#pragma unroll
    for (int q = 0; q < 4; ++q) { cpx a0 = t[q][0], a1 = t[q][1], a2 = t[q][2], a3 = t[q][3]; dft4<INV>(a0, a1, a2, a3); v[q] = a0; v[4 + q] = a1; v[8 + q] = a2; v[12 + q] = a3; }
}
constexpr int FFT_HALF_STRIDE = 4096 + 256;
__device__ __forceinline__ int fpos(int e) { return e + (e >> 4); }
template <bool INV> __device__ __forceinline__ void fft_pass_rt(LAS cpx* reg, int tid, int logn) {
    asm volatile("" : "+v"(tid));
    const int st = 1 << (logn - 4); const int u = tid & 255; LAS cpx* base = reg + (tid >> 8) * FFT_HALF_STRIDE;
    const int j = u & (st - 1), b0 = (u >> (logn - 4)) << logn;
    const int p0 = fpos(b0 + j), sp = st + (st >> 4);
    cpx v[16];
#pragma unroll
    for (int q = 0; q < 16; ++q) v[q] = base[p0 + q * sp];
    const int nm = (1 << logn) - 1; const float rn = __int_as_float((127 - logn) << 23);
    if (INV) {
        if (logn > 4) {
            cpx wq[16]; wq[1] = twid<true>((float)j * rn); wq[2] = cmul(wq[1], wq[1]); wq[3] = cmul(wq[2], wq[1]); wq[4] = cmul(wq[2], wq[2]);
#pragma unroll
            for (int q = 5; q < 8; ++q) wq[q] = cmul(wq[4], wq[q - 4]);
            wq[8] = cmul(wq[4], wq[4]);
#pragma unroll
            for (int q = 9; q < 16; ++q) wq[q] = cmul(wq[8], wq[q - 8]);
#pragma unroll
            for (int q = 1; q < 16; ++q) v[q] = cmul(v[q], wq[q]);
        }
        dft16<true>(v);
    } else {
        dft16<false>(v);
        if (logn > 4) {
            cpx wq[16]; wq[1] = twid<false>((float)j * rn); wq[2] = cmul(wq[1], wq[1]); wq[3] = cmul(wq[2], wq[1]); wq[4] = cmul(wq[2], wq[2]);
#pragma unroll
            for (int q = 5; q < 8; ++q) wq[q] = cmul(wq[4], wq[q - 4]);
            wq[8] = cmul(wq[4], wq[4]);
#pragma unroll
            for (int q = 9; q < 16; ++q) wq[q] = cmul(wq[8], wq[q - 8]);
#pragma unroll
            for (int q = 1; q < 16; ++q) v[q] = cmul(v[q], wq[q]);
        }
    }
#pragma unroll
    for (int q = 0; q < 16; ++q) base[p0 + q * sp] = v[q];
}
__device__ __forceinline__ float short_conv(const float* z, int t, int L, float w0, float w1, float w2, float b) {
    const float zm = t > 0 ? z[t - 1] : 0.f, z0 = z[t], zp = t < L - 1 ? z[t + 1] : 0.f;
    return zm * w0 + z0 * w1 + zp * w2 + b;
}
__device__ __forceinline__ void hyena_lat_item(Frame& F, int l, int c) {
    LAS cpx* RA = (LAS cpx*)(F.lds + RING_OFF); LAS cpx* RB = RA + 2 * FFT_HALF_STRIDE;
    const float* hz0 = (const float*)(F.ws + WS_HZL); const float* hz1 = hz0 + (size_t)1536 * 4096;
    const float* cw = F.in[I_HCW] + (size_t)l * 3 * 1536; const float* cbv = F.in[I_HCB] + (size_t)l * 1536;
    const float* kfl = (const float*)(F.ws + WS_KFL) + ((size_t)l * 512 + c) * 2 * 8192;
    const float* kfs = (const float*)(F.ws + WS_KFS) + ((size_t)l * 2 + 0) * 2 * 512;
    const int tid = F.tid;
    int t0_ = 8 * tid; asm volatile("" : "+v"(t0_)); const int t0 = t0_;
    float a0[8], a1[8], g0[2][8], g1[2][8];
#pragma unroll
    for (int part = 0; part < 3; ++part) { const int cc = part * 512 + c; const float w0 = cw[cc], w1 = cw[1536 + cc], w2 = cw[3072 + cc], bb = cbv[cc];
#pragma unroll
        for (int bt = 0; bt < 2; ++bt) { const float* z = (bt ? hz1 : hz0) + (size_t)cc * 4096 + t0;
            const f32x4 za = *(const GAS f32x4*)z, zb = *(const GAS f32x4*)(z + 4);
            float zm = z[t0 > 0 ? -1 : 0], zp = z[t0 + 8 < 4096 ? 8 : 7]; zm = t0 > 0 ? zm : 0.f; zp = t0 + 8 < 4096 ? zp : 0.f;
            const float zz[10] = {zm, za[0], za[1], za[2], za[3], zb[0], zb[1], zb[2], zb[3], zp};
#pragma unroll
            for (int i = 0; i < 8; ++i) { const float s = zz[i] * w0 + zz[i + 1] * w1 + zz[i + 2] * w2 + bb;
                if (part == 0) { if (bt) a1[i] = s; else a0[i] = s; } else { if (bt) g1[part - 1][i] = s; else g0[part - 1][i] = s; } } } }
    float kq[2][16];
#pragma unroll
    for (int o = 0; o < 2; ++o) { const float sc = kfs[o * 512 + c]; const float* kf = kfl + o * 8192 + t0;
        const f32x4 ka = __builtin_nontemporal_load((const GAS f32x4*)kf), kb = __builtin_nontemporal_load((const GAS f32x4*)(kf + 4)), kc = __builtin_nontemporal_load((const GAS f32x4*)(kf + 4096)), kd = __builtin_nontemporal_load((const GAS f32x4*)(kf + 4100));
#pragma unroll
        for (int i = 0; i < 4; ++i) { kq[o][2 * i] = ka[i] * sc; kq[o][2 * i + 1] = kc[i] * sc; kq[o][2 * (i + 4)] = kb[i] * sc; kq[o][2 * (i + 4) + 1] = kd[i] * sc; } }
    const float frb = (float)t0 * (1.0f / 8192.0f); float wbc = __builtin_amdgcn_cosf(frb), wbs = __builtin_amdgcn_sinf(frb); asm volatile("s_nop 1" : "+v"(wbc), "+v"(wbs)); const cpx wb = cpx{wbc, -wbs};
    constexpr float WC[8] = {1.0f, 0.99999970586288223f, 0.99999882345170188f, 0.99999735276697821f, 0.99999529380957619f, 0.99999264658070719f, 0.99998941108192840f, 0.99998558731514291f};
    constexpr float WS[8] = {0.0f, 0.00076699031874270453f, 0.0015339801862847655f, 0.0023009691514258030f, 0.0030679567629659761f, 0.0038349425697062270f, 0.0046019261204485705f, 0.0053689069639963418f};
#pragma unroll 1
    for (int o = 0; o < 2; ++o) {
        { int tq = t0; float wbx = wb.x, wby = wb.y; asm volatile("" : "+v"(tq), "+v"(wbx), "+v"(wby)); const cpx wbl = cpx{wbx, wby};
#pragma unroll
          for (int i = 0; i < 8; ++i) { const int j = tq + i; const float k0 = o ? kq[1][2 * i] : kq[0][2 * i], k1 = o ? kq[1][2 * i + 1] : kq[0][2 * i + 1]; const float d = k0 - k1;
              const cpx w = i ? cmul(wbl, cpx{WC[i], -WS[i]}) : wbl;
              RB[fpos(j)] = cpx{k0 + k1, 0.f}; RB[FFT_HALF_STRIDE + fpos(j)] = cpx{d * w.x, d * w.y};
              const cpx z = cpx{a0[i], a1[i]}; RA[fpos(j)] = z; RA[FFT_HALF_STRIDE + fpos(j)] = cmul(z, w); } }
        __syncthreads();
#pragma unroll 1
        for (int p = 0; p < 2; ++p) {
#pragma unroll 1
            for (int r = 0; r < 2; ++r) fft_pass_rt<false>(r ? RB : RA, tid, 12 - 4 * p);
            __syncthreads();
        }
        { int tq = tid; asm volatile("" : "+v"(tq)); const int u = tq & 255; LAS cpx* bA = RA + (tq >> 8) * FFT_HALF_STRIDE + 17 * u; LAS cpx* bB = bA + 2 * FFT_HALF_STRIDE;
          cpx v[16], f[16];
#pragma unroll
          for (int q = 0; q < 16; ++q) { v[q] = bA[q]; f[q] = bB[q]; }
          dft16<false>(v); dft16<false>(f);
#pragma unroll
          for (int q = 0; q < 16; ++q) v[q] = cmul(v[q], f[q]);
          dft16<true>(v);
#pragma unroll
          for (int q = 0; q < 16; ++q) bA[q] = v[q]; }
        __syncthreads();
#pragma unroll 1
        for (int p = 1; p < 3; ++p) { fft_pass_rt<true>(RA, tid, 4 + 4 * p); __syncthreads(); }
        { const float sk = F.in[I_HSKIP][((size_t)l * 2 + o) * 512 + c]; int tq = t0; float wbx = wb.x, wby = wb.y; asm volatile("" : "+v"(tq), "+v"(wbx), "+v"(wby)); const cpx wbl = cpx{wbx, wby};
#pragma unroll
          for (int i = 0; i < 8; ++i) { const int j = tq + i; const cpx wf = i ? cmul(wbl, cpx{WC[i], -WS[i]}) : wbl; const cpx wc = cpx{wf.x, -wf.y};
              const cpx lo = RA[fpos(j)], up = cmul(RA[FFT_HALF_STRIDE + fpos(j)], wc);
              const float y0 = (lo.x + up.x) * (1.0f / 8192.0f), y1 = (lo.y + up.y) * (1.0f / 8192.0f);
              const float x0 = o ? g0[1][i] : g0[0][i], x1 = o ? g1[1][i] : g1[0][i];
              a0[i] = x0 * (y0 + a0[i] * sk); a1[i] = x1 * (y1 + a1[i] * sk); } }
    }
    __syncthreads();
    { bf16* cot = (bf16*)(F.ws + WS_COTL) + (size_t)c * 4096 + t0;
      const v4u w0 = {cvtpk(a0[0], a0[1]), cvtpk(a0[2], a0[3]), cvtpk(a0[4], a0[5]), cvtpk(a0[6], a0[7])}, w1 = {cvtpk(a1[0], a1[1]), cvtpk(a1[2], a1[3]), cvtpk(a1[4], a1[5]), cvtpk(a1[6], a1[7])};
      *(GAS v4u*)cot = w0; *(GAS v4u*)(cot + (size_t)512 * 4096) = w1; }
}
__device__ __forceinline__ void hyena_ctx_item(Frame& F, int l, int it) {
    const int cq = F.tid >> 7, r = F.tid & 127, b = r >> 6, tq = r & 63, c = 4 * it + cq, t0 = 4 * tq;
    LAS float* K0 = (LAS float*)(F.lds + RING_OFF) + cq * 1536; LAS float* K1 = K0 + 512; LAS float* U = K1 + 512;
    const float* kfc = (const float*)(F.ws + WS_KFC) + ((size_t)l * 512 + c) * 2 * 512;
    const float* kfs = (const float*)(F.ws + WS_KFS) + ((size_t)l * 2 + 1) * 2 * 512;
    const float* cw = F.in[I_HCW] + (size_t)l * 3 * 1536; const float* cbv = F.in[I_HCB] + (size_t)l * 1536;
    const float sk0 = F.in[I_HSKIP][((size_t)l * 2 + 0) * 512 + c], sk1 = F.in[I_HSKIP][((size_t)l * 2 + 1) * 512 + c];
    const float* hz = (const float*)(F.ws + WS_HZC) + (size_t)b * 1536 * 256;
    const f32x4 k0v = *(const GAS f32x4*)(kfc + 4 * r) * kfs[c], k1v = *(const GAS f32x4*)(kfc + 512 + 4 * r) * kfs[512 + c];
    float xs[3][4];
#pragma unroll
    for (int part = 0; part < 3; ++part) { const int cc = part * 512 + c; const float* z = hz + (size_t)cc * 256 + t0; const float w0 = cw[cc], w1 = cw[1536 + cc], w2 = cw[3072 + cc], bb = cbv[cc];
        const f32x4 zc = *(const GAS f32x4*)z; const float zm = t0 > 0 ? z[-1] : 0.f, zp = t0 + 4 < 256 ? z[4] : 0.f;
        xs[part][0] = zm * w0 + zc[0] * w1 + zc[1] * w2 + bb; xs[part][1] = zc[0] * w0 + zc[1] * w1 + zc[2] * w2 + bb;
        xs[part][2] = zc[1] * w0 + zc[2] * w1 + zc[3] * w2 + bb; xs[part][3] = zc[2] * w0 + zc[3] * w1 + zp * w2 + bb; }
    *(LAS f32x4*)(K0 + 4 * r) = k0v; *(LAS f32x4*)(K1 + 4 * r) = k1v;
    *(LAS f32x4*)(U + b * 256 + t0) = (f32x4){xs[0][0], xs[0][1], xs[0][2], xs[0][3]};
    float cur[4] = {xs[0][0], xs[0][1], xs[0][2], xs[0][3]};
#pragma unroll 1
    for (int o = 0; o < 2; ++o) {
        __syncthreads();
        const LAS float* K = o ? K1 : K0; const LAS float* Ub = U + b * 256;
        float y[4] = {0.f, 0.f, 0.f, 0.f};
        f32x4 ghi = *(const LAS f32x4*)(K + (t0 & 511)), glo = *(const LAS f32x4*)(K + ((t0 - 4) & 511));
#pragma unroll 4
        for (int s = 0; s < 256; s += 4) {
            const f32x4 u = *(const LAS f32x4*)(Ub + s);
            const float kk[8] = {glo[0], glo[1], glo[2], glo[3], ghi[0], ghi[1], ghi[2], ghi[3]};
#pragma unroll
            for (int k = 0; k < 4; ++k)
#pragma unroll
                for (int j = 0; j < 4; ++j) y[k] += u[j] * kk[4 + k - j];
            ghi = glo; glo = *(const LAS f32x4*)(K + ((t0 - s - 8) & 511));
        }
        const float sk = o ? sk1 : sk0;
#pragma unroll
        for (int k = 0; k < 4; ++k) cur[k] = (o ? xs[2][k] : xs[1][k]) * (y[k] + cur[k] * sk);
        __syncthreads();
        if (o == 0) *(LAS f32x4*)(U + b * 256 + t0) = (f32x4){cur[0], cur[1], cur[2], cur[3]};
    }
    u32x2 w; w.x = cvtpk(cur[0], cur[1]); w.y = cvtpk(cur[2], cur[3]);
    { GAS bf16* mp = (GAS bf16*)((bf16*)(F.ws + WS_MIX) + ((size_t)ML + b * CTXL + t0) * DMIX + 1536 + c);
      mp[0] = (bf16)(w.x & 0xffffu); mp[DMIX] = (bf16)(w.x >> 16); mp[2 * DMIX] = (bf16)(w.y & 0xffffu); mp[3 * DMIX] = (bf16)(w.y >> 16); }
    __syncthreads();
}
__device__ __forceinline__ void hy_transpose_item(Frame& F, int it) {
    LAS bf16* T = (LAS bf16*)(F.lds + RING_OFF);
    const bool lat = it < 256; const int x = lat ? it : it - 256;
    const int tt = lat ? (x & 15) : 0, ct = lat ? ((x >> 4) & 7) : (x & 7), b = lat ? (x >> 7) : (x >> 3);
    const int L = lat ? 4096 : 256;
    const bf16* src = (lat ? (const bf16*)(F.ws + WS_COTL) : (const bf16*)(F.ws + WS_COTC)) + ((size_t)b * 512 + ct * 64) * L + tt * 256;
    v4u d[4];
#pragma unroll
    for (int i = 0; i < 4; ++i) { const int id = F.tid + 512 * i, ch = id >> 5, k = id & 31; d[i] = __builtin_nontemporal_load((const GAS v4u*)(src + (size_t)ch * L + 8 * k)); }
#pragma unroll
    for (int i = 0; i < 4; ++i) { const int id = F.tid + 512 * i, ch = id >> 5, k = id & 31; LAS unsigned* tp = (LAS unsigned*)(T + ch * 264 + 8 * k); tp[0] = d[i].x; tp[1] = d[i].y; tp[2] = d[i].z; tp[3] = d[i].w; }
    __syncthreads();
#pragma unroll
    for (int i = 0; i < 4; ++i) { const int id = F.tid + 512 * i, t = id >> 3, cc = id & 7; unsigned w[4];
#pragma unroll
        for (int k = 0; k < 4; ++k) w[k] = (unsigned)T[(8 * cc + 2 * k) * 264 + t] | ((unsigned)T[(8 * cc + 2 * k + 1) * 264 + t] << 16);
        const size_t row = (size_t)(lat ? b * SEQ : ML + b * CTXL) + tt * 256 + t;
        *(GAS v4u*)((bf16*)(F.ws + WS_MIX) + row * DMIX + 1536 + ct * 64 + 8 * cc) = (v4u){w[0], w[1], w[2], w[3]}; }
    __syncthreads();
}
constexpr int KT_STRIDE = 272, VT_STRIDE = 264;
constexpr int KT_BYTES = 128 * KT_STRIDE;
__device__ __forceinline__ f32x16 mfma32(bf16x8 a, bf16x8 b, f32x16 c) { return __builtin_amdgcn_mfma_f32_32x32x16_bf16(a, b, c, 0, 0, 0); }
__device__ __forceinline__ void attn_item(Frame& F, int l, int it) {
    const bool lat = it < 256; int nblk, pair, kh, b;
    if (lat) { nblk = it & 31; pair = (it >> 5) & 1; kh = (it >> 6) & 1; b = it >> 7; } else { const int x = it - 256; nblk = x & 1; pair = (x >> 1) & 1; kh = (x >> 2) & 1; b = x >> 3; }
    int lane_ = F.lane; asm volatile("" : "+v"(lane_));
    const int w = F.wave, lane = lane_, h = lane >> 5, ql = lane & 31;
    const int hq = 4 * kh + 2 * pair + (w >> 2);
    const int qi = 32 * (w & 3) + ql;
    const size_t qrow = (size_t)(lat ? b * SEQ : ML + b * CTXL) + 128 * nblk + qi;
    const bf16* QBp = (const bf16*)(F.ws + WS_QB); const bf16* KBp = (const bf16*)(F.ws + WS_KB);
    const bf16* VTl = (const bf16*)(F.ws + WS_VTL); const bf16* VTc = (const bf16*)(F.ws + WS_VTC);
    LAS unsigned char* Kt = F.lds + RING_OFF; LAS unsigned char* Vt = Kt + KT_BYTES;
    LAS unsigned char* Ost = F.lds + RING_OFF + 69632 + w * 8704;
    const size_t wrow = qrow - ql;
    { v4u qd[8];
#pragma unroll
      for (int i = 0; i < 8; ++i) { const int id = lane + 64 * i; qd[i] = *(const GAS v4u*)(QBp + (wrow + (id >> 4)) * 1024 + hq * 128 + 8 * (id & 15)); }
#pragma unroll
      for (int i = 0; i < 8; ++i) { const int id = lane + 64 * i; *(LAS v4u*)(Ost + (id >> 4) * 272 + (id & 15) * 16) = qd[i]; } }
    bf16x8 qf[8];
#pragma unroll
    for (int s = 0; s < 8; ++s) qf[s] = *(const LAS bf16x8*)(Ost + ql * 272 + (16 * s + 8 * h) * 2);
    float m = F.in[I_SINK][l * 8 + hq] * LOG2E; float lsum = h == 0 ? 1.0f : 0.0f;
    f32x16 O[4];
#pragma unroll
    for (int dt = 0; dt < 4; ++dt)
#pragma unroll
        for (int r = 0; r < 16; ++r) O[dt][r] = 0.f;
    const int ntiles = lat ? 5 : 2;
#define ATT_TILE(t, ksrc, vsrc, vld) do { if ((t) < 2) { ksrc = KBp + (size_t)(ML + b * CTXL + 128 * (t)) * 256 + kh * 128; vsrc = VTc + (size_t)((b * 2 + kh) * 128) * 256 + 128 * (t); vld = 256; } \
        else { const int kb_ = nblk + (t) - 3; ksrc = KBp + (size_t)(b * SEQ + 128 * kb_) * 256 + kh * 128; vsrc = VTl + (size_t)((b * 2 + kh) * 128) * 4096 + 128 * kb_; vld = 4096; } } while (0)
#define ATT_LOAD(ksrc, vsrc, vld) do { _Pragma("unroll") for (int i = 0; i < 4; ++i) { const int id = F.tid + 512 * i, row = id >> 4, ch = id & 15; \
        kd[i] = *(const GAS v4u*)(ksrc + (size_t)row * 256 + ch * 8); vd[i] = *(const GAS v4u*)(vsrc + (size_t)row * vld + ch * 8); } } while (0)
    v4u kd[4], vd[4];
    int ti = 0;
    { const bf16* ksrc; const bf16* vsrc; int vld; ATT_TILE(0, ksrc, vsrc, vld); ATT_LOAD(ksrc, vsrc, vld); }
    while (ti < ntiles) {
        const int type = ti < 2 ? 0 : (ti == 2 ? 1 : (ti == 3 ? 0 : 2));
        __syncthreads();
#pragma unroll
        for (int i = 0; i < 4; ++i) { const int id = F.tid + 512 * i, row = id >> 4, ch = id & 15;
            *(LAS v4u*)(Kt + row * KT_STRIDE + ch * 16) = kd[i];
            *(LAS u32x2*)(Vt + row * VT_STRIDE + ch * 16) = (u32x2){vd[i].x, vd[i].y}; *(LAS u32x2*)(Vt + row * VT_STRIDE + ch * 16 + 8) = (u32x2){vd[i].z, vd[i].w}; }
        __syncthreads();
        int tn = ti + 1; if (tn == 2 && nblk == 0) tn = 3; if (tn == 4 && nblk == 31) tn = 5;
        if (tn < ntiles) { const bf16* ksrc; const bf16* vsrc; int vld; ATT_TILE(tn, ksrc, vsrc, vld); ATT_LOAD(ksrc, vsrc, vld); }
#pragma unroll 1
        for (int hs = 0; hs < 2; ++hs) {
            f32x16 S[2];
#pragma unroll
            for (int sb = 0; sb < 2; ++sb) {
#pragma unroll
                for (int r = 0; r < 16; ++r) S[sb][r] = 0.f;
#pragma unroll
                for (int s = 0; s < 8; ++s) { const bf16x8 a = *(const LAS bf16x8*)(Kt + (32 * (2 * hs + sb) + ql) * KT_STRIDE + (16 * s + 8 * h) * 2); S[sb] = mfma32(a, qf[s], S[sb]); }
            }
            if (type != 0) {
                int qv = type == 1 ? qi - 4 * h - 64 * hs : -(qi - 4 * h - 64 * hs); asm volatile("" : "+v"(qv));
#pragma unroll
                for (int sb = 0; sb < 2; ++sb)
#pragma unroll
                    for (int r = 0; r < 16; ++r) { const int j0 = 32 * sb + (r & 3) + 8 * (r >> 2); const int jv = type == 1 ? j0 : -j0; if (jv < qv) S[sb][r] = -1e30f; }
            }
            float mx = m;
#pragma unroll
            for (int sb = 0; sb < 2; ++sb)
#pragma unroll
                for (int r = 0; r < 16; ++r) mx = fmaxf(mx, S[sb][r]);
            mx = fmaxf(mx, __shfl_xor(mx, 32));
            const float alpha = __builtin_amdgcn_exp2f(m - mx); m = mx; lsum *= alpha;
#pragma unroll
            for (int dt = 0; dt < 4; ++dt)
#pragma unroll
                for (int r = 0; r < 16; ++r) O[dt][r] *= alpha;
            float ps = 0.f;
#pragma unroll
            for (int sb = 0; sb < 2; ++sb)
#pragma unroll
                for (int r = 0; r < 16; ++r) { const float p = __builtin_amdgcn_exp2f(S[sb][r] - mx); S[sb][r] = p; ps += p; }
            lsum += ps;
#pragma unroll
            for (int sb = 0; sb < 2; ++sb)
#pragma unroll
                for (int s2 = 0; s2 < 2; ++s2) {
                    v4u pw; pw.x = cvtpk(S[sb][8 * s2 + 0], S[sb][8 * s2 + 1]); pw.y = cvtpk(S[sb][8 * s2 + 2], S[sb][8 * s2 + 3]); pw.z = cvtpk(S[sb][8 * s2 + 4], S[sb][8 * s2 + 5]); pw.w = cvtpk(S[sb][8 * s2 + 6], S[sb][8 * s2 + 7]);
                    const bf16x8 pf = __builtin_bit_cast(bf16x8, pw);
#pragma unroll
                    for (int dt = 0; dt < 4; ++dt) { LAS unsigned char* vb = Vt + (32 * dt + ql) * VT_STRIDE + (32 * (2 * hs + sb) + 16 * s2 + 4 * h) * 2;
                        const u32x2 lo = *(const LAS u32x2*)vb, hi = *(const LAS u32x2*)(vb + 16);
                        const bf16x8 a = __builtin_bit_cast(bf16x8, (v4u){lo.x, lo.y, hi.x, hi.y});
                        O[dt] = mfma32(a, pf, O[dt]); }
                    asm volatile("" ::: "memory");
                }
        }
        ti = tn;
    }
#undef ATT_TILE
#undef ATT_LOAD
    const float lt = lsum + __shfl_xor(lsum, 32); const float inv = 1.0f / lt;
    { int lq = lane; asm volatile("" : "+v"(lq));
      const int ql2 = lq & 31, h2 = lq >> 5;
#pragma unroll
      for (int dt = 0; dt < 4; ++dt)
#pragma unroll
          for (int g = 0; g < 4; ++g) { u32x2 wv; wv.x = cvtpk(O[dt][4 * g + 0] * inv, O[dt][4 * g + 1] * inv); wv.y = cvtpk(O[dt][4 * g + 2] * inv, O[dt][4 * g + 3] * inv);
              *(LAS u32x2*)(Ost + ql2 * 272 + (32 * dt + 8 * g + 4 * h2) * 2) = wv; }
      bf16* op = (bf16*)(F.ws + WS_MIX) + ((size_t)(lat ? b * SEQ : ML + b * CTXL) + 128 * nblk + 32 * (w & 3)) * DMIX + 512 + hq * 128;
#pragma unroll
      for (int i = 0; i < 8; ++i) { const int id = lq + 64 * i; *(GAS v4u*)(op + (size_t)(id >> 4) * DMIX + 8 * (id & 15)) = *(const LAS v4u*)(Ost + (id >> 4) * 272 + (id & 15) * 16); } }
    __syncthreads();
}
__device__ __forceinline__ void sgu_item(Frame& F, int l, int it) {
    const int n = it >> 2, g = it & 3; const int row0 = 128 * n;
    int lane_ = F.lane; asm volatile("" : "+v"(lane_));
    const int w = F.wave, lane = lane_, h = lane >> 5, ql = lane & 31;
    LAS unsigned char* VnT = F.lds + RING_OFF;
    const bf16* AU = (const bf16*)(F.ws + WS_AU);
    const int ct = w & 3, qt0 = 2 * (w >> 2);
    const float* Ws = F.in[I_SGUW] + ((size_t)l * 4 + g) * 128 * 128;
    bf16* MIXp = (bf16*)(F.ws + WS_MIX);
    float gam[8];
#pragma unroll
    for (int k = 0; k < 8; ++k) gam[k] = F.in[I_SGUG][l * 512 + 8 * lane + k];
    v4u dd[16];
#pragma unroll
    for (int rr = 0; rr < 16; ++rr) dd[rr] = *(const GAS v4u*)(AU + (size_t)(row0 + 16 * w + rr) * 1024 + 512 + 8 * lane);
    v4u bfr[2][8]; float bs[2];
    LAS unsigned char* Ut = VnT + 128 * 272;
    v4u ud[4];
#pragma unroll
    for (int i = 0; i < 4; ++i) { const int id = (w * 64 + lane) + 512 * i; ud[i] = *(const GAS v4u*)(AU + ((size_t)row0 + (id >> 4)) * 1024 + 128 * g + 8 * (id & 15)); }
#pragma unroll
    for (int qq = 0; qq < 2; ++qq) { const int q = 32 * (qt0 + qq) + ql; const GAS float* wp = (const GAS float*)(Ws + (size_t)q * 128 + 8 * h);
        f32x4 w0[8], w1[8];
#pragma unroll
        for (int s = 0; s < 8; ++s) { w0[s] = *(const GAS f32x4*)(wp + 16 * s); w1[s] = *(const GAS f32x4*)(wp + 16 * s + 4); }
        bs[qq] = F.in[I_SGUB][((size_t)l * 4 + g) * 128 + q];
#pragma unroll
        for (int s = 0; s < 8; ++s) bfr[qq][s] = (v4u){cvtpk(w0[s][0], w0[s][1]), cvtpk(w0[s][2], w0[s][3]), cvtpk(w1[s][0], w1[s][1]), cvtpk(w1[s][2], w1[s][3])}; }
#pragma unroll
    for (int rr = 0; rr < 16; ++rr) {
        const int p = 16 * w + rr; const v4u d = dd[rr];
        float x[8] = {bf_lo(d.x), bf_hi(d.x), bf_lo(d.y), bf_hi(d.y), bf_lo(d.z), bf_hi(d.z), bf_lo(d.w), bf_hi(d.w)};
        float s = 0.f;
#pragma unroll
        for (int k = 0; k < 8; ++k) s += x[k];
        const float mean = wave_sum(s) * (1.0f / 512.0f); float q = 0.f;
#pragma unroll
        for (int k = 0; k < 8; ++k) { x[k] -= mean; q += x[k] * x[k]; }
        const float rstd = rsqrtf(wave_sum(q) * (1.0f / 512.0f) + NORM_EPS);
        if ((lane >> 4) == g) {
#pragma unroll
            for (int k = 0; k < 8; ++k) { const int cl = 8 * (lane & 15) + k; *(LAS bf16*)(VnT + cl * 272 + ((((p >> 3) ^ (lane & 15)) << 4) | ((p & 7) << 1))) = (bf16)f2bf(x[k] * rstd * gam[k]); }
        }
    }
#pragma unroll
    for (int i = 0; i < 4; ++i) { const int id = (w * 64 + lane) + 512 * i; *(LAS v4u*)(Ut + (id >> 4) * 272 + (id & 15) * 16) = ud[i]; }
    __syncthreads();
    bf16x8 af[8];
#pragma unroll
    for (int s = 0; s < 8; ++s) af[s] = *(const LAS bf16x8*)(VnT + (32 * ct + ql) * 272 + (((2 * s + h) ^ (((32 * ct + ql) >> 3) & 15)) << 4));
#pragma unroll
    for (int qq = 0; qq < 2; ++qq) {
        const int q = 32 * (qt0 + qq) + ql;
        f32x16 D;
#pragma unroll
        for (int r = 0; r < 16; ++r) D[r] = 0.f;
#pragma unroll
        for (int s = 0; s < 8; ++s) D = mfma32(af[s], __builtin_bit_cast(bf16x8, bfr[qq][s]), D);
        const size_t row = (size_t)row0 + q;
#pragma unroll
        for (int gi = 0; gi < 4; ++gi) { LAS u32x2* up = (LAS u32x2*)(Ut + q * 272 + (32 * ct + 8 * gi + 4 * h) * 2); const u32x2 u2 = *up;
            u32x2 o; o.x = cvtpk(bf_lo(u2.x) * (D[4 * gi + 0] + bs[qq]), bf_hi(u2.x) * (D[4 * gi + 1] + bs[qq])); o.y = cvtpk(bf_lo(u2.y) * (D[4 * gi + 2] + bs[qq]), bf_hi(u2.y) * (D[4 * gi + 3] + bs[qq]));
            *up = o; }
    }
    __syncthreads();
#pragma unroll
    for (int i = 0; i < 4; ++i) { const int id = (w * 64 + lane) + 512 * i; *(GAS v4u*)(MIXp + ((size_t)row0 + (id >> 4)) * DMIX + 128 * g + 8 * (id & 15)) = *(const LAS v4u*)(Ut + (id >> 4) * 272 + (id & 15) * 16); }
    __syncthreads();
}
#ifndef PHM
#define PHM 0xffffffffu
#endif
#define PON(b) ((PHM >> (b)) & 1u)
__device__ __forceinline__ int grab(Frame& F, int qidx) {
    __syncthreads();
    if (F.tid == 0) F.MISC[16] = __hip_atomic_fetch_add(F.ctl + CW_Q + qidx * 64, 1u, __ATOMIC_RELAXED, __HIP_MEMORY_SCOPE_AGENT);
    __syncthreads();
    return (int)F.MISC[16];
}
#ifndef PROBE_DUP
#define PROBE_DUP 0
#endif
__device__ __forceinline__ Frame phase_frame(const Frame& F);
__device__ __forceinline__ void mixer_phase(Frame& F, int lq) {
    const int l = lq & 3;
    for (int rep = 0; rep < (PROBE_DUP == 12 ? 2 : 1); ++rep)
    if (PON(12)) { Frame P = phase_frame(F);
        const bool remap = P.G == 256;
        for (int it0 = P.bx; it0 < (remap ? 512 : 272); it0 += P.G) { int it = it0; if (remap && it0 >= 256) { const int x = it0 - 256; it = (x >= 128 && x < 144) ? 128 + x : 1 << 20; } if (it < 272) attn_item(P, l, it); } }
    for (int rep = 0; rep < (PROBE_DUP == 13 ? 2 : 1); ++rep)
    if (PON(13)) { Frame P = phase_frame(F); for (int it = P.bx; it < 512; it += P.G) hyena_lat_item(P, l, it); }
    for (int rep = 0; rep < (PROBE_DUP == 14 ? 2 : 1); ++rep)
    if (PON(14)) { Frame P = phase_frame(F); for (int it = P.G - 1 - P.bx; it < 272; it += P.G) sgu_item(P, l, it); }
    for (int rep = 0; rep < (PROBE_DUP == 15 ? 2 : 1); ++rep)
    if (PON(15)) { Frame P = phase_frame(F); for (int it = P.bx; it < 128; it += P.G) hyena_ctx_item(P, l, it); }
}

__device__ __forceinline__ void win_fixup(Frame& F) {
    for (int it = F.bx; it < 256; it += F.G) {
        const int tile = it >> 3, ai = (it >> 2) & 1, m = it & 3;
        const int pm = 32 + (tile & 1), pn = tile >> 1;
        const int wid = F.wave, lane = F.lane, wr = wid >> 2, wc = wid & 3, fr = lane & 15, fq = lane >> 4;
        const bf16* zs = (const bf16*)(F.ws + WS_ZS) + ((size_t)(pm - 32) * 256 + ai * 128 + m * 16 + wr * 64 + fr) * 4096 + pn * 256 + wc * 32 + 8 * fq;
        v4u part[S_IN][2];
#pragma unroll
        for (int s = 0; s < S_IN; ++s)
#pragma unroll
            for (int bj = 0; bj < 2; ++bj) part[s][bj] = __builtin_nontemporal_load((const GAS v4u*)(zs + (size_t)s * 512 * 4096 + bj * 128));
        pg8::f32x4 acc[1][2][1][2];
#pragma unroll
        for (int bj = 0; bj < 2; ++bj) { pg8::f32x4 v0 = {0.f, 0.f, 0.f, 0.f}, v1 = v0;
#pragma unroll
            for (int s = 0; s < S_IN; ++s) { const v4u w = part[s][bj]; v0 += (pg8::f32x4){bf_lo(w.x), bf_hi(w.x), bf_lo(w.y), bf_hi(w.y)}; v1 += (pg8::f32x4){bf_lo(w.z), bf_hi(w.z), bf_lo(w.w), bf_hi(w.w)}; }
            acc[0][bj][0][0] = v0; acc[0][bj][0][1] = v1; }
        pg8::EpiWin E{F.ws, QSCALE};
        E.finish<1, 1>(acc, pm * 256 + ai * 128 + m * 16, pm, pn, wr, wc, fr, fq);
    }
}
__device__ __forceinline__ Frame phase_frame(const Frame& F) {
    Frame P = F;
    unsigned long long w = (unsigned long long)P.ws; int gg = P.G, bx = P.bx; asm volatile("" : "+s"(w), "+s"(gg), "+s"(bx)); P.ws = (unsigned char*)w; P.G = gg; P.bx = bx;
    P.ctl = (gu32*)(P.ws + WS_CTL);
    int ln; asm volatile("v_mbcnt_lo_u32_b32 %0, -1, 0\n\tv_mbcnt_hi_u32_b32 %0, -1, %0" : "=v"(ln)); P.lane = ln; P.tid = P.wave * 64 + ln;
    return P;
}
struct Args { const float* in[28]; float* out; unsigned char* ws; int ph_lo, ph_hi; };
constexpr int NPH = 2 + 12 * DEPTH;
__global__ void __launch_bounds__(NWAVES * 64, 2) hymba_fwd(Args args) {
    extern __shared__ __attribute__((aligned(16))) unsigned char lds[];
    Frame F;
    F.lds = (LAS unsigned char*)lds;
    F.MISC = (volatile LAS unsigned*)(F.lds + MISC_OFF);
    F.tid = threadIdx.x; F.lane = F.tid & 63; F.wave = __builtin_amdgcn_readfirstlane(F.tid >> 6);
    F.G = gridDim.x; F.bx = blockIdx.x;
    F.in = args.in;
    F.out = args.out; F.ws = args.ws;
    F.ctl = (gu32*)(args.ws + WS_CTL);
    for (int u = F.tid; u < (LDS_BYTES - LDSCTL_OFF) / 4; u += NWAVES * 64) ((LAS unsigned*)(F.lds + LDSCTL_OFF))[u] = 0u;
    __syncthreads();
    XcdBarrier bar; bar.bar = (unsigned*)(F.ctl + CW_BAR); bar.x = 0; bar.st = nullptr;
    if (!MK_MULTI) bar = xcd_barrier_post((unsigned*)(F.ctl + CW_BAR), F.MISC + 8);
    const int lo = args.ph_lo, hi = args.ph_hi;
#ifndef STAMP_LNB
#define STAMP_LNB 0.1823215568f
#endif
#ifndef STAMP_OFS
#define STAMP_OFS 0.0f
#endif
#ifndef STAMP_SEL
#define STAMP_SEL -1
#endif
#define tsb ((unsigned long long*)(args.ws + WS_CTL + 512 * 1024))
#define STAMP(p) do { if (STAMP_SEL >= 0 && blockIdx.x == 0 && threadIdx.x == 0) tsb[p] = __builtin_amdgcn_s_memrealtime(); } while (0)
#ifndef PHM
#define PHM 0xffffffffu
#endif
#define PON(b) ((PHM >> (b)) & 1u)
#define IN(k) (lo <= (k) && (k) < hi)
#define SEAM(k) do { if (!MK_MULTI && (k) + 1 < hi) xcd_barrier(bar); } while (0)

#ifndef PROBE_DUP
#define PROBE_DUP 0
#endif
    STAMP(0);
    if (IN(0)) { if (PON(0)) { Frame P = phase_frame(F); p0_prologue(P); } SEAM(0); }
    if (PROBE_DUP == 1) { { Frame P = phase_frame(F); p0_prologue(P); } xcd_barrier(bar); }
    STAMP(1);
    if (IN(1)) {
        Frame P = phase_frame(F);
        const bool conv_first = ((P.bx >> 3) & 1) != 0;
        if (conv_first) { p0_convert_all(P); __syncthreads(); }
        if (PON(1)) for (int it = P.bx; it < DEPTH * 2 * 64; it += P.G) p1_filter_item(P, it);
        if (!conv_first) { __syncthreads(); p0_convert_all(P); }
        if (PON(2)) thin_phase<false, true, false>(P, 0, 0, 0.f, 0, 0, 0);
        SEAM(1);
    }
    for (int l = 0; l < DEPTH; ++l) {
        const int pb = 2 + 12 * l;
        STAMP(pb + 0);
        if (IN(pb + 0) && PON(3)) {
            Frame P = phase_frame(F); unsigned char* wl = P.ws + WS_W + (size_t)l * WL_STRIDE;
            pg8::Gemm g{(const pg8::bf16_t*)(P.ws + WS_XN), (const pg8::bf16_t*)(wl + WL_GU1), MA, 2 * FF, DM}; pg8::MixedOrder S; S.init(2 * FF, DM, 1, P.G, P.bx);
            pg8::EpiSwiGLU E{(pg8::bf16_t*)(P.ws + WS_H), FF};
            pg8::gemm_phase<pg8::EpiSwiGLU, pg8::MixedOrder, true, true>(P.lds + RING_OFF, g, S, E, P.tid);
            if (PROBE_DUP == 5) { xcd_barrier(bar); pg8::gemm_phase<pg8::EpiSwiGLU, pg8::MixedOrder, true, true>(P.lds + RING_OFF, g, S, E, P.tid); }
            if (PROBE_DUP == 7) { xcd_barrier(bar); pg8::EpiNone EN; pg8::gemm_phase<pg8::EpiNone, pg8::MixedOrder, true, true>(P.lds + RING_OFF, g, S, EN, P.tid); }
        }
        if (IN(pb + 0)) SEAM(pb + 0);
        if (PROBE_DUP == 20) { for (int rep = 0; rep < 8; ++rep) xcd_barrier(bar); }
        STAMP(pb + 1);
        if (IN(pb + 1) && PON(4)) {
            Frame P = phase_frame(F); unsigned char* wl = P.ws + WS_W + (size_t)l * WL_STRIDE;
            pg8::Gemm g{(const pg8::bf16_t*)(P.ws + WS_H), (const pg8::bf16_t*)(wl + WL_D1), MA, DM, FF}; pg8::MixedOrder S; S.init(DM, FF, S_DOWN, P.G, P.bx);
            pg8::EpiF32 E{(pg8::bf16_t*)(P.ws + WS_Y), DM, (pg8::bf16_t*)(P.ws + WS_YS)};
            pg8::gemm_phase<pg8::EpiF32, pg8::MixedOrder, true, true>(P.lds + RING_OFF, g, S, E, P.tid);
            if (PROBE_DUP == 4) { xcd_barrier(bar); pg8::gemm_phase<pg8::EpiF32, pg8::MixedOrder, true, true>(P.lds + RING_OFF, g, S, E, P.tid); }
        }
        if (IN(pb + 1)) SEAM(pb + 1);
        STAMP(pb + 2);
        if (IN(pb + 2)) { if (PON(5)) { Frame P = phase_frame(F); thin_phase<true, true, false>(P, l, 0, 0.5f, l, 1, S_DOWN); } SEAM(pb + 2); }
        STAMP(pb + 3);
        if (IN(pb + 3) && PON(6)) {
            Frame P = phase_frame(F); unsigned char* wl = P.ws + WS_W + (size_t)l * WL_STRIDE;
            pg8::Gemm g{(const pg8::bf16_t*)(P.ws + WS_XN), (const pg8::bf16_t*)(wl + WL_IN), MA, INC, DM}; pg8::MixedOrder S; S.init(INC, DM, S_IN, P.G, P.bx);
            pg8::EpiWin E{P.ws, QSCALE};
            pg8::gemm_phase<pg8::EpiWin, pg8::MixedOrder, true, true>(P.lds + RING_OFF, g, S, E, P.tid);
        }
        if (IN(pb + 3)) SEAM(pb + 3);
        STAMP(pb + 4);
        if (IN(pb + 4)) { if (PON(6)) { Frame P = phase_frame(F); win_fixup(P); } SEAM(pb + 4); }
        STAMP(pb + 5);
        if (IN(pb + 5)) { { Frame P = phase_frame(F); mixer_phase(P, l); } SEAM(pb + 5); }
        STAMP(pb + 6);
        if (IN(pb + 6)) { { Frame P = phase_frame(F); for (int it = P.bx; it < 256; it += P.G) hy_transpose_item(P, it); } SEAM(pb + 6); }
        STAMP(pb + 7);
        if (PROBE_DUP == 3) { { Frame P = phase_frame(F); mixer_phase(P, l + 4); } xcd_barrier(bar); }
        if (PROBE_DUP == 6) { { Frame P = phase_frame(F); win_fixup(P); } xcd_barrier(bar);
            { Frame P = phase_frame(F); for (int it = P.bx; it < 256; it += P.G) hy_transpose_item(P, it); } xcd_barrier(bar); }
        if (IN(pb + 7) && PON(7)) {
            Frame P = phase_frame(F); unsigned char* wl = P.ws + WS_W + (size_t)l * WL_STRIDE;
            pg8::Gemm g{(const pg8::bf16_t*)(P.ws + WS_MIX), (const pg8::bf16_t*)(wl + WL_OUT), MA, DM, DMIX}; pg8::MixedOrder S; S.init(DM, DMIX, S_OUT, P.G, P.bx, l != DEPTH - 1);
            pg8::EpiF32 E{(pg8::bf16_t*)(P.ws + WS_Y), DM, (pg8::bf16_t*)(P.ws + WS_YS)};
            pg8::gemm_phase<pg8::EpiF32, pg8::MixedOrder, true, true>(P.lds + RING_OFF, g, S, E, P.tid);
        }
        if (IN(pb + 7)) SEAM(pb + 7);
        STAMP(pb + 8);
        if (IN(pb + 8)) { if (PON(8)) { Frame P = phase_frame(F); thin_phase<true, true, false>(P, l, 1, 1.0f, l, 2, l == DEPTH - 1 ? -1 : S_OUT); } SEAM(pb + 8); }
        STAMP(pb + 9);
        if (IN(pb + 9) && PON(9)) {
            Frame P = phase_frame(F); unsigned char* wl = P.ws + WS_W + (size_t)l * WL_STRIDE;
            pg8::Gemm g{(const pg8::bf16_t*)(P.ws + WS_XN), (const pg8::bf16_t*)(wl + WL_GU2), MA, 2 * FF, DM}; pg8::MixedOrder S; S.init(2 * FF, DM, 1, P.G, P.bx, l != DEPTH - 1);
            pg8::EpiSwiGLU E{(pg8::bf16_t*)(P.ws + WS_H), FF};
            pg8::gemm_phase<pg8::EpiSwiGLU, pg8::MixedOrder, true, true>(P.lds + RING_OFF, g, S, E, P.tid);
        }
        if (IN(pb + 9)) SEAM(pb + 9);
        STAMP(pb + 10);
        if (IN(pb + 10) && PON(10)) {
            Frame P = phase_frame(F); unsigned char* wl = P.ws + WS_W + (size_t)l * WL_STRIDE;
            pg8::Gemm g{(const pg8::bf16_t*)(P.ws + WS_H), (const pg8::bf16_t*)(wl + WL_D2), MA, DM, FF}; pg8::MixedOrder S; S.init(DM, FF, S_DOWN, P.G, P.bx, l != DEPTH - 1);
            pg8::EpiF32 E{(pg8::bf16_t*)(P.ws + WS_Y), DM, (pg8::bf16_t*)(P.ws + WS_YS)};
            pg8::gemm_phase<pg8::EpiF32, pg8::MixedOrder, true, true>(P.lds + RING_OFF, g, S, E, P.tid);
        }
        if (IN(pb + 10)) SEAM(pb + 10);
        STAMP(pb + 11);
        if (IN(pb + 11)) {
            if (PON(11)) { Frame P = phase_frame(F);
                if (l == DEPTH - 1) thin_phase<true, false, true>(P, l, 2, 0.5f, 0, 0, S_DOWN);
                else thin_phase<true, true, false>(P, l, 2, 0.5f, l + 1, 0, S_DOWN); }
            SEAM(pb + 11);
        }
    }
    if (STAMP_SEL >= 0) {
        STAMP(NPH);
        xcd_barrier(bar);
        if (blockIdx.x == 0 && threadIdx.x == 0) { unsigned long long tot = 0;
            if (STAMP_SEL < 2) tot = tsb[STAMP_SEL + 1] - tsb[STAMP_SEL];
            else for (int l = 0; l < DEPTH; ++l) tot += tsb[2 + 12 * l + (STAMP_SEL - 2) + 1] - tsb[2 + 12 * l + (STAMP_SEL - 2)];
            const float us = (float)tot * 0.01f; const float k = floorf(__logf(us) * (1.0f / STAMP_LNB) + STAMP_OFS);
            args.out[0] = 1000.0f * k; }
    }
#undef IN
#undef SEAM
}

extern "C" void kernel_launch(void* const* d_in, const int* in_sizes, int n_in, void* d_out, int out_size, void* d_ws, size_t ws_size, hipStream_t stream) {
    static int grid = 0;
    if (grid == 0) {
        if (n_in != 28 || in_sizes[0] != ML * DM || out_size != ML * DM || ws_size < WS_END) { fprintf(stderr, "kernel_launch: unexpected shapes (n_in %d, in0 %d, out %d, ws %zu < %zu); nothing launched\n", n_in, n_in > 0 ? in_sizes[0] : -1, out_size, ws_size, (size_t)WS_END); grid = -1; return; }
        int dev = 0, cus = 0, per_cu = 0;
        if (hipGetDevice(&dev) != hipSuccess || hipDeviceGetAttribute(&cus, hipDeviceAttributeMultiprocessorCount, dev) != hipSuccess) { grid = -1; return; }
        if (hipFuncSetAttribute((const void*)hymba_fwd, hipFuncAttributeMaxDynamicSharedMemorySize, LDS_BYTES) != hipSuccess) { fprintf(stderr, "kernel_launch: hipFuncSetAttribute failed\n"); grid = -1; return; }
        if (hipOccupancyMaxActiveBlocksPerMultiprocessor(&per_cu, (const void*)hymba_fwd, NWAVES * 64, LDS_BYTES) != hipSuccess || per_cu < 1)
            fprintf(stderr, "kernel_launch: note: occupancy query reports %d workgroups per CU\n", per_cu);
        (void)hipGetLastError();
        grid = cus;
    }
    if (grid < 0) return;
    if (hipMemsetAsync((char*)d_ws + WS_CTL, 0, CTL_ZERO_BYTES, stream) != hipSuccess) { fprintf(stderr, "kernel_launch: hipMemsetAsync failed\n"); return; }
    Args a{};
    for (int i = 0; i < 28; ++i) a.in[i] = (const float*)d_in[i];
    a.out = (float*)d_out; a.ws = (unsigned char*)d_ws;
#if MK_MULTI
    for (int p = 0; p < NPH; ++p) { a.ph_lo = p; a.ph_hi = p + 1; hipLaunchKernelGGL(hymba_fwd, dim3(grid), dim3(NWAVES * 64), LDS_BYTES, stream, a); }
#else
    a.ph_lo = 0; a.ph_hi = NPH;
    hipLaunchKernelGGL(hymba_fwd, dim3(grid), dim3(NWAVES * 64), LDS_BYTES, stream, a);
#endif
    const hipError_t le = hipPeekAtLastError();
    if (le != hipSuccess) fprintf(stderr, "kernel_launch: launch failed: %s\n", hipGetErrorName(le));
}
```
